# Optimizing an MI355X kernel written in HIP

```python
import jax, jax.numpy as jnp
from jax import lax
import numpy as np

D_MODEL = 1024
BATCH = 8
SEQ = 2048
DEPTH = 2

MOBA_HEADS = 8
MOBA_HEAD_DIM = D_MODEL // 16
MOBA_WIDTH = MOBA_HEADS * MOBA_HEAD_DIM
MOBA_BLOCK = 256
MOBA_TOPK = 3
MOBA_Q_CHUNK = 64
ROPE_THETA = 10000.0
GLA_HEADS = 4
GLA_DK = D_MODEL // 16
GLA_DV = D_MODEL // 8
GLA_KW = GLA_HEADS * GLA_DK
GLA_VW = GLA_HEADS * GLA_DV
GLA_RANK = 16
GLA_TEMP = 16.0
GLA_CHUNK = 64
CONV_CH = D_MODEL // 2
CONV_WIDTH = 31
D_FF = 4 * D_MODEL
N_BRANCH = 3
EPS = 1e-6
NEG = -1e30
IN_SIZES = (MOBA_WIDTH, MOBA_WIDTH, MOBA_WIDTH,
            GLA_KW, GLA_KW, GLA_VW, GLA_RANK, GLA_VW,
            CONV_CH, CONV_CH,
            N_BRANCH * D_MODEL)
IN_WIDTH = sum(IN_SIZES)

kernel_name = 'hybrid_moba_gla_conformer_gated'


def rms_norm(x, g):
    xf = x.astype(jnp.float32)
    y = xf * lax.rsqrt(jnp.mean(xf * xf, axis=-1, keepdims=True) + EPS)
    return (y * g.astype(jnp.float32)).astype(x.dtype)


def layer_norm(x, g, b):
    xf = x.astype(jnp.float32)
    mu = jnp.mean(xf, axis=-1, keepdims=True)
    var = jnp.mean(jnp.square(xf - mu), axis=-1, keepdims=True)
    y = (xf - mu) * lax.rsqrt(var + EPS)
    return (y * g.astype(jnp.float32) + b.astype(jnp.float32)).astype(x.dtype)


def rope_tables(positions):
    half = MOBA_HEAD_DIM // 2
    inv_freq = ROPE_THETA ** (-jnp.arange(half, dtype=jnp.float32) / half)
    ang = positions.astype(jnp.float32)[..., None] * inv_freq
    return jnp.cos(ang)[:, :, None, :], jnp.sin(ang)[:, :, None, :]


def apply_rope(x, cos, sin):
    xf = x.astype(jnp.float32)
    x1, x2 = jnp.split(xf, 2, axis=-1)
    return jnp.concatenate([x1 * cos - x2 * sin, x2 * cos + x1 * sin], axis=-1).astype(x.dtype)


def gather_blocks(blocks, idx):
    return jax.vmap(jax.vmap(lambda t, i: t[i]))(blocks, idx)


def moba_attention(q, k, v):
    B, H, S, Dh = q.shape
    nb = -(-S // MOBA_BLOCK)
    pad = nb * MOBA_BLOCK - S
    kb = jnp.pad(k, ((0, 0), (0, 0), (0, pad), (0, 0))).reshape(B, H, nb, MOBA_BLOCK, Dh)
    vb = jnp.pad(v, ((0, 0), (0, 0), (0, pad), (0, 0))).reshape(B, H, nb, MOBA_BLOCK, Dh)
    kmean = jnp.mean(kb.astype(jnp.float32), axis=3)
    gate = jnp.einsum('bhsd,bhnd->bhsn', q.astype(jnp.float32), kmean)
    qblk = jnp.arange(S) // MOBA_BLOCK
    past = jnp.arange(nb)[None, :] < qblk[:, None]
    gate = jnp.where(past, gate, -jnp.inf)
    n_sel = min(MOBA_TOPK, nb)
    _, gidx = lax.top_k(gate, n_sel)
    sel_valid = jnp.arange(n_sel)[None, :] < qblk[:, None]
    scale = Dh ** -0.5
    n_qc = S // MOBA_Q_CHUNK

    def chunk(c):
        start = c * MOBA_Q_CHUNK
        qc = lax.dynamic_slice_in_dim(q, start, MOBA_Q_CHUNK, axis=2)
        idx = lax.dynamic_slice_in_dim(gidx, start, MOBA_Q_CHUNK, axis=2)
        valid = lax.dynamic_slice_in_dim(sel_valid, start, MOBA_Q_CHUNK, axis=0)
        own = start // MOBA_BLOCK
        k_own = lax.dynamic_index_in_dim(kb, own, axis=2, keepdims=False)
        v_own = lax.dynamic_index_in_dim(vb, own, axis=2, keepdims=False)
        qpos = start + jnp.arange(MOBA_Q_CHUNK)
        kpos = own * MOBA_BLOCK + jnp.arange(MOBA_BLOCK)
        s_own = jnp.einsum('bhqd,bhkd->bhqk', qc, k_own).astype(jnp.float32) * scale
        s_own = jnp.where(kpos[None, :] <= qpos[:, None], s_own, NEG)
        scores = [s_own]
        for i in range(n_sel):
            k_g = gather_blocks(kb, idx[..., i])
            s = jnp.einsum('bhqd,bhqkd->bhqk', qc, k_g).astype(jnp.float32) * scale
            scores.append(jnp.where(valid[:, i][:, None], s, NEG))
        p = jax.nn.softmax(jnp.concatenate(scores, axis=-1), axis=-1).astype(v.dtype)
        out = jnp.einsum('bhqk,bhkd->bhqd', p[..., :MOBA_BLOCK], v_own)
        for i in range(n_sel):
            v_g = gather_blocks(vb, idx[..., i])
            p_i = p[..., MOBA_BLOCK * (i + 1):MOBA_BLOCK * (i + 2)]
            out = out + jnp.einsum('bhqk,bhqkd->bhqd', p_i, v_g)
        return out

    out = lax.map(chunk, jnp.arange(n_qc))
    return out.transpose(1, 2, 0, 3, 4).reshape(B, H, S, Dh)


def gla_attention(q, k, v, g):
    B, H, S, dk = q.shape
    dv = v.shape[-1]
    nc = S // GLA_CHUNK

    def to_chunks(t):
        return t.astype(jnp.float32).reshape(B, H, nc, GLA_CHUNK, t.shape[-1]).transpose(2, 0, 1, 3, 4)

    qc, kc, vc, gc = to_chunks(q * (dk ** -0.5)), to_chunks(k), to_chunks(v), to_chunks(g)
    causal = jnp.tril(jnp.ones((GLA_CHUNK, GLA_CHUNK), dtype=bool))[:, :, None]

    def step(state, inp):
        qi, ki, vi, gi = inp
        G = jnp.cumsum(gi, axis=2)
        diff = G[:, :, :, None, :] - G[:, :, None, :, :]
        decay = jnp.exp(jnp.where(causal, diff, -jnp.inf))
        A = jnp.einsum('bhid,bhjd,bhijd->bhij', qi, ki, decay)
        o = jnp.einsum('bhij,bhjv->bhiv', A, vi) + jnp.einsum('bhid,bhdv->bhiv', qi * jnp.exp(G), state)
        G_last = G[:, :, -1:, :]
        k_dec = ki * jnp.exp(G_last - G)
        state = state * jnp.exp(G_last[:, :, 0, :])[..., None] + jnp.einsum('bhjd,bhjv->bhdv', k_dec, vi)
        return state, o

    state0 = jnp.zeros((B, H, dk, dv), jnp.float32)
    _, o = lax.scan(step, state0, (qc, kc, vc, gc))
    return o.transpose(1, 2, 0, 3, 4).reshape(B, H, S, dv)


def conformer_conv(a, gate, w_dw, b_dw, g_ln, b_ln):
    u = a * jax.nn.sigmoid(gate)
    y = lax.conv_general_dilated(u, w_dw[:, None, :].astype(u.dtype), window_strides=(1,),
                                 padding=((CONV_WIDTH - 1, 0),),
                                 dimension_numbers=('NWC', 'WIO', 'NWC'),
                                 feature_group_count=CONV_CH) + b_dw
    return jax.nn.silu(layer_norm(y, g_ln, b_ln))


def hybrid_mixer(xn, cos, sin, w_in, b_gate, w_gla_a2, b_gla_a, g_gla_norm, w_dw, b_dw,
                 g_conv_ln, b_conv_ln, w_moba_o, w_gla_o, w_conv_o, w_mix_out):
    B, S, _ = xn.shape
    z = xn @ w_in
    points, acc = [], 0
    for s in IN_SIZES[:-1]:
        acc += s
        points.append(acc)
    mq, mk, mv, lq, lk, lv, la, lr, ca, cg, gates = jnp.split(z, points, axis=-1)

    def moba_heads(t, rot):
        t = t.reshape(B, S, MOBA_HEADS, MOBA_HEAD_DIM)
        t = apply_rope(t, cos, sin) if rot else t
        return t.transpose(0, 2, 1, 3)
    ya = moba_attention(moba_heads(mq, True), moba_heads(mk, True), moba_heads(mv, False))
    ya = ya.transpose(0, 2, 1, 3).reshape(B, S, MOBA_WIDTH) @ w_moba_o

    logdecay = jax.nn.log_sigmoid((la @ w_gla_a2 + b_gla_a).astype(jnp.float32)) / GLA_TEMP
    def gla_heads(t, d):
        return t.reshape(B, S, GLA_HEADS, d).transpose(0, 2, 1, 3)
    ob = gla_attention(gla_heads(lq, GLA_DK), gla_heads(lk, GLA_DK), gla_heads(lv, GLA_DV),
                       gla_heads(logdecay, GLA_DK))
    ob = ob.transpose(0, 2, 1, 3).astype(xn.dtype)
    ob = rms_norm(ob, g_gla_norm) * jax.nn.silu(lr.reshape(B, S, GLA_HEADS, GLA_DV))
    yb = ob.reshape(B, S, GLA_VW) @ w_gla_o

    yc = conformer_conv(ca, cg, w_dw, b_dw, g_conv_ln, b_conv_ln) @ w_conv_o

    g_a, g_b, g_c = jnp.split(jax.nn.sigmoid(gates + b_gate), N_BRANCH, axis=-1)
    return (g_a * ya + g_b * yb + g_c * yc) @ w_mix_out


def sq_relu_mlp(xn, w_up, w_down):
    return jnp.square(jax.nn.relu(xn @ w_up)) @ w_down


def setup_inputs(seed: int = 0) -> dict:
    key = jax.random.key(seed)
    ks = jax.random.split(key, 24)
    f32 = jnp.float32

    def nrm(k, shape, fan_in):
        return jax.random.normal(k, shape, f32) * (fan_in ** -0.5)

    def gain(k, shape):
        return 1.0 + 0.02 * jax.random.normal(k, shape, f32)

    def bias(k, shape, s):
        return s * jax.random.normal(k, shape, f32)

    L = DEPTH
    return {
        'x': jax.random.normal(ks[0], (BATCH, SEQ, D_MODEL), f32),
        'positions': jnp.broadcast_to(jnp.arange(SEQ, dtype=jnp.int32), (BATCH, SEQ)),
        'g_mix_pre': gain(ks[1], (L, D_MODEL)),
        'w_in': nrm(ks[2], (L, D_MODEL, IN_WIDTH), D_MODEL),
        'b_gate': bias(ks[3], (L, N_BRANCH * D_MODEL), 0.1),
        'w_gla_a2': nrm(ks[4], (L, GLA_RANK, GLA_KW), GLA_RANK),
        'b_gla_a': bias(ks[5], (L, GLA_KW), 0.1),
        'g_gla_norm': gain(ks[6], (L, GLA_DV)),
        'w_dw': nrm(ks[7], (L, CONV_WIDTH, CONV_CH), CONV_WIDTH),
        'b_dw': bias(ks[8], (L, CONV_CH), 0.02),
        'g_conv_ln': gain(ks[9], (L, CONV_CH)),
        'b_conv_ln': bias(ks[10], (L, CONV_CH), 0.02),
        'w_moba_o': nrm(ks[11], (L, MOBA_WIDTH, D_MODEL), MOBA_WIDTH),
        'w_gla_o': nrm(ks[12], (L, GLA_VW, D_MODEL), GLA_VW),
        'w_conv_o': nrm(ks[13], (L, CONV_CH, D_MODEL), CONV_CH),
        'w_mix_out': nrm(ks[14], (L, D_MODEL, D_MODEL), D_MODEL),
        'g_mix_post': gain(ks[15], (L, D_MODEL)),
        'g_mlp_pre': gain(ks[16], (L, D_MODEL)),
        'w_mlp_up': nrm(ks[17], (L, D_MODEL, D_FF), D_MODEL),
        'w_mlp_down': nrm(ks[18], (L, D_FF, D_MODEL), D_FF),
        'g_mlp_post': gain(ks[19], (L, D_MODEL)),
    }


def reference(x, positions, g_mix_pre, w_in, b_gate, w_gla_a2, b_gla_a, g_gla_norm, w_dw, b_dw,
              g_conv_ln, b_conv_ln, w_moba_o, w_gla_o, w_conv_o, w_mix_out, g_mix_post,
              g_mlp_pre, w_mlp_up, w_mlp_down, g_mlp_post):
    cos, sin = rope_tables(positions)
    h = x
    for l in range(DEPTH):
        y = hybrid_mixer(rms_norm(h, g_mix_pre[l]), cos, sin, w_in[l], b_gate[l], w_gla_a2[l],
                         b_gla_a[l], g_gla_norm[l], w_dw[l], b_dw[l], g_conv_ln[l], b_conv_ln[l],
                         w_moba_o[l], w_gla_o[l], w_conv_o[l], w_mix_out[l])
        h = h + rms_norm(y, g_mix_post[l])
        y = sq_relu_mlp(rms_norm(h, g_mlp_pre[l]), w_mlp_up[l], w_mlp_down[l])
        h = h + rms_norm(y, g_mlp_post[l])
    return h
```

```cpp
#include <hip/hip_runtime.h>
#include <hip/hip_cooperative_groups.h>
#include <cstdio>
#include <cstdint>
namespace cg = cooperative_groups;
namespace pg8 {
#define PG8_LAS __attribute__((address_space(3)))
typedef unsigned short bf16_t;
typedef short bf16x8 __attribute__((ext_vector_type(8)));
typedef float f32x4 __attribute__((ext_vector_type(4)));
typedef unsigned u32x4 __attribute__((ext_vector_type(4)));
constexpr int BM = 256, BK = 64, HALF = 128, HTB = HALF * BK * 2  , STAGE_BYTES = 8 * HTB, NXCD = 8, WGM = 8;

__host__ __device__ __forceinline__ int lds_byte(int r, int c) { const int st = (r >> 4) * 2 + (c >> 5), rr = r & 15, cc = c & 31, ob = rr * 64 + cc * 2; return st * 1024 + (ob ^ (((ob >> 9) & 1) << 5)); }
__host__ __device__ __forceinline__ void stage_rc(int b, int& R, int& C) { const int st = b / 1024, sb = b % 1024, swz = sb ^ (((sb >> 9) & 1) << 5); R = (st >> 1) * 16 + swz / 64; C = (st & 1) * 32 + (swz % 64) / 2; }
__host__ __device__ __forceinline__ int perm32(int rho) { const int n = rho >> 4, i = rho & 15; return 8 * (i >> 2) + 4 * n + (i & 3); }

struct Unit { int pm, pn; };
struct Gemm { const bf16_t* A; const bf16_t* Bt; int M, N, K; };

struct StaticOrder {
    int nM, nN, nwg, G, c;
    __host__ __device__ void init(int M, int N, int G_, int c_) { nM = M / BM; nN = N / BM; nwg = nM * nN; G = G_; c = c_; }
    __host__ __device__ bool next(int i, Unit& u) const {
        const long L = (long)i * G + c; if (L >= nwg) return false;
        int wgid = (int)L; { const int q = nwg / NXCD, r = nwg % NXCD, xcd = wgid % NXCD, off = wgid / NXCD; wgid = (xcd < r ? xcd * (q + 1) : r * (q + 1) + (xcd - r) * q) + off; }
        const int nig = WGM * nN, gid = wgid / nig, fm = gid * WGM, gsz = (nM - fm) < WGM ? (nM - fm) : WGM;
        u.pm = fm + ((wgid % nig) % gsz); u.pn = (wgid % nig) / gsz; return true;
    }
    __device__ __forceinline__ void a_ready(const Unit&) const {}
    __device__ __forceinline__ void done(const Unit&) const {}
};

__device__ __forceinline__ unsigned cvt_pk_bf16(float lo, float hi) { unsigned r; asm volatile("v_cvt_pk_bf16_f32 %0, %1, %2" : "=v"(r) : "v"(lo), "v"(hi)); return r; }
typedef float f32x2 __attribute__((ext_vector_type(2)));
typedef unsigned u32x2 __attribute__((ext_vector_type(2)));
__device__ __forceinline__ float bf_lo(unsigned w) { return __uint_as_float(w << 16); }
__device__ __forceinline__ float bf_hi(unsigned w) { return __uint_as_float(w & 0xffff0000u); }
__device__ __forceinline__ float sigm(float x) { return 1.0f / (1.0f + __expf(-x)); }
__device__ __forceinline__ u32x4 pack8(const f32x4 a, const f32x4 b) { u32x4 w; w.x = cvt_pk_bf16(a[0], a[1]); w.y = cvt_pk_bf16(a[2], a[3]); w.z = cvt_pk_bf16(b[0], b[1]); w.w = cvt_pk_bf16(b[2], b[3]); return w; }

__host__ __device__ __forceinline__ void tile_of(int wgid, int nM, int nN, int& pm, int& pn) {
    const int nwg = nM * nN;
    { const int q = nwg / NXCD, r = nwg % NXCD, xcd = wgid % NXCD, off = wgid / NXCD; wgid = (xcd < r ? xcd * (q + 1) : r * (q + 1) + (xcd - r) * q) + off; }
    const int nig = WGM * nN, gid = wgid / nig, fm = gid * WGM, gsz = (nM - fm) < WGM ? (nM - fm) : WGM;
    pm = fm + ((wgid % nig) % gsz); pn = (wgid % nig) / gsz;
}
struct SchedBranch {
    int G, c;
    __device__ bool next(int i, Unit& u) const { const long L = (long)i * G + c; if (L >= 768) return false; const int j = (int)(L / 256); int pm, pn; tile_of((int)(L % 256), 64, 4, pm, pn); u.pm = 64 * j + pm; u.pn = 4 * j + pn; return true; }
    __device__ __forceinline__ void a_ready(const Unit&) const {}
    __device__ __forceinline__ void done(const Unit&) const {}
};
struct SchedGates {
    int G, c;
    __device__ bool next(int i, Unit& u) const { const int j = i % 3, rnd = i / 3; const long L = (long)rnd * G + c; if (L >= 256) return false; int pm, pn; tile_of((int)L, 64, 4, pm, pn); u.pm = pm; u.pn = 4 * j + pn; return true; }
    __device__ __forceinline__ void a_ready(const Unit&) const {}
    __device__ __forceinline__ void done(const Unit&) const {}
};

template <int ACT  > struct EpiStore {
    static constexpr bool PERM = true, AFTER_DRAIN = false;
    bf16_t* O; int ldc; int jdiv; size_t jstride;
    __device__ __forceinline__ void operator()(const f32x4 (&acc)[2][2][4][2], const Unit& u, int wr, int wc, int fr, int fq) const {
        const int j = u.pn / jdiv; const int pm = u.pm - 64 * j, pn = u.pn - jdiv * j;
        bf16_t* base = O + (size_t)j * jstride;
        const int row0 = pm * BM + wr * 64 + fr, col0 = pn * BM + wc * 32 + 8 * fq;
#pragma unroll
        for (int ai = 0; ai < 2; ++ai)
#pragma unroll
            for (int m = 0; m < 4; ++m) { bf16_t* rowp = base + (size_t)(row0 + ai * HALF + m * 16) * ldc + col0;
#pragma unroll
                for (int bj = 0; bj < 2; ++bj) { f32x4 v0 = acc[ai][bj][m][0], v1 = acc[ai][bj][m][1];
                    if (ACT == 1) {
#pragma unroll
                        for (int e = 0; e < 4; ++e) { const float a = fmaxf(v0[e], 0.f), b = fmaxf(v1[e], 0.f); v0[e] = a * a; v1[e] = b * b; } }
                    *(u32x4*)(rowp + bj * HALF) = pack8(v0, v1); } }
    }
};
struct EpiGate {
    static constexpr bool PERM = true, AFTER_DRAIN = false;
    const bf16_t* Y; size_t ystride; bf16_t* Mb; const float* bgate;
    __device__ __forceinline__ void operator()(const f32x4 (&acc)[2][2][4][2], const Unit& u, int wr, int wc, int fr, int fq) const {
        const int j = u.pn >> 2, pn = u.pn & 3;
        const bf16_t* Yj = Y + (size_t)j * ystride;
        const int row0 = u.pm * BM + wr * 64 + fr, col0 = pn * BM + wc * 32 + 8 * fq;
        f32x4 bv[2][2];
#pragma unroll
        for (int bj = 0; bj < 2; ++bj)
#pragma unroll
            for (int n = 0; n < 2; ++n) bv[bj][n] = *(const f32x4*)(bgate + j * 1024 + col0 + bj * HALF + 4 * n);
#pragma unroll
        for (int ai = 0; ai < 2; ++ai)
#pragma unroll
            for (int m = 0; m < 4; ++m) { const size_t off = (size_t)(row0 + ai * HALF + m * 16) * 1024 + col0;
#pragma unroll
                for (int bj = 0; bj < 2; ++bj) { const size_t o2 = off + bj * HALF;
                    const u32x4 yw = *(const u32x4*)(Yj + o2); u32x4 mw = (u32x4){0u, 0u, 0u, 0u}; if (j > 0) mw = *(const u32x4*)(Mb + o2);
                    const f32x4 x0 = acc[ai][bj][m][0] + bv[bj][0], x1 = acc[ai][bj][m][1] + bv[bj][1];
                    f32x4 r0, r1;
                    r0[0] = sigm(x0[0]) * bf_lo(yw.x) + bf_lo(mw.x); r0[1] = sigm(x0[1]) * bf_hi(yw.x) + bf_hi(mw.x);
                    r0[2] = sigm(x0[2]) * bf_lo(yw.y) + bf_lo(mw.y); r0[3] = sigm(x0[3]) * bf_hi(yw.y) + bf_hi(mw.y);
                    r1[0] = sigm(x1[0]) * bf_lo(yw.z) + bf_lo(mw.z); r1[1] = sigm(x1[1]) * bf_hi(yw.z) + bf_hi(mw.z);
                    r1[2] = sigm(x1[2]) * bf_lo(yw.w) + bf_lo(mw.w); r1[3] = sigm(x1[3]) * bf_hi(yw.w) + bf_hi(mw.w);
                    *(u32x4*)(Mb + o2) = pack8(r0, r1); } }
    }
};
struct EpiInproj {
    static constexpr bool PERM = true, AFTER_DRAIN = false;
    bf16_t *Q, *Kb, *V, *lq, *lk, *lv, *lr, *ca, *cg; float* gdec; float* kmean; const float* ropec; const float* ropes; const float* bgla; float qscale;
    __device__ __forceinline__ void operator()(const f32x4 (&acc)[2][2][4][2], const Unit& u, int wr, int wc, int fr, int fq) const {
        const int pn = u.pn;
        const int row0 = u.pm * BM + wr * 64 + fr, cl = wc * 32 + 8 * fq;
        if (pn < 4) {
            const bool isk = pn >= 2; bf16_t* dst = isk ? Kb : Q; const int ct = (pn & 1) * 256; const float sc = isk ? 1.0f : qscale;
#pragma unroll
            for (int bj = 0; bj < 2; ++bj) { const int c = ct + bj * HALF + cl, i0 = (c & 63) >> 1;
                float cs[8];
#pragma unroll
                for (int e = 0; e < 8; ++e) cs[e] = 0.f;
#pragma unroll
                for (int ai = 0; ai < 2; ++ai)
#pragma unroll
                    for (int m = 0; m < 4; ++m) { const int row = row0 + ai * HALF + m * 16;
                        const f32x4 co = *(const f32x4*)(ropec + (size_t)row * 32 + i0), si = *(const f32x4*)(ropes + (size_t)row * 32 + i0);
                        const f32x4 v0 = acc[ai][bj][m][0], v1 = acc[ai][bj][m][1]; f32x4 o0, o1;
                        o0[0] = (v0[0] * co[0] - v0[1] * si[0]) * sc; o0[1] = (v0[1] * co[0] + v0[0] * si[0]) * sc;
                        o0[2] = (v0[2] * co[1] - v0[3] * si[1]) * sc; o0[3] = (v0[3] * co[1] + v0[2] * si[1]) * sc;
                        o1[0] = (v1[0] * co[2] - v1[1] * si[2]) * sc; o1[1] = (v1[1] * co[2] + v1[0] * si[2]) * sc;
                        o1[2] = (v1[2] * co[3] - v1[3] * si[3]) * sc; o1[3] = (v1[3] * co[3] + v1[2] * si[3]) * sc;
#pragma unroll
                        for (int e = 0; e < 4; ++e) { cs[e] += o0[e]; cs[4 + e] += o1[e]; }
                        *(u32x4*)(dst + (size_t)row * 512 + c) = pack8(o0, o1); }
                if (isk) {
#pragma unroll
                    for (int e = 0; e < 8; ++e) { float s = cs[e]; s += __shfl_xor(s, 1); s += __shfl_xor(s, 2); s += __shfl_xor(s, 4); s += __shfl_xor(s, 8); cs[e] = s; }
                    if (fr == 0) {
#pragma unroll
                        for (int e = 0; e < 8; ++e) atomicAdd(kmean + (size_t)u.pm * 512 + c + e, cs[e]); } } }
        } else if (pn == 10) {
#pragma unroll
            for (int bj = 0; bj < 2; ++bj) { const int c = bj * HALF + cl; const f32x4 b0 = *(const f32x4*)(bgla + c), b1 = *(const f32x4*)(bgla + c + 4);
#pragma unroll
                for (int ai = 0; ai < 2; ++ai)
#pragma unroll
                    for (int m = 0; m < 4; ++m) { const int row = row0 + ai * HALF + m * 16; const f32x4 x0 = acc[ai][bj][m][0] + b0, x1 = acc[ai][bj][m][1] + b1; f32x4 g0, g1;
#pragma unroll
                        for (int e = 0; e < 4; ++e) { g0[e] = (fminf(x0[e], 0.f) - __logf(1.0f + __expf(-fabsf(x0[e])))) * 0.0625f; g1[e] = (fminf(x1[e], 0.f) - __logf(1.0f + __expf(-fabsf(x1[e])))) * 0.0625f; }
                        *(f32x4*)(gdec + (size_t)row * 256 + c) = g0; *(f32x4*)(gdec + (size_t)row * 256 + c + 4) = g1; } }
        } else {
            bf16_t* dst; int ld = 512, ct; float sc = 1.0f;
            if (pn < 6) { dst = V; ct = (pn - 4) * 256; }
            else if (pn == 6) { dst = lq; ld = 256; ct = 0; sc = 0.125f; }
            else if (pn == 7) { dst = lk; ld = 256; ct = 0; }
            else if (pn < 10) { dst = lv; ct = (pn - 8) * 256; }
            else if (pn < 13) { dst = lr; ct = (pn - 11) * 256; }
            else if (pn < 15) { dst = ca; ct = (pn - 13) * 256; }
            else { dst = cg; ct = (pn - 15) * 256; }
#pragma unroll
            for (int ai = 0; ai < 2; ++ai)
#pragma unroll
                for (int m = 0; m < 4; ++m) { bf16_t* rowp = dst + (size_t)(row0 + ai * HALF + m * 16) * ld + ct + cl;
#pragma unroll
                    for (int bj = 0; bj < 2; ++bj) *(u32x4*)(rowp + bj * HALF) = pack8(acc[ai][bj][m][0] * sc, acc[ai][bj][m][1] * sc); }
        }
    }
};
template <class Epi, class Sched, bool ALIGN_EPI = false, bool SP2 = false>
__device__ __forceinline__ void gemm_phase(PG8_LAS unsigned char* lds, const Gemm g, const Sched& S, const Epi& E) {
    int tid_l = threadIdx.x; asm volatile("" : "+v"(tid_l));
    const int tid = tid_l, wid = __builtin_amdgcn_readfirstlane(tid >> 6), lane = tid & 63, wr = wid >> 2, wc = wid & 3, fr = lane & 15, fq = lane >> 4;
    const int K = g.K, nt = K / BK;
    unsigned voffA[2], voffB[2];
#pragma unroll
    for (int i = 0; i < 2; ++i) { int R, C; stage_rc(tid * 16 + i * 8192, R, C); const int Rb = Epi::PERM ? ((R & ~31) + perm32(R & 31)) : R;
        voffA[i] = (unsigned)(R * K + C) * 2u; voffB[i] = (unsigned)(Rb * K + C) * 2u; }
    const size_t kstep = (size_t)(BK * 2);
    const size_t hstep = (size_t)HALF * K * 2;
    const size_t tstep = 2 * hstep;
    const unsigned ldsw = (unsigned)wid * 1024u;
    const int aoff = lds_byte(wr * 64 + fr, fq * 8), boff = lds_byte(wc * 32 + fr, fq * 8);
#define PG8_SA(b, h) (((b) * 2 + (h)) * HTB)
#define PG8_SB(b, h) ((4 + (b) * 2 + (h)) * HTB)
#define PG8_STAGE(bufoff, gbase, voff) do { _Pragma("unroll") for (int _i = 0; _i < 2; ++_i) \
        __builtin_amdgcn_global_load_lds((const unsigned*)((const char*)(gbase) + (voff)[_i]), (PG8_LAS unsigned*)(lds + (bufoff) + ldsw + _i * 8192), 16, 0, 0); } while (0)
#define PG8_LDA(dst, b, h) do { _Pragma("unroll") for (int m = 0; m < 4; ++m) _Pragma("unroll") for (int k = 0; k < 2; ++k) dst[m][k] = *(const PG8_LAS bf16x8*)(lds + PG8_SA(b, h) + aoff + m * 2048 + k * 1024); } while (0)
#define PG8_LDB(dst, b, h) do { _Pragma("unroll") for (int n = 0; n < 2; ++n) _Pragma("unroll") for (int k = 0; k < 2; ++k) dst[n][k] = *(const PG8_LAS bf16x8*)(lds + PG8_SB(b, h) + boff + n * 2048 + k * 1024); } while (0)
#define PG8_MMA(ai, bj, At, Bt) do { __builtin_amdgcn_s_setprio(1); _Pragma("unroll") for (int m = 0; m < 4; ++m) _Pragma("unroll") for (int n = 0; n < 2; ++n) _Pragma("unroll") for (int k = 0; k < 2; ++k) \
        acc[ai][bj][m][n] = __builtin_amdgcn_mfma_f32_16x16x32_bf16(Bt[n][k], At[m][k], acc[ai][bj][m][n], 0, 0, 0); __builtin_amdgcn_s_setprio(0); } while (0)
#define PG8_WAIT_V(n) asm volatile("s_waitcnt vmcnt(" #n ")" ::: "memory")
#define PG8_WAIT_L(n) asm volatile("s_waitcnt lgkmcnt(" #n ")" ::: "memory")
#define PG8_BAR __builtin_amdgcn_s_barrier()
#define PG8_SCHED __builtin_amdgcn_sched_barrier(0)
    Unit cur, nxt; int ui = 0;
    if (!S.next(0, cur)) return;
    f32x4 acc[2][2][4][2];
#pragma unroll
    for (int a = 0; a < 2; ++a)
#pragma unroll
        for (int b = 0; b < 2; ++b)
#pragma unroll
            for (int m = 0; m < 4; ++m)
#pragma unroll
                for (int n = 0; n < 2; ++n) acc[a][b][m][n] = (f32x4){0.f, 0.f, 0.f, 0.f};
    bf16x8 At[4][2], B0[2][2], B1[2][2];
    const char* cA = (const char*)g.A + (size_t)cur.pm * tstep; const char* cB = (const char*)g.Bt + (size_t)cur.pn * tstep;
    S.a_ready(cur);
    if constexpr (SP2) {
        PG8_STAGE(PG8_SB(0, 0), cB, voffB); PG8_STAGE(PG8_SB(0, 1), cB + hstep, voffB); PG8_STAGE(PG8_SA(0, 0), cA, voffA); PG8_STAGE(PG8_SA(0, 1), cA + hstep, voffA);
        if (wr == 1) PG8_BAR;
        PG8_WAIT_V(2); PG8_BAR;
        PG8_STAGE(PG8_SB(1, 0), cB + kstep, voffB); PG8_STAGE(PG8_SA(1, 0), cA + kstep, voffA); PG8_STAGE(PG8_SB(1, 1), cB + hstep + kstep, voffB);
        PG8_WAIT_V(6); PG8_BAR;
    } else {
        PG8_STAGE(PG8_SB(0, 0), cB, voffB); PG8_STAGE(PG8_SA(0, 0), cA, voffA); PG8_STAGE(PG8_SB(0, 1), cB + hstep, voffB); PG8_STAGE(PG8_SA(0, 1), cA + hstep, voffA);
        if (wr == 1) PG8_BAR;
        PG8_WAIT_V(4); PG8_BAR;
        PG8_STAGE(PG8_SB(1, 0), cB + kstep, voffB); PG8_STAGE(PG8_SA(1, 0), cA + kstep, voffA); PG8_STAGE(PG8_SB(1, 1), cB + hstep + kstep, voffB);
        PG8_WAIT_V(6); PG8_BAR;
    }
    for (;;) {
        const bool has_next = S.next(ui + 1, nxt);
        const char* nA = has_next ? (const char*)g.A + (size_t)nxt.pm * tstep : cA; const char* nB = has_next ? (const char*)g.Bt + (size_t)nxt.pn * tstep : cB;
        for (int t = 0; t < nt; t += 2) {
            const bool last = (t == nt - 2);
            const char* a1 = cA + (size_t)(t + 1) * kstep;
            const char* a2 = last ? nA : cA + (size_t)(t + 2) * kstep; const char* b2 = last ? nB : cB + (size_t)(t + 2) * kstep;
            const char* a3 = a2 + kstep; const char* b3 = b2 + kstep;
            if (last && has_next) S.a_ready(nxt);
            if constexpr (SP2) {
            PG8_LDB(B0, 0, 0); PG8_LDB(B1, 0, 1); PG8_SCHED; PG8_LDA(At, 0, 0); PG8_STAGE(PG8_SA(1, 1), a1 + hstep, voffA);
            PG8_WAIT_V(8); PG8_WAIT_L(0); PG8_BAR; PG8_MMA(0, 0, At, B0); PG8_MMA(0, 1, At, B1); PG8_BAR; PG8_SCHED;
            PG8_LDA(At, 0, 1); PG8_STAGE(PG8_SB(0, 0), b2, voffB); PG8_STAGE(PG8_SB(0, 1), b2 + hstep, voffB); PG8_STAGE(PG8_SA(0, 0), a2, voffA);
            PG8_WAIT_V(8); PG8_WAIT_L(0); PG8_BAR; PG8_MMA(1, 0, At, B0); PG8_MMA(1, 1, At, B1); PG8_BAR; PG8_SCHED;
            PG8_LDB(B0, 1, 0); PG8_LDB(B1, 1, 1); PG8_SCHED; PG8_LDA(At, 1, 0); PG8_STAGE(PG8_SA(0, 1), a2 + hstep, voffA);
            PG8_WAIT_V(8); PG8_WAIT_L(0); PG8_BAR; PG8_MMA(0, 0, At, B0); PG8_MMA(0, 1, At, B1); PG8_BAR; PG8_SCHED;
            PG8_LDA(At, 1, 1); PG8_STAGE(PG8_SB(1, 0), b3, voffB); PG8_STAGE(PG8_SB(1, 1), b3 + hstep, voffB); PG8_STAGE(PG8_SA(1, 0), a3, voffA);
            PG8_WAIT_V(8); PG8_WAIT_L(0); PG8_BAR; PG8_MMA(1, 0, At, B0); PG8_MMA(1, 1, At, B1); PG8_BAR; PG8_SCHED;
            } else {
            PG8_LDB(B0, 0, 0); PG8_SCHED; PG8_LDA(At, 0, 0); PG8_STAGE(PG8_SA(1, 1), a1 + hstep, voffA);
            PG8_WAIT_L(8); PG8_BAR; PG8_WAIT_L(0); PG8_MMA(0, 0, At, B0); PG8_BAR; PG8_SCHED;
            PG8_LDB(B1, 0, 1); PG8_STAGE(PG8_SB(0, 0), b2, voffB);
            PG8_BAR; PG8_WAIT_L(0); PG8_MMA(0, 1, At, B1); PG8_BAR;
            PG8_LDA(At, 0, 1); PG8_STAGE(PG8_SA(0, 0), a2, voffA);
            PG8_BAR; PG8_WAIT_L(0); PG8_MMA(1, 0, At, B0); PG8_BAR; PG8_SCHED;
            PG8_STAGE(PG8_SB(0, 1), b2 + hstep, voffB);
            PG8_WAIT_V(6); PG8_BAR; PG8_MMA(1, 1, At, B1); PG8_BAR;
            PG8_LDB(B0, 1, 0); PG8_SCHED; PG8_LDA(At, 1, 0); PG8_STAGE(PG8_SA(0, 1), a2 + hstep, voffA);
            PG8_WAIT_L(8); PG8_BAR; PG8_WAIT_L(0); PG8_MMA(0, 0, At, B0); PG8_BAR; PG8_SCHED;
            PG8_LDB(B1, 1, 1); PG8_STAGE(PG8_SB(1, 0), b3, voffB);
            PG8_BAR; PG8_WAIT_L(0); PG8_MMA(0, 1, At, B1); PG8_BAR;
            PG8_LDA(At, 1, 1); PG8_STAGE(PG8_SA(1, 0), a3, voffA);
            PG8_BAR; PG8_WAIT_L(0); PG8_MMA(1, 0, At, B0); PG8_BAR; PG8_SCHED;
            PG8_STAGE(PG8_SB(1, 1), b3 + hstep, voffB);
            PG8_WAIT_V(6); PG8_BAR; PG8_MMA(1, 1, At, B1); PG8_BAR;
            }
        }
        if constexpr (ALIGN_EPI) { if (wr == 0) PG8_BAR; }
        if constexpr (!Epi::AFTER_DRAIN) { E(acc, cur, wr, wc, fr, fq); S.done(cur); }
        if (!has_next) break;
#pragma unroll
        for (int a = 0; a < 2; ++a)
#pragma unroll
            for (int b = 0; b < 2; ++b)
#pragma unroll
                for (int m = 0; m < 4; ++m)
#pragma unroll
                    for (int n = 0; n < 2; ++n) acc[a][b][m][n] = (f32x4){0.f, 0.f, 0.f, 0.f};
        cur = nxt; cA = nA; cB = nB; ++ui;
        if constexpr (ALIGN_EPI) { if (wr == 1) PG8_BAR; }
    }
    PG8_WAIT_V(0);
    if constexpr (!ALIGN_EPI) { if (wr == 0) PG8_BAR; }
    PG8_BAR;
    if constexpr (Epi::AFTER_DRAIN) { E.fused(acc, cur, wr, wc, fr, fq, lds, wid, lane); S.done(cur); }
#undef PG8_SA
#undef PG8_SB
#undef PG8_STAGE
#undef PG8_LDA
#undef PG8_LDB
#undef PG8_MMA
#undef PG8_WAIT_V
#undef PG8_WAIT_L
#undef PG8_BAR
#undef PG8_SCHED
}
}
#include <hip/hip_bf16.h>
#include <cmath>
namespace attn_body {
using bf16=__hip_bfloat16;
using bf16x8=__attribute__((ext_vector_type(8)))short;
using s16x4=__attribute__((ext_vector_type(4)))short;
using f32x16=__attribute__((ext_vector_type(16)))float;
using u32x4=__attribute__((ext_vector_type(4)))unsigned;
constexpr int BATCH=8,NHEAD=8,SEQ=2048,D=64,DM=NHEAD*D;
constexpr int NW=8,QBLK=32,QB=QBLK*NW,KVBLK=64,NQB=SEQ/QB;
constexpr int ATTN_PITCH=DM, ATTN_UNIT_ROWS=QB;
__device__ __forceinline__ int crow(int r,int hi){return (r&3)+8*(r>>2)+4*hi;}
#define SBAR() __builtin_amdgcn_sched_barrier(0)
__device__ __forceinline__ void cmask(f32x16&p0,f32x16&p1,int jb,int qrel,int hi){
  const float NEG=-INFINITY; int kb=64*jb+4*hi;
  #pragma unroll
  for(int r=0;r<16;++r){int kv=kb+(r&3)+8*(r>>2); if(kv>qrel)p0[r]=NEG; if(kv+32>qrel)p1[r]=NEG;}
}

constexpr int NSLOT=3, SLOTB=8192;
constexpr int LDS_K=0, LDS_V=NSLOT*SLOTB, LDS_WS=2*NSLOT*SLOTB, LDS_OST=LDS_WS+NW*64*4, LDS_BYTES=LDS_OST+NW*4096;
constexpr float C2=0.125f*1.4426950408889634f;
__device__ __forceinline__ void glds16(const void*gsrc,unsigned lds_dst){unsigned keep;
  asm volatile("s_mov_b32 %0, m0\n\ts_mov_b32 m0, %2\n\ts_nop 0\n\tglobal_load_lds_dwordx4 %1, off\n\ts_mov_b32 m0, %0":"=&s"(keep):"v"(gsrc),"s"(lds_dst):"memory");}
__device__ __forceinline__ float max3f(float a,float b,float c){float r;asm("v_max3_f32 %0, %1, %2, %3":"=v"(r):"v"(a),"v"(b),"v"(c));return r;}
__device__ __forceinline__ float max2f(float a,float b){float r;asm("v_max_f32_e32 %0, %1, %2":"=v"(r):"v"(a),"v"(b));return r;}
__device__ __forceinline__ float fadd_s(float a,float b){float r;asm("v_add_f32_e32 %0, %1, %2":"=v"(r):"v"(a),"v"(b));return r;}
__device__ __forceinline__ float fsub_s(float a,float b){float r;asm("v_sub_f32_e32 %0, %1, %2":"=v"(r):"v"(a),"v"(b));return r;}
typedef float f32x2_t __attribute__((ext_vector_type(2))); typedef float f32x4_t __attribute__((ext_vector_type(4))); typedef __bf16 bf16x2_t __attribute__((ext_vector_type(2)));
__device__ __forceinline__ unsigned cvtpk_s(float lo,float hi){f32x2_t v={lo,hi};bf16x2_t b=__builtin_convertvector(v,bf16x2_t);return __builtin_bit_cast(unsigned,b);}
#define WAIT_BAR(N) asm volatile("s_waitcnt vmcnt(" #N ") lgkmcnt(0)\n\ts_barrier":::"memory")

__device__ __forceinline__ void qkt(f32x16&p0,f32x16&p1,const char*Kslot,const bf16x8*qr,const f32x16&negm,int r32,int hi){
  const char*kb=Kslot+hi*1024+r32*16;
  #pragma unroll
  for(int d0=0;d0<4;++d0){
    const bf16x8 b0=*reinterpret_cast<const bf16x8*>(kb+d0*2048);
    const bf16x8 b1=*reinterpret_cast<const bf16x8*>(kb+d0*2048+512);
    if(d0==0){p0=__builtin_amdgcn_mfma_f32_32x32x16_bf16(b0,qr[0],negm,0,0,0);p1=__builtin_amdgcn_mfma_f32_32x32x16_bf16(b1,qr[0],negm,0,0,0);}
    else{p0=__builtin_amdgcn_mfma_f32_32x32x16_bf16(b0,qr[d0],p0,0,0,0);p1=__builtin_amdgcn_mfma_f32_32x32x16_bf16(b1,qr[d0],p1,0,0,0);}}
}
typedef __attribute__((address_space(3))) const char* lds_cptr;
typedef short v4i16_t __attribute__((ext_vector_type(4)));
__device__ __forceinline__ void kload8(bf16x8*kf,lds_cptr kp){
  kf[0]=*(const __attribute__((address_space(3))) bf16x8*)(kp);      kf[1]=*(const __attribute__((address_space(3))) bf16x8*)(kp+512);
  kf[2]=*(const __attribute__((address_space(3))) bf16x8*)(kp+2048); kf[3]=*(const __attribute__((address_space(3))) bf16x8*)(kp+2560);
  kf[4]=*(const __attribute__((address_space(3))) bf16x8*)(kp+4096); kf[5]=*(const __attribute__((address_space(3))) bf16x8*)(kp+4608);
  kf[6]=*(const __attribute__((address_space(3))) bf16x8*)(kp+6144); kf[7]=*(const __attribute__((address_space(3))) bf16x8*)(kp+6656);
}
__device__ __forceinline__ void kload2(bf16x8*kf,lds_cptr kp,int j){ kf[2*j]=*(const __attribute__((address_space(3))) bf16x8*)(kp+j*2048); kf[2*j+1]=*(const __attribute__((address_space(3))) bf16x8*)(kp+j*2048+512); }
__device__ __forceinline__ s16x4 vtr(lds_cptr p){ return __builtin_bit_cast(s16x4,__builtin_amdgcn_ds_read_tr16_b64_v4i16((__attribute__((address_space(3))) v4i16_t*)p)); }
__device__ __forceinline__ float rowmax(const f32x16&p0,const f32x16&p1){
  float a=max3f(p0[0],p0[1],p1[0]),b=max3f(p0[2],p0[3],p1[1]);a=max3f(a,p1[2],p1[3]);
  #pragma unroll
  for(int r=4;r<16;r+=4){a=max3f(a,p0[r],p0[r+1]);b=max3f(b,p0[r+2],p0[r+3]);a=max3f(a,p1[r],p1[r+1]);b=max3f(b,p1[r+2],p1[r+3]);}
  const float m=max2f(a,b);
  auto rr=__builtin_amdgcn_permlane32_swap(__float_as_uint(m),__float_as_uint(m),false,false);
  return max2f(__uint_as_float(rr[0]),__uint_as_float(rr[1]));
}
__device__ __forceinline__ void pv(f32x16*o,int vb,bf16x8 pa0,bf16x8 pa1,bf16x8 pa2,bf16x8 pa3){
  #pragma unroll
  for(int d0=0;d0<2;++d0){s16x4 lo[4],hi[4];
    #pragma unroll
    for(int ks=0;ks<4;++ks){
      asm volatile("ds_read_b64_tr_b16 %0,%1 offset:%c2":"=&v"(lo[ks]):"v"(vb),"i"(d0*4096+ks*1024):"memory");
      asm volatile("ds_read_b64_tr_b16 %0,%1 offset:%c2":"=&v"(hi[ks]):"v"(vb),"i"(d0*4096+ks*1024+512):"memory");}
    asm volatile("s_waitcnt lgkmcnt(0)":::"memory");SBAR();
    #define PK(k) (bf16x8){lo[k][0],lo[k][1],lo[k][2],lo[k][3],hi[k][0],hi[k][1],hi[k][2],hi[k][3]}
    o[d0]=__builtin_amdgcn_mfma_f32_32x32x16_bf16(pa0,PK(0),o[d0],0,0,0);
    o[d0]=__builtin_amdgcn_mfma_f32_32x32x16_bf16(pa1,PK(1),o[d0],0,0,0);
    o[d0]=__builtin_amdgcn_mfma_f32_32x32x16_bf16(pa2,PK(2),o[d0],0,0,0);
    o[d0]=__builtin_amdgcn_mfma_f32_32x32x16_bf16(pa3,PK(3),o[d0],0,0,0);
    #undef PK
  }
}

#ifndef ATTN_STORE16
#define ATTN_STORE16(p,v) (*(u32x4*)(p)=(v))
#endif
template<int THRL> __device__ __forceinline__ void attn_unit(int b,int h,int qb,const bf16*Q,const bf16*__restrict__ K,const bf16*__restrict__ V,bf16*O,const float*ksum,char*shm){
  int tid_l=threadIdx.x; asm volatile("":"+v"(tid_l)); const int tid=tid_l,lane=tid&63,r32=lane&31,hi=lane>>5; const int wid=__builtin_amdgcn_readfirstlane(tid>>6);
  const long rowbase=(long)b*SEQ; const int q0=qb*QB;
  const bf16*Qw=Q+(rowbase+q0+wid*QBLK)*DM+h*D;
  const bf16*Kh=K+rowbase*DM+h*D,*Vh=V+rowbase*DM+h*D;
  const unsigned lds0=(unsigned)(uintptr_t)shm;
  float*wsf=(float*)(shm+LDS_WS)+wid*64;
  const bf16*ksrc=Kh+(long)lane*DM+wid*8;
  const bf16*vsrc=Vh+(long)(16*(wid&3)+(lane>>2))*DM+(wid>>2)*32+(lane&3)*8;
  const unsigned kdst=lds0+LDS_K+wid*1024, vdst=lds0+LDS_V+wid*1024;
  #define DMA_K(t,slot) glds16(ksrc+(long)(t)*KVBLK*DM,(unsigned)__builtin_amdgcn_readfirstlane(kdst+(slot)))
  #define DMA_V(t,slot) glds16(vsrc+(long)(t)*KVBLK*DM,(unsigned)__builtin_amdgcn_readfirstlane(vdst+(slot)))
  const int vb0=(int)(lds0+LDS_V)+((lane>>4)&1)*32+(lane&3)*8+(4*hi+((lane&15)>>2))*64;
  const char*Kbase=shm+LDS_K; bf16x8 kf[8];
  const lds_cptr shm3=(lds_cptr)shm; const lds_cptr kp0=shm3+LDS_K+hi*1024+r32*16; const lds_cptr vp0=shm3+LDS_V+((lane>>4)&1)*32+(lane&3)*8+(4*hi+((lane&15)>>2))*64;
  const int NT=(q0+QB)/KVBLK;
  DMA_K(0,0);DMA_V(0,0);DMA_K(1,SLOTB);
  bf16x8 qr[4];
  #pragma unroll
  for(int d0=0;d0<4;++d0)qr[d0]=*reinterpret_cast<const bf16x8*>(&Qw[(long)r32*DM+d0*16+hi*8]);

  unsigned selmask=1u<<qb;
  if(qb>0){
    float gt[7];
    #pragma unroll
    for(int n=0;n<7;++n){ float s=-INFINITY;
      if(n<qb){ const float*km=ksum+((size_t)(b*8+n))*512+h*64; s=0.f;
        #pragma unroll
        for(int d0=0;d0<4;++d0){ const f32x4_t k0=*reinterpret_cast<const f32x4_t*>(km+d0*16+hi*8),k1=*reinterpret_cast<const f32x4_t*>(km+d0*16+hi*8+4);
          #pragma unroll
          for(int e=0;e<4;++e){ s+=__uint_as_float(((unsigned)(unsigned short)qr[d0][e])<<16)*k0[e]; s+=__uint_as_float(((unsigned)(unsigned short)qr[d0][4+e])<<16)*k1[e]; } }
        s+=__shfl_xor(s,32); }
      gt[n]=s; }
    #pragma unroll
    for(int n=0;n<7;++n){ int rank=0;
      #pragma unroll
      for(int m2=0;m2<7;++m2){ if(m2!=n) rank+=((gt[m2]>gt[n])||((gt[m2]==gt[n])&&(m2<n)))?1:0; }
      if(n<qb&&rank<3)selmask|=(1u<<n); }
  }
  #define MMASK(P0,P1,t) do{ if(!((selmask>>((t)>>2))&1u)){ _Pragma("unroll") for(int r=0;r<16;++r){P0[r]=-INFINITY;P1[r]=-INFINITY;} } }while(0)
  float mhat=0.f,l_reg=0.f;f32x16 o[2];o[0]=f32x16{};o[1]=f32x16{};f32x16 negm=f32x16{};asm volatile("":"+v"(negm));
  const int qrel=wid*QBLK+r32;
  #define CMASK(P0,P1,t) do{int jb_=(t)-(NT-4); if(jb_>=0)cmask(P0,P1,jb_,qrel,hi);}while(0)
  bool resc=false;
  #define START(P0,P1) do{ const float rm=rowmax(P0,P1); resc=false; \
    { const float dl=rm; mhat=fadd_s(mhat,dl); \
      _Pragma("unroll") for(int r=0;r<16;++r){P0[r]=fsub_s(P0[r],dl);P1[r]=fsub_s(P1[r],dl);} \
      _Pragma("unroll") for(int r=0;r<16;++r)negm[r]=-mhat; asm volatile("":"+v"(negm)); } \
    _Pragma("unroll") for(int r=0;r<16;++r)P0[r]=__builtin_amdgcn_exp2f(P0[r]); }while(0)
  #define RESC() do{ if(resc){ asm volatile("s_waitcnt lgkmcnt(0)":::"memory"); \
      _Pragma("unroll") for(int d_=0;d_<2;++d_) _Pragma("unroll") for(int r=0;r<16;++r)o[d_][r]*=wsf[crow(r,hi)]; } }while(0)
  f32x16 pA0,pA1,pB0,pB1;
  int sl_prev=0,sl_cur=0,sl_next=SLOTB;
  #define ROT() do{sl_prev=sl_cur;sl_cur=sl_next;sl_next=(sl_next==(NSLOT-1)*SLOTB)?0:sl_next+SLOTB;}while(0)
  DMA_K(2,2*SLOTB);
  WAIT_BAR(3);
  qkt(pA0,pA1,Kbase,qr,negm,r32,hi);asm volatile("s_nop 15\n\ts_nop 7":"+v"(pA0),"+v"(pA1));CMASK(pA0,pA1,0);
  START(pA0,pA1);
  _Pragma("unroll") for(int r=0;r<16;++r)pA1[r]=__builtin_amdgcn_exp2f(pA1[r]);
  if(!(selmask&1u)){ _Pragma("unroll") for(int r=0;r<16;++r){pA0[r]=0.f;pA1[r]=0.f;} }
  WAIT_BAR(0);
  DMA_K(3,0);DMA_V(1,SLOTB);
  ROT();
  kload8(kf,kp0+sl_cur);
  WAIT_BAR(2);
  s16x4 vlo[8],vhi[8]; u32x4 pw0,pw1,pw2,pw3;
  #define PKW(P,B) cvtpk_s(P[B],P[B+1])
  #define PAF(k) __builtin_bit_cast(bf16x8,pw##k)
  #define VFR(i) (bf16x8){vlo[i][0],vlo[i][1],vlo[i][2],vlo[i][3],vhi[i][0],vhi[i][1],vhi[i][2],vhi[i][3]}
  #define PIN(x) asm volatile("":"+v"(x))
  #define MX3(a,b,c) __builtin_fmaxf(__builtin_fmaxf((a),(b)),(c))
  #define GAPA(MF,A0,A1,A2,A3,W0,W1,PW) do{ MF; sacc+=A0; sacc+=A1; sacc+=A2; sacc+=A3; PIN(sacc); W0; W1; PIN(PW); SBAR(); }while(0)
  #define EX(v) __builtin_amdgcn_exp2f(v)
  #define GAPB(MF,X,B) do{ MF; X[B]=EX(X[B]); X[B+1]=EX(X[B+1]); X[B+2]=EX(X[B+2]); X[B+3]=EX(X[B+3]); PIN(X); SBAR(); }while(0)
  #define VRD(i) do{ vlo[i]=vtr(vp_+(((i)>>2)*4096+((i)&3)*1024)); vhi[i]=vtr(vp_+(((i)>>2)*4096+((i)&3)*1024+512)); }while(0)
  #define KRD(G,j) do{ if(G){ kload2(kf,kp0+sl_next,j); SBAR(); } }while(0)
  #define STEP(C0,C1,P0,P1,t,GK,GV,GL) do{ SBAR(); \
    const lds_cptr vp_=vp0+sl_prev; \
    VRD(0); SBAR(); float sacc=(P0[0]+P0[1]); \
    GAPA(C0=__builtin_amdgcn_mfma_f32_32x32x16_bf16(kf[0],qr[0],negm,0,0,0), P0[2],P0[3],P0[4],P0[5],     pw0[0]=PKW(P0,0), pw0[1]=PKW(P0,2), pw0); \
    VRD(4); SBAR(); GAPA(C1=__builtin_amdgcn_mfma_f32_32x32x16_bf16(kf[1],qr[0],negm,0,0,0), P0[6],P0[7],P0[8],P0[9],     pw0[2]=PKW(P0,4), pw0[3]=PKW(P0,6), pw0); \
    VRD(1); SBAR(); GAPA(C0=__builtin_amdgcn_mfma_f32_32x32x16_bf16(kf[2],qr[1],C0,0,0,0),   P0[10],P0[11],P0[12],P0[13], pw1[0]=PKW(P0,8), pw1[1]=PKW(P0,10), pw1); \
    VRD(5); SBAR(); GAPA(C1=__builtin_amdgcn_mfma_f32_32x32x16_bf16(kf[3],qr[1],C1,0,0,0),   P0[14],P0[15],P1[0],P1[1],   pw1[2]=PKW(P0,12),pw1[3]=PKW(P0,14), pw1); \
    VRD(2); SBAR(); GAPA(C0=__builtin_amdgcn_mfma_f32_32x32x16_bf16(kf[4],qr[2],C0,0,0,0),   P1[2],P1[3],P1[4],P1[5],     pw2[0]=PKW(P1,0), pw2[1]=PKW(P1,2), pw2); \
    VRD(6); SBAR(); GAPA(C1=__builtin_amdgcn_mfma_f32_32x32x16_bf16(kf[5],qr[2],C1,0,0,0),   P1[6],P1[7],P1[8],P1[9],     pw2[2]=PKW(P1,4), pw2[3]=PKW(P1,6), pw2); \
    VRD(3); SBAR(); GAPA(C0=__builtin_amdgcn_mfma_f32_32x32x16_bf16(kf[6],qr[3],C0,0,0,0),   P1[10],P1[11],P1[12],P1[13], pw3[0]=PKW(P1,8), pw3[1]=PKW(P1,10), pw3); \
    VRD(7); SBAR(); GAPA(C1=__builtin_amdgcn_mfma_f32_32x32x16_bf16(kf[7],qr[3],C1,0,0,0),   P1[14],P1[15],0.f,0.f,       pw3[2]=PKW(P1,12),pw3[3]=PKW(P1,14), pw3); \
    l_reg+=sacc; \
    if(GK){DMA_K((t)+3,sl_cur);} if(GV){DMA_V((t)+1,sl_next);} \
    CMASK(C0,C1,t); \
    { float a=MX3(C0[0],C0[1],C1[0]),b=MX3(C0[2],C0[3],C1[1]); a=MX3(a,C1[2],C1[3]); \
      _Pragma("unroll") for(int r=4;r<16;r+=4){a=MX3(a,C0[r],C0[r+1]);b=MX3(b,C0[r+2],C0[r+3]);a=MX3(a,C1[r],C1[r+1]);b=MX3(b,C1[r+2],C1[r+3]);} \
      float rm=__builtin_fmaxf(a,b); { auto rr=__builtin_amdgcn_permlane32_swap(__float_as_uint(rm),__float_as_uint(rm),false,false); rm=__builtin_fmaxf(__uint_as_float(rr[0]),__uint_as_float(rr[1])); } \
      resc=false; \
      if(__builtin_expect(__any(rm>(float)THRL),0)){ const float dl=__builtin_fmaxf(rm,0.f); mhat+=dl; \
        _Pragma("unroll") for(int r=0;r<16;++r){C0[r]-=dl;C1[r]-=dl;} \
        _Pragma("unroll") for(int r=0;r<16;++r)negm[r]=-mhat; asm volatile("":"+v"(negm)); \
        const float f=__builtin_amdgcn_exp2f(-dl); l_reg*=f; if(hi==0)wsf[r32]=f; resc=true; } } \
    MMASK(C0,C1,t); \
    SBAR(); \
    GAPB(o[0]=__builtin_amdgcn_mfma_f32_32x32x16_bf16(PAF(0),VFR(0),o[0],0,0,0), C0,0); \
    GAPB(o[1]=__builtin_amdgcn_mfma_f32_32x32x16_bf16(PAF(0),VFR(4),o[1],0,0,0), C0,4); \
    KRD(GL,0); GAPB(o[0]=__builtin_amdgcn_mfma_f32_32x32x16_bf16(PAF(1),VFR(1),o[0],0,0,0), C0,8); \
    KRD(GL,1); GAPB(o[1]=__builtin_amdgcn_mfma_f32_32x32x16_bf16(PAF(1),VFR(5),o[1],0,0,0), C0,12); \
    KRD(GL,2); GAPB(o[0]=__builtin_amdgcn_mfma_f32_32x32x16_bf16(PAF(2),VFR(2),o[0],0,0,0), C1,0); \
    KRD(GL,3); GAPB(o[1]=__builtin_amdgcn_mfma_f32_32x32x16_bf16(PAF(2),VFR(6),o[1],0,0,0), C1,4); \
    GAPB(o[0]=__builtin_amdgcn_mfma_f32_32x32x16_bf16(PAF(3),VFR(3),o[0],0,0,0), C1,8); \
    GAPB(o[1]=__builtin_amdgcn_mfma_f32_32x32x16_bf16(PAF(3),VFR(7),o[1],0,0,0), C1,12); \
    }while(0)
  int t=1;
  #undef CMASK
  #define CMASK(P0,P1,t) do{}while(0)
  for(;t+5<NT;t+=2){
    STEP(pB0,pB1,pA0,pA1,t,true,true,true);     WAIT_BAR(2); RESC(); ROT();
    STEP(pA0,pA1,pB0,pB1,t+1,true,true,true);   WAIT_BAR(2); RESC(); ROT();
  }
  #undef CMASK
  #define CMASK(P0,P1,t) do{int jb_=(t)-(NT-4); if(jb_>=0)cmask(P0,P1,jb_,qrel,hi);}while(0)
  #define ENDW(tt) do{ if((tt)+3<NT){WAIT_BAR(2);} else if((tt)+2<NT){WAIT_BAR(1);} else {WAIT_BAR(0);} }while(0)
  for(;t+1<NT;t+=2){
    STEP(pB0,pB1,pA0,pA1,t,(t+3<NT),(t+1<NT),(t+1<NT));       ENDW(t);   RESC(); ROT();
    STEP(pA0,pA1,pB0,pB1,t+1,(t+4<NT),(t+2<NT),(t+2<NT));     ENDW(t+1); RESC(); ROT();
  }
  STEP(pB0,pB1,pA0,pA1,NT-1,false,false,false); RESC();
  { float sacc=pB0[0]+pB0[1]; _Pragma("unroll") for(int r=2;r<16;++r)sacc+=pB0[r]; _Pragma("unroll") for(int r=0;r<16;++r)sacc+=pB1[r]; l_reg+=sacc;
    pw0=(u32x4){PKW(pB0,0),PKW(pB0,2),PKW(pB0,4),PKW(pB0,6)};pw1=(u32x4){PKW(pB0,8),PKW(pB0,10),PKW(pB0,12),PKW(pB0,14)};pw2=(u32x4){PKW(pB1,0),PKW(pB1,2),PKW(pB1,4),PKW(pB1,6)};pw3=(u32x4){PKW(pB1,8),PKW(pB1,10),PKW(pB1,12),PKW(pB1,14)};
    SBAR(); pv(o,vb0+sl_cur,PAF(0),PAF(1),PAF(2),PAF(3)); }
  #undef PKW
  #undef PAF
  #undef VFR
  #undef PIN
  #undef MX3
  #undef GAPA
  #undef GAPB
  #undef EX
  #undef VRD
  #undef KRD
  #undef STEP
  #undef ENDW
  {auto rr=__builtin_amdgcn_permlane32_swap(__float_as_uint(l_reg),__float_as_uint(l_reg),false,false);l_reg=__uint_as_float(rr[0])+__uint_as_float(rr[1]);}
  if(hi==0)wsf[32+r32]=l_reg;asm volatile("s_waitcnt lgkmcnt(0)":::"memory");
  float rli[16];
  #pragma unroll
  for(int r=0;r<16;++r)rli[r]=__builtin_amdgcn_rcpf(wsf[32+crow(r,hi)]);
  bf16*Ow=O+(rowbase+q0+wid*QBLK)*DM+h*D;
  { bf16*stg=(bf16*)(shm+LDS_OST)+wid*2048;
    #pragma unroll
    for(int r=0;r<16;++r){const int orow=crow(r,hi);
      #pragma unroll
      for(int d0=0;d0<2;++d0)stg[orow*64+d0*32+r32]=__float2bfloat16(o[d0][r]*rli[r]);}
    asm volatile("s_waitcnt lgkmcnt(0)":::"memory");
    #pragma unroll
    for(int i=0;i<4;++i){const int row=i*8+(lane>>3),ch=lane&7; const u32x4 v=*(const u32x4*)(stg+row*64+ch*8); ATTN_STORE16(Ow+(long)row*DM+ch*8,v);} }
  asm volatile("s_waitcnt lgkmcnt(0)\n\ts_barrier":::"memory");
  #undef MMASK
  #undef DMA_K
  #undef DMA_V
  #undef CMASK
  #undef START
  #undef RESC
  #undef ROT
}
constexpr int ATTN_LDS_BYTES=LDS_BYTES;
struct AttnTensors { const bf16* Q; const bf16* K; const bf16* V; bf16* O; };
struct AttnUnit { int bh; int qb; };
struct StaticOrder {
  int vcu;
  __device__ __forceinline__ explicit StaticOrder(int grid,int block):vcu((block%8)*(grid/8)+block/8){}
  __device__ __forceinline__ bool next(int i,AttnUnit&u)const{ if(i>=4)return false; const int s=vcu&7; u.bh=vcu>>3; u.qb=(i==0)?s:(i==1)?15-s:(i==2)?16+s:31-s; return true; }
  __device__ __forceinline__ void a_ready(const AttnUnit&)const{}
  __device__ __forceinline__ void done(const AttnUnit&)const{}
};
template<class Sched,int THRL=8> __device__ __forceinline__ void attn_phase(char*lds,const AttnTensors&T,const Sched&S){
  AttnUnit u;
  for(int i=0;S.next(i,u);++i){ S.a_ready(u); attn_unit<THRL>(u.bh/NHEAD,u.bh%NHEAD,u.qb,T.Q,T.K,T.V,T.O,lds); S.done(u); }
}
#undef SBAR
#undef WAIT_BAR
}
#define LAS __attribute__((address_space(3)))
typedef unsigned short bf16;
typedef unsigned v4u __attribute__((ext_vector_type(4)));
typedef unsigned v2u __attribute__((ext_vector_type(2)));
typedef float f32x4 __attribute__((ext_vector_type(4)));
typedef float f32x2 __attribute__((ext_vector_type(2)));
typedef float f32x16 __attribute__((ext_vector_type(16)));
typedef short bf16x8 __attribute__((ext_vector_type(8)));
constexpr int NB = 8, SEQ = 2048, DM = 1024, M = NB * SEQ, DFF = 4096;
constexpr int NIN = 7424;
constexpr int NMIX = 4352;
constexpr float EPS = 1e-6f;
constexpr size_t MiB = 1u << 20;
constexpr size_t WS_CTL = 0, WS_ROPEC = 1 * MiB, WS_ROPES = 3 * MiB, WS_KMEAN = 5 * MiB;
constexpr size_t WS_WIN = 6 * MiB, WS_WBO = WS_WIN + (size_t)NIN * DM * 2, WS_WMIX = WS_WBO + 3 * MiB, WS_WUP = WS_WMIX + 2 * MiB, WS_WDN = WS_WUP + 8 * MiB;
static_assert(WS_WDN + 8 * MiB <= 42 * MiB, "weights");
constexpr size_t WS_XN = 42 * MiB;
constexpr size_t WS_Q = 74 * MiB, WS_LR = 90 * MiB, WS_CONV = 106 * MiB, WS_K = 122 * MiB, WS_V = 138 * MiB, WS_LQ = 154 * MiB, WS_LK = 162 * MiB, WS_LV = 170 * MiB,
                 WS_CA = 186 * MiB, WS_CG = 202 * MiB, WS_G = 218 * MiB;
constexpr size_t WS_YB = 122 * MiB, WS_MB = 74 * MiB, WS_Y = 106 * MiB, WS_H = 74 * MiB, WS_Y2 = 202 * MiB, WS_END = 256 * MiB;
constexpr int LDS_RING = 131072, LDS_BYTES = LDS_RING + 1024;

__device__ __forceinline__ unsigned f2bf(float f) { unsigned u = __builtin_bit_cast(unsigned, f); return (u + 0x7fffu + ((u >> 16) & 1u)) >> 16; }
__device__ __forceinline__ unsigned pk2(float lo, float hi) { return pg8::cvt_pk_bf16(lo, hi); }
__device__ __forceinline__ float bflo(unsigned w) { return __uint_as_float(w << 16); }
__device__ __forceinline__ float bfhi(unsigned w) { return __uint_as_float(w & 0xffff0000u); }
__device__ __forceinline__ float bf1(unsigned short h) { return __uint_as_float(((unsigned)h) << 16); }
__device__ __forceinline__ float sigmf(float x) { return 1.0f / (1.0f + __expf(-x)); }
__device__ __forceinline__ float wave_sum(float v) {
#pragma unroll
    for (int o = 1; o < 64; o <<= 1) v += __shfl_xor(v, o);
    return v;
}
__constant__ float c_inv_freq[32] = {1.0f, 0.7498942613601685f, 0.5623413324356079f, 0.4216965138912201f, 0.3162277638912201f, 0.23713737726211548f, 0.17782793939113617f, 0.133352130651474f, 0.10000000149011612f, 0.07498941570520401f, 0.05623413249850273f, 0.04216965287923813f, 0.03162277489900589f, 0.023713737726211548f, 0.017782794311642647f, 0.01333521492779255f, 0.009999999776482582f, 0.007498941849917173f, 0.005623413249850273f, 0.0042169648222625256f, 0.003162277629598975f, 0.00237137358635664f, 0.0017782794311642647f, 0.0013335214462131262f, 0.0010000000474974513f, 0.0007498942431993783f, 0.000562341301701963f, 0.0004216965171508491f, 0.0003162277571391314f, 0.00023713737027719617f, 0.00017782794020604342f, 0.0001333521504420787f};

__device__ __forceinline__ int src_inproj(int n) {
    if (n < 1024) { const int sec = n >> 9, w = n & 511, hd = w >> 6, j = w & 63; return sec * 512 + hd * 64 + (j >> 1) + 32 * (j & 1); }
    if (n < 2560) return n;
    if (n < 2816) return -(n - 2560) - 1;
    return n - 240;
}
template <bool INPROJ> __device__ __forceinline__ void wt_item(const float* W, int K, int ldw, int nblk, bf16* WT, const float* A2, LAS float* scr, int item, int lane) {
    const int kb = item / nblk, nb = item % nblk, k0 = 64 * kb, n0 = 32 * nb;
    const int nd = n0 + (lane & 31); const int src = INPROJ ? src_inproj(nd) : nd;
    if (INPROJ && src < 0) {
        const int nn = -(src + 1);
        float a2[16];
#pragma unroll
        for (int r = 0; r < 16; ++r) a2[r] = A2[r * 256 + nn];
#pragma unroll 2
        for (int i = 0; i < 32; ++i) { const int kk = 2 * i + (lane >> 5); const float* wr = W + (size_t)(k0 + kk) * ldw + 2560; float s = 0.f;
#pragma unroll
            for (int r = 0; r < 16; r += 4) { const f32x4 w4 = *(const f32x4*)(wr + r); s += w4[0] * a2[r] + w4[1] * a2[r + 1] + w4[2] * a2[r + 2] + w4[3] * a2[r + 3]; }
            scr[kk * 33 + (lane & 31)] = s; }
    } else {
#pragma unroll 8
        for (int i = 0; i < 32; ++i) { const int kk = 2 * i + (lane >> 5); scr[kk * 33 + (lane & 31)] = W[(size_t)(k0 + kk) * ldw + src]; }
    }
    asm volatile("s_waitcnt lgkmcnt(0)" ::: "memory");
    const int c = lane & 7;
#pragma unroll
    for (int j = 0; j < 4; ++j) { const int n = (lane >> 3) + 8 * j; const LAS float* s = scr + (8 * c) * 33 + n;
        v4u o; o.x = pk2(s[0 * 33], s[1 * 33]); o.y = pk2(s[2 * 33], s[3 * 33]); o.z = pk2(s[4 * 33], s[5 * 33]); o.w = pk2(s[6 * 33], s[7 * 33]);
        *(v4u*)(WT + (size_t)(n0 + n) * K + k0 + 8 * c) = o; }
    asm volatile("s_waitcnt lgkmcnt(0)" ::: "memory");
}
struct LayerW { const float *w_in, *a2, *w_mo, *w_go, *w_co, *w_mix, *w_up, *w_dn; };
__device__ __forceinline__ void convert_weights(const LayerW& L, unsigned char* ws, LAS unsigned char* lds, int gw, int NGW, int wave, int lane) {
    LAS float* scr = (LAS float*)(lds + wave * 16384);
    bf16* Win = (bf16*)(ws + WS_WIN); bf16* Wbo = (bf16*)(ws + WS_WBO); bf16* Wmix = (bf16*)(ws + WS_WMIX); bf16* Wup = (bf16*)(ws + WS_WUP); bf16* Wdn = (bf16*)(ws + WS_WDN);
    constexpr int I_IN = (DM / 64) * (NIN / 32), I_BO = (512 / 64) * (DM / 32), I_MIX = (DM / 64) * (DM / 32), I_UP = (DM / 64) * (DFF / 32), I_DN = (DFF / 64) * (DM / 32);
    constexpr int NITEMS = I_IN + 3 * I_BO + I_MIX + I_UP + I_DN;
    for (int it = gw; it < NITEMS; it += NGW) {
        int r = it;
        if (r < I_IN) { wt_item<true>(L.w_in, DM, 7184, NIN / 32, Win, L.a2, scr, r, lane); continue; } r -= I_IN;
        if (r < I_BO) { wt_item<false>(L.w_mo, 512, DM, DM / 32, Wbo, nullptr, scr, r, lane); continue; } r -= I_BO;
        if (r < I_BO) { wt_item<false>(L.w_go, 512, DM, DM / 32, Wbo + 512 * 1024, nullptr, scr, r, lane); continue; } r -= I_BO;
        if (r < I_BO) { wt_item<false>(L.w_co, 512, DM, DM / 32, Wbo + 2 * 512 * 1024, nullptr, scr, r, lane); continue; } r -= I_BO;
        if (r < I_MIX) { wt_item<false>(L.w_mix, DM, DM, DM / 32, Wmix, nullptr, scr, r, lane); continue; } r -= I_MIX;
        if (r < I_UP) { wt_item<false>(L.w_up, DM, DFF, DFF / 32, Wup, nullptr, scr, r, lane); continue; } r -= I_UP;
        wt_item<false>(L.w_dn, DFF, DM, DM / 32, Wdn, nullptr, scr, r, lane);
    }
}
__device__ __forceinline__ void row_phase(const float* hin, const bf16* Y, const float* gY, float* hout, const float* gN, bf16* XN, int gw, int NGW, int lane) {
    for (int m = gw; m < M; m += NGW) {
        const f32x4* xr = (const f32x4*)(hin + (size_t)m * DM) + lane;
        f32x4 v[4];
#pragma unroll
        for (int j = 0; j < 4; ++j) v[j] = xr[64 * j];
        if (Y) {
            const v2u* yr = (const v2u*)(Y + (size_t)m * DM) + lane; f32x4 y[4]; float s = 0.f;
#pragma unroll
            for (int j = 0; j < 4; ++j) { const v2u w = yr[64 * j]; y[j] = (f32x4){bflo(w.x), bfhi(w.x), bflo(w.y), bfhi(w.y)}; s += (y[j].x * y[j].x + y[j].y * y[j].y) + (y[j].z * y[j].z + y[j].w * y[j].w); }
            const float rstd = rsqrtf(wave_sum(s) * (1.f / DM) + EPS);
            f32x4* ho = (f32x4*)(hout + (size_t)m * DM) + lane;
#pragma unroll
            for (int j = 0; j < 4; ++j) { const f32x4 g = ((const f32x4*)gY)[lane + 64 * j]; v[j] = v[j] + y[j] * rstd * g; ho[64 * j] = v[j]; }
        }
        if (XN) {
            float s = 0.f;
#pragma unroll
            for (int j = 0; j < 4; ++j) s += (v[j].x * v[j].x + v[j].y * v[j].y) + (v[j].z * v[j].z + v[j].w * v[j].w);
            const float rstd = rsqrtf(wave_sum(s) * (1.f / DM) + EPS);
            v2u* o8 = (v2u*)(XN + (size_t)m * DM) + lane;
#pragma unroll
            for (int j = 0; j < 4; ++j) { const f32x4 g = ((const f32x4*)gN)[lane + 64 * j]; const f32x4 t = v[j] * rstd * g; v2u w; w.x = pk2(t.x, t.y); w.y = pk2(t.z, t.w); o8[64 * j] = w; }
        }
    }
}
constexpr int GL_QS = 0, GL_KS = 9216, GL_KT = 18432, GL_VT = 27648, GL_AS = 46080, GL_ST = 55296, GL_OS = 92160, GL_TOT = 125952, GL_DEC = 128000;
__device__ __forceinline__ int crow16(int r, int hi) { return (r & 3) + 8 * (r >> 2) + 4 * hi; }
__device__ __forceinline__ void gla_unit(int bh, const bf16* lq, const bf16* lk, const bf16* lv, const float* gdec, bf16* lr, const float* gnorm, LAS unsigned char* lds) {
    int tid_l = threadIdx.x; asm volatile("" : "+v"(tid_l));
    const int tid = tid_l, lane = tid & 63, l31 = lane & 31, hi = lane >> 5; const int w = __builtin_amdgcn_readfirstlane(tid >> 6);
    const int b = bh >> 2, hh = bh & 3; const size_t rowbase = (size_t)b * SEQ;
    LAS bf16* Qs = (LAS bf16*)(lds + GL_QS); LAS bf16* Ks = (LAS bf16*)(lds + GL_KS); LAS bf16* KT = (LAS bf16*)(lds + GL_KT); LAS bf16* VT = (LAS bf16*)(lds + GL_VT);
    LAS bf16* As = (LAS bf16*)(lds + GL_AS); LAS bf16* ST = (LAS bf16*)(lds + GL_ST); LAS float* Os = (LAS float*)(lds + GL_OS); LAS float* tot = (LAS float*)(lds + GL_TOT); LAS float* dec = (LAS float*)(lds + GL_DEC);
    const int dt = w >> 2, vt = w & 3;
    f32x16 sacc;
#pragma unroll
    for (int r = 0; r < 16; ++r) sacc[r] = 0.f;
    for (int i = tid; i < 128 * 72 / 2; i += 512) ((LAS unsigned*)ST)[i] = 0u;
    for (int c = 0; c < SEQ / 64; ++c) {
        const size_t r0 = rowbase + (size_t)c * 64 + 8 * w;
        float gl[8]; unsigned short qv[8], kv[8], vv0[8], vv1[8];
#pragma unroll
        for (int t = 0; t < 8; ++t) { const size_t row = r0 + t; gl[t] = gdec[row * 256 + hh * 64 + lane]; qv[t] = lq[row * 256 + hh * 64 + lane]; kv[t] = lk[row * 256 + hh * 64 + lane];
            vv0[t] = lv[row * 512 + hh * 128 + lane]; vv1[t] = lv[row * 512 + hh * 128 + 64 + lane]; }
#pragma unroll
        for (int t = 1; t < 8; ++t) gl[t] += gl[t - 1];
        tot[w * 64 + lane] = gl[7];
        __syncthreads();
        float off = 0.f, glast = 0.f;
#pragma unroll
        for (int j = 0; j < 8; ++j) { const float tj = tot[j * 64 + lane]; glast += tj; if (j < w) off += tj; }
        unsigned kt[4];
#pragma unroll
        for (int t = 0; t < 8; t += 2) {
            const float G0 = off + gl[t], G1 = off + gl[t + 1];
            const float q0 = bf1(qv[t]) * __expf(G0), q1 = bf1(qv[t + 1]) * __expf(G1), k0 = bf1(kv[t]) * __expf(-G0), k1 = bf1(kv[t + 1]) * __expf(-G1);
            const unsigned qp = pk2(q0, q1), kp = pk2(k0, k1);
            Qs[(8 * w + t) * 72 + lane] = (bf16)(qp & 0xffffu); Qs[(8 * w + t + 1) * 72 + lane] = (bf16)(qp >> 16);
            Ks[(8 * w + t) * 72 + lane] = (bf16)(kp & 0xffffu); Ks[(8 * w + t + 1) * 72 + lane] = (bf16)(kp >> 16);
            kt[t >> 1] = kp; }
        *(LAS v4u*)(KT + lane * 72 + 8 * w) = (v4u){kt[0], kt[1], kt[2], kt[3]};
        *(LAS v4u*)(VT + lane * 72 + 8 * w) = (v4u){(unsigned)vv0[0] | ((unsigned)vv0[1] << 16), (unsigned)vv0[2] | ((unsigned)vv0[3] << 16), (unsigned)vv0[4] | ((unsigned)vv0[5] << 16), (unsigned)vv0[6] | ((unsigned)vv0[7] << 16)};
        *(LAS v4u*)(VT + (64 + lane) * 72 + 8 * w) = (v4u){(unsigned)vv1[0] | ((unsigned)vv1[1] << 16), (unsigned)vv1[2] | ((unsigned)vv1[3] << 16), (unsigned)vv1[4] | ((unsigned)vv1[5] << 16), (unsigned)vv1[6] | ((unsigned)vv1[7] << 16)};
        if (w == 0) dec[lane] = __expf(glast);
        __syncthreads();
        {
#pragma unroll
            for (int kk = 0; kk < 4; ++kk) { const bf16x8 a = *(const LAS bf16x8*)(KT + (32 * dt + l31) * 72 + kk * 16 + hi * 8), bb = *(const LAS bf16x8*)(VT + (32 * vt + l31) * 72 + kk * 16 + hi * 8);
                sacc = __builtin_amdgcn_mfma_f32_32x32x16_bf16(a, bb, sacc, 0, 0, 0); }
            LAS bf16* Sn = ST + ((c + 1) & 1) * (128 * 72);
#pragma unroll
            for (int g = 0; g < 4; ++g) { const int d0 = 32 * dt + 8 * g + 4 * hi; const f32x4 dv = *(const LAS f32x4*)(dec + d0);
                sacc[4 * g] *= dv[0]; sacc[4 * g + 1] *= dv[1]; sacc[4 * g + 2] *= dv[2]; sacc[4 * g + 3] *= dv[3];
                *(LAS v2u*)(Sn + (32 * vt + l31) * 72 + d0) = (v2u){pk2(sacc[4 * g], sacc[4 * g + 1]), pk2(sacc[4 * g + 2], sacc[4 * g + 3])}; }
        }
        if (w < 3) {
            const int it = (w == 0) ? 0 : 1, jt = (w == 2) ? 1 : 0;
            f32x16 a16;
#pragma unroll
            for (int r = 0; r < 16; ++r) a16[r] = 0.f;
#pragma unroll
            for (int kk = 0; kk < 4; ++kk) { const bf16x8 a = *(const LAS bf16x8*)(Ks + (32 * jt + l31) * 72 + kk * 16 + hi * 8), bb = *(const LAS bf16x8*)(Qs + (32 * it + l31) * 72 + kk * 16 + hi * 8);
                a16 = __builtin_amdgcn_mfma_f32_32x32x16_bf16(a, bb, a16, 0, 0, 0); }
            const int i = 32 * it + l31;
#pragma unroll
            for (int g = 0; g < 4; ++g) { const int j0 = 32 * jt + 8 * g + 4 * hi;
                const float x0 = (j0 <= i) ? a16[4 * g] : 0.f, x1 = (j0 + 1 <= i) ? a16[4 * g + 1] : 0.f, x2 = (j0 + 2 <= i) ? a16[4 * g + 2] : 0.f, x3 = (j0 + 3 <= i) ? a16[4 * g + 3] : 0.f;
                *(LAS v2u*)(As + i * 72 + j0) = (v2u){pk2(x0, x1), pk2(x2, x3)}; }
        }
        __syncthreads();
        {
            f32x16 o16;
#pragma unroll
            for (int r = 0; r < 16; ++r) o16[r] = 0.f;
            const LAS bf16* Sc = ST + (c & 1) * (128 * 72);
#pragma unroll
            for (int kk = 0; kk < 4; ++kk) { const bf16x8 a = *(const LAS bf16x8*)(Qs + (32 * dt + l31) * 72 + kk * 16 + hi * 8), bb = *(const LAS bf16x8*)(Sc + (32 * vt + l31) * 72 + kk * 16 + hi * 8);
                o16 = __builtin_amdgcn_mfma_f32_32x32x16_bf16(a, bb, o16, 0, 0, 0); }
#pragma unroll
            for (int kk = 0; kk < 4; ++kk) if (kk < 2 || dt == 1) { const bf16x8 a = *(const LAS bf16x8*)(As + (32 * dt + l31) * 72 + kk * 16 + hi * 8), bb = *(const LAS bf16x8*)(VT + (32 * vt + l31) * 72 + kk * 16 + hi * 8);
                o16 = __builtin_amdgcn_mfma_f32_32x32x16_bf16(a, bb, o16, 0, 0, 0); }
#pragma unroll
            for (int r = 0; r < 16; ++r) Os[(32 * dt + crow16(r, hi)) * 132 + 32 * vt + l31] = o16[r];
        }
        __syncthreads();
        {
            const int i = tid >> 3, v0 = (tid & 7) * 16;
            f32x4 o[4]; float ss = 0.f;
#pragma unroll
            for (int j = 0; j < 4; ++j) { o[j] = *(const LAS f32x4*)(Os + i * 132 + v0 + 4 * j); ss += (o[j].x * o[j].x + o[j].y * o[j].y) + (o[j].z * o[j].z + o[j].w * o[j].w); }
            ss += __shfl_xor(ss, 1); ss += __shfl_xor(ss, 2); ss += __shfl_xor(ss, 4);
            const float rstd = rsqrtf(ss * (1.f / 128.f) + EPS);
            bf16* rp = lr + (rowbase + (size_t)c * 64 + i) * 512 + hh * 128 + v0;
            const v4u ra = *(const v4u*)rp, rb = *(const v4u*)(rp + 8);
            const float rr[16] = {bflo(ra.x), bfhi(ra.x), bflo(ra.y), bfhi(ra.y), bflo(ra.z), bfhi(ra.z), bflo(ra.w), bfhi(ra.w), bflo(rb.x), bfhi(rb.x), bflo(rb.y), bfhi(rb.y), bflo(rb.z), bfhi(rb.z), bflo(rb.w), bfhi(rb.w)};
            float out[16];
#pragma unroll
            for (int j = 0; j < 4; ++j) { const f32x4 gn = *(const f32x4*)(gnorm + v0 + 4 * j);
#pragma unroll
                for (int e = 0; e < 4; ++e) { const float r = rr[4 * j + e]; out[4 * j + e] = o[j][e] * rstd * gn[e] * (r * sigmf(r)); } }
            *(v4u*)rp = (v4u){pk2(out[0], out[1]), pk2(out[2], out[3]), pk2(out[4], out[5]), pk2(out[6], out[7])};
            *(v4u*)(rp + 8) = (v4u){pk2(out[8], out[9]), pk2(out[10], out[11]), pk2(out[12], out[13]), pk2(out[14], out[15])};
        }
    }
    __syncthreads();
}
__device__ __forceinline__ void conv_unit(int cu, const bf16* ca, const bf16* cg, bf16* outp, const float* wdw, const float* bdw, const float* gln, const float* bln, LAS unsigned char* lds) {
    int tid_l = threadIdx.x; asm volatile("" : "+v"(tid_l));
    const int tid = tid_l, lane = tid & 63; const int w = __builtin_amdgcn_readfirstlane(tid >> 6);
    const size_t row0 = (size_t)cu * 32; const int s0 = (int)(row0 % SEQ);
    LAS unsigned* us = (LAS unsigned*)lds;
    LAS float* ys = (LAS float*)(lds + 62 * 1024);
    for (int idx = tid; idx < 62 * 64; idx += 512) { const int r = idx >> 6, ch = idx & 63; const int s = s0 - 30 + r;
        v4u o = (v4u){0u, 0u, 0u, 0u};
        if (s >= 0) { const size_t off = (row0 + r - 30) * 512 + ch * 8; const v4u a = *(const v4u*)(ca + off), g = *(const v4u*)(cg + off);
            o.x = pk2(bflo(a.x) * sigmf(bflo(g.x)), bfhi(a.x) * sigmf(bfhi(g.x))); o.y = pk2(bflo(a.y) * sigmf(bflo(g.y)), bfhi(a.y) * sigmf(bfhi(g.y)));
            o.z = pk2(bflo(a.z) * sigmf(bflo(g.z)), bfhi(a.z) * sigmf(bfhi(g.z))); o.w = pk2(bflo(a.w) * sigmf(bflo(g.w)), bfhi(a.w) * sigmf(bfhi(g.w))); }
        *(LAS v4u*)(us + r * 256 + ch * 4) = o; }
    const int cp = tid & 255, th = tid >> 8;
    float w0[31], w1[31];
#pragma unroll
    for (int k = 0; k < 31; ++k) { const f32x2 ww = *(const f32x2*)(wdw + k * 512 + 2 * cp); w0[k] = ww.x; w1[k] = ww.y; }
    const f32x2 bb = *(const f32x2*)(bdw + 2 * cp);
    __syncthreads();
#pragma unroll 1
    for (int tq = 0; tq < 4; ++tq) {
        const int t0 = th * 16 + tq * 4;
        unsigned uw[34];
#pragma unroll
        for (int r = 0; r < 34; ++r) uw[r] = us[(t0 + r) * 256 + cp];
#pragma unroll
        for (int tt = 0; tt < 4; ++tt) { float y0 = bb.x, y1 = bb.y;
#pragma unroll
            for (int k = 0; k < 31; ++k) { y0 += w0[k] * bflo(uw[tt + k]); y1 += w1[k] * bfhi(uw[tt + k]); }
            *(LAS f32x2*)(ys + (t0 + tt) * 512 + 2 * cp) = (f32x2){y0, y1}; }
    }
    __syncthreads();
#pragma unroll 1
    for (int tt = 0; tt < 4; ++tt) { const int t = 4 * w + tt;
        const f32x4 a = *(const LAS f32x4*)(ys + t * 512 + lane * 8), b = *(const LAS f32x4*)(ys + t * 512 + lane * 8 + 4);
        const float mean = wave_sum((a.x + a.y) + (a.z + a.w) + (b.x + b.y) + (b.z + b.w)) * (1.f / 512.f);
        const f32x4 da = a - mean, db = b - mean;
        const float var = wave_sum((da.x * da.x + da.y * da.y) + (da.z * da.z + da.w * da.w) + (db.x * db.x + db.y * db.y) + (db.z * db.z + db.w * db.w)) * (1.f / 512.f);
        const float rstd = rsqrtf(var + EPS);
        const f32x4 g0 = *(const f32x4*)(gln + lane * 8), g1 = *(const f32x4*)(gln + lane * 8 + 4), b0 = *(const f32x4*)(bln + lane * 8), b1 = *(const f32x4*)(bln + lane * 8 + 4);
        f32x4 y0 = da * rstd * g0 + b0, y1 = db * rstd * g1 + b1;
#pragma unroll
        for (int e = 0; e < 4; ++e) { y0[e] = y0[e] * sigmf(y0[e]); y1[e] = y1[e] * sigmf(y1[e]); }
        *(v4u*)(outp + (row0 + t) * 512 + lane * 8) = (v4u){pk2(y0.x, y0.y), pk2(y0.z, y0.w), pk2(y1.x, y1.y), pk2(y1.z, y1.w)}; }
    __syncthreads();
}

struct Params { const float* in[21]; float* out; unsigned char* ws; };
template <int l> __device__ __forceinline__ void layer_body(const Params& p, LAS unsigned char* lds, unsigned char* lds_raw, cg::grid_group& grid) {
    int tid_l = threadIdx.x; asm volatile("" : "+v"(tid_l));
    const int tid = tid_l, lane = tid & 63, wave = __builtin_amdgcn_readfirstlane(tid >> 6);
    const int G = gridDim.x, bx = blockIdx.x;
    const int vcu = (G % 8 == 0) ? (bx % 8) * (G / 8) + bx / 8 : bx;
    const int gw = vcu * 8 + wave, NGW = G * 8;
    unsigned char* ws = p.ws;
    unsigned* ctl = (unsigned*)(ws + WS_CTL);
    float* ropec = (float*)(ws + WS_ROPEC); float* ropes = (float*)(ws + WS_ROPES); float* kmean = (float*)(ws + WS_KMEAN);
    bf16* XN = (bf16*)(ws + WS_XN);
    const float* x = p.in[0];
    float* hbuf = p.out;
    {
        const float* hin = (l == 0) ? x : hbuf;
        {
            pg8::Gemm g{(const pg8::bf16_t*)XN, (const pg8::bf16_t*)(ws + WS_WIN), M, NMIX, DM}; pg8::StaticOrder S; S.init(M, NMIX + 0, G, bx);
            pg8::EpiInproj E{(bf16*)(ws + WS_Q), (bf16*)(ws + WS_K), (bf16*)(ws + WS_V), (bf16*)(ws + WS_LQ), (bf16*)(ws + WS_LK), (bf16*)(ws + WS_LV), (bf16*)(ws + WS_LR), (bf16*)(ws + WS_CA), (bf16*)(ws + WS_CG),
                             (float*)(ws + WS_G), kmean, ropec, ropes, p.in[6] + l * 256, 0.125f * 1.4426950408889634f};
#ifndef NO_G1
            pg8::gemm_phase<pg8::EpiInproj, pg8::StaticOrder, true, true>(lds, g, S, E);
#endif
        }
        grid.sync();
        {
            LAS unsigned* slot = (LAS unsigned*)(lds + LDS_RING);
            for (;;) {
                __syncthreads();
                if (tid == 0) *slot = atomicAdd(ctl + 64 * l, 1u);
                __syncthreads();
                const int u = (int)*slot;
                if (u >= 32 + 512 + 512) break;
#ifndef NO_GLA
                if (u < 32) gla_unit(u, (const bf16*)(ws + WS_LQ), (const bf16*)(ws + WS_LK), (const bf16*)(ws + WS_LV), (const float*)(ws + WS_G), (bf16*)(ws + WS_LR), p.in[7] + l * 128, lds);
#endif
#ifndef NO_ATTN
                if (u >= 32 && u < 544) { const int a = u - 32, qb = 7 - (a >> 6), bh = a & 63;
                    attn_body::attn_unit<8>(bh >> 3, bh & 7, qb, (const attn_body::bf16*)(ws + WS_Q), (const attn_body::bf16*)(ws + WS_K), (const attn_body::bf16*)(ws + WS_V), (attn_body::bf16*)(ws + WS_Q), kmean, (char*)lds_raw); }
#endif
#ifndef NO_CONV
                if (u >= 544) conv_unit(u - 544, (const bf16*)(ws + WS_CA), (const bf16*)(ws + WS_CG), (bf16*)(ws + WS_CONV), p.in[8] + l * 31 * 512, p.in[9] + l * 512, p.in[10] + l * 512, p.in[11] + l * 512, lds);
#endif
            }
        }
        grid.sync();
        {
            pg8::Gemm g{(const pg8::bf16_t*)(ws + WS_Q), (const pg8::bf16_t*)(ws + WS_WBO), 3 * M, 3 * DM, 512}; pg8::SchedBranch S{G, bx};
            pg8::EpiStore<0> E{(bf16*)(ws + WS_YB), DM, 4, (size_t)M * DM};
#ifndef NO_G2
            pg8::gemm_phase<pg8::EpiStore<0>, pg8::SchedBranch, true, true>(lds, g, S, E);
#endif
        }
        grid.sync();
        {
            pg8::Gemm g{(const pg8::bf16_t*)XN, (const pg8::bf16_t*)(ws + WS_WIN) + (size_t)NMIX * DM, M, 3 * DM, DM}; pg8::SchedGates S{G, bx};
            pg8::EpiGate E{(const bf16*)(ws + WS_YB), (size_t)M * DM, (bf16*)(ws + WS_MB), p.in[4] + l * 3072};
#ifndef NO_G3
            pg8::gemm_phase<pg8::EpiGate, pg8::SchedGates, true, true>(lds, g, S, E);
#endif
        }
        grid.sync();
        {
            pg8::Gemm g{(const pg8::bf16_t*)(ws + WS_MB), (const pg8::bf16_t*)(ws + WS_WMIX), M, DM, DM}; pg8::StaticOrder S; S.init(M, DM, G, bx);
            pg8::EpiStore<0> E{(bf16*)(ws + WS_Y), DM, 1 << 20, 0};
#ifndef NO_G4
            pg8::gemm_phase<pg8::EpiStore<0>, pg8::StaticOrder, true, true>(lds, g, S, E);
#endif
        }
        grid.sync();
        row_phase(hin, (const bf16*)(ws + WS_Y), p.in[16] + l * DM, hbuf, p.in[17] + l * DM, XN, gw, NGW, lane);
        grid.sync();
        {
            pg8::Gemm g{(const pg8::bf16_t*)XN, (const pg8::bf16_t*)(ws + WS_WUP), M, DFF, DM}; pg8::StaticOrder S; S.init(M, DFF, G, bx);
            pg8::EpiStore<1> E{(bf16*)(ws + WS_H), DFF, 1 << 20, 0};
#ifndef NO_G5
            pg8::gemm_phase<pg8::EpiStore<1>, pg8::StaticOrder, true, true>(lds, g, S, E);
#endif
        }
        grid.sync();
        {
            pg8::Gemm g{(const pg8::bf16_t*)(ws + WS_H), (const pg8::bf16_t*)(ws + WS_WDN), M, DM, DFF}; pg8::StaticOrder S; S.init(M, DM, G, bx);
            pg8::EpiStore<0> E{(bf16*)(ws + WS_Y2), DM, 1 << 20, 0};
#ifndef NO_G6
            pg8::gemm_phase<pg8::EpiStore<0>, pg8::StaticOrder, true, true>(lds, g, S, E);
#endif
        }
        grid.sync();
        if (l == 0) {
            LayerW L{p.in[3] + (size_t)DM * 7184, p.in[5] + 16 * 256, p.in[12] + 512 * DM, p.in[13] + 512 * DM, p.in[14] + 512 * DM, p.in[15] + DM * DM, p.in[18] + (size_t)DM * DFF, p.in[19] + (size_t)DFF * DM};
    #ifndef NO_CVT
        convert_weights(L, ws, lds, gw, NGW, wave, lane);
#endif
            for (int i = bx * 512 + tid; i < 64 * 512; i += G * 512) kmean[i] = 0.f;
            row_phase(hbuf, (const bf16*)(ws + WS_Y2), p.in[20], hbuf, p.in[2] + DM, XN, gw, NGW, lane);
            grid.sync();
        } else {
            row_phase(hbuf, (const bf16*)(ws + WS_Y2), p.in[20] + DM, hbuf, nullptr, nullptr, gw, NGW, lane);
        }
        }
}
__global__ void __launch_bounds__(512, 2) mk_fwd(Params p) {
    extern __shared__ __attribute__((aligned(16))) unsigned char lds_raw[];
    cg::grid_group grid = cg::this_grid();
    LAS unsigned char* lds = (LAS unsigned char*)lds_raw;
    const int tid = threadIdx.x, lane = tid & 63, wave = __builtin_amdgcn_readfirstlane(tid >> 6);
    const int G = gridDim.x, bx = blockIdx.x;
    const int vcu = (G % 8 == 0) ? (bx % 8) * (G / 8) + bx / 8 : bx;
    const int gw = vcu * 8 + wave, NGW = G * 8;
    unsigned char* ws = p.ws;
    unsigned* ctl = (unsigned*)(ws + WS_CTL);
    float* ropec = (float*)(ws + WS_ROPEC); float* ropes = (float*)(ws + WS_ROPES); float* kmean = (float*)(ws + WS_KMEAN);
    bf16* XN = (bf16*)(ws + WS_XN);
    const float* x = p.in[0]; const int* positions = (const int*)p.in[1];
    float* hbuf = p.out;

    {
        LayerW L{p.in[3], p.in[5], p.in[12], p.in[13], p.in[14], p.in[15], p.in[18], p.in[19]};
#ifndef NO_CVT
        convert_weights(L, ws, lds, gw, NGW, wave, lane);
#endif
        for (int i = bx * 512 + tid; i < M * 32; i += G * 512) { const int m = i >> 5, f = i & 31; const float ang = (float)positions[m] * c_inv_freq[f];
            const double rev = (double)ang * 0.15915494309189535; const float fr = (float)(rev - __builtin_rint(rev));
            ropec[i] = __builtin_amdgcn_cosf(fr); ropes[i] = __builtin_amdgcn_sinf(fr); }
        for (int i = bx * 512 + tid; i < 64 * 512; i += G * 512) kmean[i] = 0.f;
        row_phase(x, nullptr, nullptr, nullptr, p.in[2], XN, gw, NGW, lane);
    }
    grid.sync();
    layer_body<0>(p, lds, lds_raw, grid);
    layer_body<1>(p, lds, lds_raw, grid);
}

extern "C" void kernel_launch(void* const* d_in, const int* in_sizes, int n_in, void* d_out, int out_size, void* d_ws, size_t ws_size, hipStream_t stream) {
    static int grid = 0;
    if (grid == 0) {
        if (n_in != 21 || out_size != M * DM || ws_size < WS_END) { fprintf(stderr, "kernel_launch: unexpected shapes (n_in %d out %d ws %zu)\n", n_in, out_size, ws_size); grid = -1; return; }
        int dev = 0, cus = 0, per_cu = 0;
        hipGetDevice(&dev);
        hipDeviceGetAttribute(&cus, hipDeviceAttributeMultiprocessorCount, dev);
        hipFuncSetAttribute((const void*)mk_fwd, hipFuncAttributeMaxDynamicSharedMemorySize, LDS_BYTES);
        hipOccupancyMaxActiveBlocksPerMultiprocessor(&per_cu, (const void*)mk_fwd, 512, LDS_BYTES);
        if (per_cu < 1) { fprintf(stderr, "kernel_launch: occupancy query says %d blocks per CU\n", per_cu); per_cu = 1; }
        if (per_cu > 1) per_cu = 1;
        grid = cus * per_cu;
        (void)hipGetLastError();
    }
    if (grid < 0) return;
    hipMemsetAsync((char*)d_ws + WS_CTL, 0, 4096, stream);
    Params p{};
    for (int i = 0; i < 21; ++i) p.in[i] = (const float*)d_in[i];
    p.out = (float*)d_out; p.ws = (unsigned char*)d_ws;
    void* args[] = {&p};
    hipError_t e = hipLaunchCooperativeKernel((const void*)mk_fwd, dim3(grid), dim3(512), args, LDS_BYTES, stream);
    if (e != hipSuccess) fprintf(stderr, "cooperative launch failed: %s (grid %d)\n", hipGetErrorString(e), grid);
}
```

```cpp
#include <hip/hip_runtime.h>
#include <hip/hip_cooperative_groups.h>
#include <cstdio>
#include <cstdint>
namespace cg = cooperative_groups;
namespace pg8 {
#define PG8_LAS __attribute__((address_space(3)))
typedef unsigned short bf16_t;
typedef short bf16x8 __attribute__((ext_vector_type(8)));
typedef float f32x4 __attribute__((ext_vector_type(4)));
typedef unsigned u32x4 __attribute__((ext_vector_type(4)));
constexpr int BM = 256, BK = 64, HALF = 128, HTB = HALF * BK * 2  , STAGE_BYTES = 8 * HTB, NXCD = 8, WGM = 8;

__host__ __device__ __forceinline__ int lds_byte(int r, int c) { const int st = (r >> 4) * 2 + (c >> 5), rr = r & 15, cc = c & 31, ob = rr * 64 + cc * 2; return st * 1024 + (ob ^ (((ob >> 9) & 1) << 5)); }
__host__ __device__ __forceinline__ void stage_rc(int b, int& R, int& C) { const int st = b / 1024, sb = b % 1024, swz = sb ^ (((sb >> 9) & 1) << 5); R = (st >> 1) * 16 + swz / 64; C = (st & 1) * 32 + (swz % 64) / 2; }
__host__ __device__ __forceinline__ int perm32(int rho) { const int n = rho >> 4, i = rho & 15; return 8 * (i >> 2) + 4 * n + (i & 3); }

struct Unit { int pm, pn; };
struct Gemm { const bf16_t* A; const bf16_t* Bt; int M, N, K; };

struct StaticOrder {
    int nM, nN, nwg, G, c;
    __host__ __device__ void init(int M, int N, int G_, int c_) { nM = M / BM; nN = N / BM; nwg = nM * nN; G = G_; c = c_; }
    __host__ __device__ bool next(int i, Unit& u) const {
        const long L = (long)i * G + c; if (L >= nwg) return false;
        int wgid = (int)L; { const int q = nwg / NXCD, r = nwg % NXCD, xcd = wgid % NXCD, off = wgid / NXCD; wgid = (xcd < r ? xcd * (q + 1) : r * (q + 1) + (xcd - r) * q) + off; }
        const int nig = WGM * nN, gid = wgid / nig, fm = gid * WGM, gsz = (nM - fm) < WGM ? (nM - fm) : WGM;
        u.pm = fm + ((wgid % nig) % gsz); u.pn = (wgid % nig) / gsz; return true;
    }
    __device__ __forceinline__ void a_ready(const Unit&) const {}
    __device__ __forceinline__ void done(const Unit&) const {}
};

__device__ __forceinline__ unsigned cvt_pk_bf16(float lo, float hi) { unsigned r; asm volatile("v_cvt_pk_bf16_f32 %0, %1, %2" : "=v"(r) : "v"(lo), "v"(hi)); return r; }
typedef float f32x2 __attribute__((ext_vector_type(2)));
typedef unsigned u32x2 __attribute__((ext_vector_type(2)));
__device__ __forceinline__ float bf_lo(unsigned w) { return __uint_as_float(w << 16); }
__device__ __forceinline__ float bf_hi(unsigned w) { return __uint_as_float(w & 0xffff0000u); }
__device__ __forceinline__ float sigm(float x) { return 1.0f / (1.0f + __expf(-x)); }
__device__ __forceinline__ u32x4 pack8(const f32x4 a, const f32x4 b) { u32x4 w; w.x = cvt_pk_bf16(a[0], a[1]); w.y = cvt_pk_bf16(a[2], a[3]); w.z = cvt_pk_bf16(b[0], b[1]); w.w = cvt_pk_bf16(b[2], b[3]); return w; }

__host__ __device__ __forceinline__ void tile_of(int wgid, int nM, int nN, int& pm, int& pn) {
    const int nwg = nM * nN;
    { const int q = nwg / NXCD, r = nwg % NXCD, xcd = wgid % NXCD, off = wgid / NXCD; wgid = (xcd < r ? xcd * (q + 1) : r * (q + 1) + (xcd - r) * q) + off; }
    const int nig = WGM * nN, gid = wgid / nig, fm = gid * WGM, gsz = (nM - fm) < WGM ? (nM - fm) : WGM;
    pm = fm + ((wgid % nig) % gsz); pn = (wgid % nig) / gsz;
}
struct SchedBranch {
    int G, c;
    __device__ bool next(int i, Unit& u) const { const long L = (long)i * G + c; if (L >= 768) return false; const int j = (int)(L / 256); int pm, pn; tile_of((int)(L % 256), 64, 4, pm, pn); u.pm = 64 * j + pm; u.pn = 4 * j + pn; return true; }
    __device__ __forceinline__ void a_ready(const Unit&) const {}
    __device__ __forceinline__ void done(const Unit&) const {}
};
struct SchedGates {
    int G, c;
    __device__ bool next(int i, Unit& u) const { const int j = i % 3, rnd = i / 3; const long L = (long)rnd * G + c; if (L >= 256) return false; int pm, pn; tile_of((int)L, 64, 4, pm, pn); u.pm = pm; u.pn = 4 * j + pn; return true; }
    __device__ __forceinline__ void a_ready(const Unit&) const {}
    __device__ __forceinline__ void done(const Unit&) const {}
};

template <int ACT  > struct EpiStore {
    static constexpr bool PERM = true, AFTER_DRAIN = false;
    bf16_t* O; int ldc; int jdiv; size_t jstride;
    __device__ __forceinline__ void operator()(const f32x4 (&acc)[2][2][4][2], const Unit& u, int wr, int wc, int fr, int fq) const {
        const int j = u.pn / jdiv; const int pm = u.pm - 64 * j, pn = u.pn - jdiv * j;
        bf16_t* base = O + (size_t)j * jstride;
        const int row0 = pm * BM + wr * 64 + fr, col0 = pn * BM + wc * 32 + 8 * fq;
#pragma unroll
        for (int ai = 0; ai < 2; ++ai)
#pragma unroll
            for (int m = 0; m < 4; ++m) { bf16_t* rowp = base + (size_t)(row0 + ai * HALF + m * 16) * ldc + col0;
#pragma unroll
                for (int bj = 0; bj < 2; ++bj) { f32x4 v0 = acc[ai][bj][m][0], v1 = acc[ai][bj][m][1];
                    if (ACT == 1) {
#pragma unroll
                        for (int e = 0; e < 4; ++e) { const float a = fmaxf(v0[e], 0.f), b = fmaxf(v1[e], 0.f); v0[e] = a * a; v1[e] = b * b; } }
                    *(u32x4*)(rowp + bj * HALF) = pack8(v0, v1); } }
    }
};
struct EpiGate {
    static constexpr bool PERM = true, AFTER_DRAIN = false;
    const bf16_t* Y; size_t ystride; bf16_t* Mb; const float* bgate;
    __device__ __forceinline__ void operator()(const f32x4 (&acc)[2][2][4][2], const Unit& u, int wr, int wc, int fr, int fq) const {
        const int j = u.pn >> 2, pn = u.pn & 3;
        const bf16_t* Yj = Y + (size_t)j * ystride;
        const int row0 = u.pm * BM + wr * 64 + fr, col0 = pn * BM + wc * 32 + 8 * fq;
        f32x4 bv[2][2];
#pragma unroll
        for (int bj = 0; bj < 2; ++bj)
#pragma unroll
            for (int n = 0; n < 2; ++n) bv[bj][n] = *(const f32x4*)(bgate + j * 1024 + col0 + bj * HALF + 4 * n);
#pragma unroll
        for (int ai = 0; ai < 2; ++ai)
#pragma unroll
            for (int m = 0; m < 4; ++m) { const size_t off = (size_t)(row0 + ai * HALF + m * 16) * 1024 + col0;
#pragma unroll
                for (int bj = 0; bj < 2; ++bj) { const size_t o2 = off + bj * HALF;
                    const u32x4 yw = *(const u32x4*)(Yj + o2); u32x4 mw = (u32x4){0u, 0u, 0u, 0u}; if (j > 0) mw = *(const u32x4*)(Mb + o2);
                    const f32x4 x0 = acc[ai][bj][m][0] + bv[bj][0], x1 = acc[ai][bj][m][1] + bv[bj][1];
                    f32x4 r0, r1;
                    r0[0] = sigm(x0[0]) * bf_lo(yw.x) + bf_lo(mw.x); r0[1] = sigm(x0[1]) * bf_hi(yw.x) + bf_hi(mw.x);
                    r0[2] = sigm(x0[2]) * bf_lo(yw.y) + bf_lo(mw.y); r0[3] = sigm(x0[3]) * bf_hi(yw.y) + bf_hi(mw.y);
                    r1[0] = sigm(x1[0]) * bf_lo(yw.z) + bf_lo(mw.z); r1[1] = sigm(x1[1]) * bf_hi(yw.z) + bf_hi(mw.z);
                    r1[2] = sigm(x1[2]) * bf_lo(yw.w) + bf_lo(mw.w); r1[3] = sigm(x1[3]) * bf_hi(yw.w) + bf_hi(mw.w);
                    *(u32x4*)(Mb + o2) = pack8(r0, r1); } }
    }
};
struct EpiInproj {
    static constexpr bool PERM = true, AFTER_DRAIN = false;
    bf16_t *Q, *Kb, *V, *lq, *lk, *lv, *lr, *ca, *cg; float* gdec; float* kmean; const float* ropec; const float* ropes; const float* bgla; float qscale;
    __device__ __forceinline__ void operator()(const f32x4 (&acc)[2][2][4][2], const Unit& u, int wr, int wc, int fr, int fq) const {
        const int pn = u.pn;
        const int row0 = u.pm * BM + wr * 64 + fr, cl = wc * 32 + 8 * fq;
        if (pn < 4) {
            const bool isk = pn >= 2; bf16_t* dst = isk ? Kb : Q; const int ct = (pn & 1) * 256; const float sc = isk ? 1.0f : qscale;
#pragma unroll
            for (int bj = 0; bj < 2; ++bj) { const int c = ct + bj * HALF + cl, i0 = (c & 63) >> 1;
                float cs[8];
#pragma unroll
                for (int e = 0; e < 8; ++e) cs[e] = 0.f;
#pragma unroll
                for (int ai = 0; ai < 2; ++ai)
#pragma unroll
                    for (int m = 0; m < 4; ++m) { const int row = row0 + ai * HALF + m * 16;
                        const f32x4 co = *(const f32x4*)(ropec + (size_t)row * 32 + i0), si = *(const f32x4*)(ropes + (size_t)row * 32 + i0);
                        const f32x4 v0 = acc[ai][bj][m][0], v1 = acc[ai][bj][m][1]; f32x4 o0, o1;
                        o0[0] = (v0[0] * co[0] - v0[1] * si[0]) * sc; o0[1] = (v0[1] * co[0] + v0[0] * si[0]) * sc;
                        o0[2] = (v0[2] * co[1] - v0[3] * si[1]) * sc; o0[3] = (v0[3] * co[1] + v0[2] * si[1]) * sc;
                        o1[0] = (v1[0] * co[2] - v1[1] * si[2]) * sc; o1[1] = (v1[1] * co[2] + v1[0] * si[2]) * sc;
                        o1[2] = (v1[2] * co[3] - v1[3] * si[3]) * sc; o1[3] = (v1[3] * co[3] + v1[2] * si[3]) * sc;
#pragma unroll
                        for (int e = 0; e < 4; ++e) { cs[e] += o0[e]; cs[4 + e] += o1[e]; }
                        *(u32x4*)(dst + (size_t)row * 512 + c) = pack8(o0, o1); }
                if (isk) {
#pragma unroll
                    for (int e = 0; e < 8; ++e) { float s = cs[e]; s += __shfl_xor(s, 1); s += __shfl_xor(s, 2); s += __shfl_xor(s, 4); s += __shfl_xor(s, 8); cs[e] = s; }
                    if (fr == 0) {
#pragma unroll
                        for (int e = 0; e < 8; ++e) atomicAdd(kmean + (size_t)u.pm * 512 + c + e, cs[e]); } } }
        } else if (pn == 10) {
#pragma unroll
            for (int bj = 0; bj < 2; ++bj) { const int c = bj * HALF + cl; const f32x4 b0 = *(const f32x4*)(bgla + c), b1 = *(const f32x4*)(bgla + c + 4);
#pragma unroll
                for (int ai = 0; ai < 2; ++ai)
#pragma unroll
                    for (int m = 0; m < 4; ++m) { const int row = row0 + ai * HALF + m * 16; const f32x4 x0 = acc[ai][bj][m][0] + b0, x1 = acc[ai][bj][m][1] + b1; f32x4 g0, g1;
#pragma unroll
                        for (int e = 0; e < 4; ++e) { g0[e] = (fminf(x0[e], 0.f) - __logf(1.0f + __expf(-fabsf(x0[e])))) * 0.0625f; g1[e] = (fminf(x1[e], 0.f) - __logf(1.0f + __expf(-fabsf(x1[e])))) * 0.0625f; }
                        *(f32x4*)(gdec + (size_t)row * 256 + c) = g0; *(f32x4*)(gdec + (size_t)row * 256 + c + 4) = g1; } }
        } else {
            bf16_t* dst; int ld = 512, ct; float sc = 1.0f;
            if (pn < 6) { dst = V; ct = (pn - 4) * 256; }
            else if (pn == 6) { dst = lq; ld = 256; ct = 0; sc = 0.125f; }
            else if (pn == 7) { dst = lk; ld = 256; ct = 0; }
            else if (pn < 10) { dst = lv; ct = (pn - 8) * 256; }
            else if (pn < 13) { dst = lr; ct = (pn - 11) * 256; }
            else if (pn < 15) { dst = ca; ct = (pn - 13) * 256; }
            else { dst = cg; ct = (pn - 15) * 256; }
#pragma unroll
            for (int ai = 0; ai < 2; ++ai)
#pragma unroll
                for (int m = 0; m < 4; ++m) { bf16_t* rowp = dst + (size_t)(row0 + ai * HALF + m * 16) * ld + ct + cl;
#pragma unroll
                    for (int bj = 0; bj < 2; ++bj) *(u32x4*)(rowp + bj * HALF) = pack8(acc[ai][bj][m][0] * sc, acc[ai][bj][m][1] * sc); }
        }
    }
};
template <class Epi, class Sched, bool ALIGN_EPI = false, bool SP2 = false>
__device__ __forceinline__ void gemm_phase(PG8_LAS unsigned char* lds, const Gemm g, const Sched& S, const Epi& E) {
    int tid_l = threadIdx.x; asm volatile("" : "+v"(tid_l));
    const int tid = tid_l, wid = __builtin_amdgcn_readfirstlane(tid >> 6), lane = tid & 63, wr = wid >> 2, wc = wid & 3, fr = lane & 15, fq = lane >> 4;
    const int K = g.K, nt = K / BK;
    unsigned voffA[2], voffB[2];
#pragma unroll
    for (int i = 0; i < 2; ++i) { int R, C; stage_rc(tid * 16 + i * 8192, R, C); const int Rb = Epi::PERM ? ((R & ~31) + perm32(R & 31)) : R;
        voffA[i] = (unsigned)(R * K + C) * 2u; voffB[i] = (unsigned)(Rb * K + C) * 2u; }
    const size_t kstep = (size_t)(BK * 2);
    const size_t hstep = (size_t)HALF * K * 2;
    const size_t tstep = 2 * hstep;
    const unsigned ldsw = (unsigned)wid * 1024u;
    const int aoff = lds_byte(wr * 64 + fr, fq * 8), boff = lds_byte(wc * 32 + fr, fq * 8);
#define PG8_SA(b, h) (((b) * 2 + (h)) * HTB)
#define PG8_SB(b, h) ((4 + (b) * 2 + (h)) * HTB)
#define PG8_STAGE(bufoff, gbase, voff) do { _Pragma("unroll") for (int _i = 0; _i < 2; ++_i) \
        __builtin_amdgcn_global_load_lds((const unsigned*)((const char*)(gbase) + (voff)[_i]), (PG8_LAS unsigned*)(lds + (bufoff) + ldsw + _i * 8192), 16, 0, 0); } while (0)
#define PG8_LDA(dst, b, h) do { _Pragma("unroll") for (int m = 0; m < 4; ++m) _Pragma("unroll") for (int k = 0; k < 2; ++k) dst[m][k] = *(const PG8_LAS bf16x8*)(lds + PG8_SA(b, h) + aoff + m * 2048 + k * 1024); } while (0)
#define PG8_LDB(dst, b, h) do { _Pragma("unroll") for (int n = 0; n < 2; ++n) _Pragma("unroll") for (int k = 0; k < 2; ++k) dst[n][k] = *(const PG8_LAS bf16x8*)(lds + PG8_SB(b, h) + boff + n * 2048 + k * 1024); } while (0)
#define PG8_MMA(ai, bj, At, Bt) do { __builtin_amdgcn_s_setprio(1); _Pragma("unroll") for (int m = 0; m < 4; ++m) _Pragma("unroll") for (int n = 0; n < 2; ++n) _Pragma("unroll") for (int k = 0; k < 2; ++k) \
        acc[ai][bj][m][n] = __builtin_amdgcn_mfma_f32_16x16x32_bf16(Bt[n][k], At[m][k], acc[ai][bj][m][n], 0, 0, 0); __builtin_amdgcn_s_setprio(0); } while (0)
#define PG8_WAIT_V(n) asm volatile("s_waitcnt vmcnt(" #n ")" ::: "memory")
#define PG8_WAIT_L(n) asm volatile("s_waitcnt lgkmcnt(" #n ")" ::: "memory")
#define PG8_BAR __builtin_amdgcn_s_barrier()
#define PG8_SCHED __builtin_amdgcn_sched_barrier(0)
    Unit cur, nxt; int ui = 0;
    if (!S.next(0, cur)) return;
    f32x4 acc[2][2][4][2];
#pragma unroll
    for (int a = 0; a < 2; ++a)
#pragma unroll
        for (int b = 0; b < 2; ++b)
#pragma unroll
            for (int m = 0; m < 4; ++m)
#pragma unroll
                for (int n = 0; n < 2; ++n) acc[a][b][m][n] = (f32x4){0.f, 0.f, 0.f, 0.f};
    bf16x8 At[4][2], B0[2][2], B1[2][2];
    const char* cA = (const char*)g.A + (size_t)cur.pm * tstep; const char* cB = (const char*)g.Bt + (size_t)cur.pn * tstep;
    S.a_ready(cur);
    if constexpr (SP2) {
        PG8_STAGE(PG8_SB(0, 0), cB, voffB); PG8_STAGE(PG8_SB(0, 1), cB + hstep, voffB); PG8_STAGE(PG8_SA(0, 0), cA, voffA); PG8_STAGE(PG8_SA(0, 1), cA + hstep, voffA);
        if (wr == 1) PG8_BAR;
        PG8_WAIT_V(2); PG8_BAR;
        PG8_STAGE(PG8_SB(1, 0), cB + kstep, voffB); PG8_STAGE(PG8_SA(1, 0), cA + kstep, voffA); PG8_STAGE(PG8_SB(1, 1), cB + hstep + kstep, voffB);
        PG8_WAIT_V(6); PG8_BAR;
    } else {
        PG8_STAGE(PG8_SB(0, 0), cB, voffB); PG8_STAGE(PG8_SA(0, 0), cA, voffA); PG8_STAGE(PG8_SB(0, 1), cB + hstep, voffB); PG8_STAGE(PG8_SA(0, 1), cA + hstep, voffA);
        if (wr == 1) PG8_BAR;
        PG8_WAIT_V(4); PG8_BAR;
        PG8_STAGE(PG8_SB(1, 0), cB + kstep, voffB); PG8_STAGE(PG8_SA(1, 0), cA + kstep, voffA); PG8_STAGE(PG8_SB(1, 1), cB + hstep + kstep, voffB);
        PG8_WAIT_V(6); PG8_BAR;
    }
    for (;;) {
        const bool has_next = S.next(ui + 1, nxt);
        const char* nA = has_next ? (const char*)g.A + (size_t)nxt.pm * tstep : cA; const char* nB = has_next ? (const char*)g.Bt + (size_t)nxt.pn * tstep : cB;
        for (int t = 0; t < nt; t += 2) {
            const bool last = (t == nt - 2);
            const char* a1 = cA + (size_t)(t + 1) * kstep;
            const char* a2 = last ? nA : cA + (size_t)(t + 2) * kstep; const char* b2 = last ? nB : cB + (size_t)(t + 2) * kstep;
            const char* a3 = a2 + kstep; const char* b3 = b2 + kstep;
            if (last && has_next) S.a_ready(nxt);
            if constexpr (SP2) {
            PG8_LDB(B0, 0, 0); PG8_LDB(B1, 0, 1); PG8_SCHED; PG8_LDA(At, 0, 0); PG8_STAGE(PG8_SA(1, 1), a1 + hstep, voffA);
            PG8_WAIT_V(8); PG8_WAIT_L(0); PG8_BAR; PG8_MMA(0, 0, At, B0); PG8_MMA(0, 1, At, B1); PG8_BAR; PG8_SCHED;
            PG8_LDA(At, 0, 1); PG8_STAGE(PG8_SB(0, 0), b2, voffB); PG8_STAGE(PG8_SB(0, 1), b2 + hstep, voffB); PG8_STAGE(PG8_SA(0, 0), a2, voffA);
            PG8_WAIT_V(8); PG8_WAIT_L(0); PG8_BAR; PG8_MMA(1, 0, At, B0); PG8_MMA(1, 1, At, B1); PG8_BAR; PG8_SCHED;
            PG8_LDB(B0, 1, 0); PG8_LDB(B1, 1, 1); PG8_SCHED; PG8_LDA(At, 1, 0); PG8_STAGE(PG8_SA(0, 1), a2 + hstep, voffA);
            PG8_WAIT_V(8); PG8_WAIT_L(0); PG8_BAR; PG8_MMA(0, 0, At, B0); PG8_MMA(0, 1, At, B1); PG8_BAR; PG8_SCHED;
            PG8_LDA(At, 1, 1); PG8_STAGE(PG8_SB(1, 0), b3, voffB); PG8_STAGE(PG8_SB(1, 1), b3 + hstep, voffB); PG8_STAGE(PG8_SA(1, 0), a3, voffA);
            PG8_WAIT_V(8); PG8_WAIT_L(0); PG8_BAR; PG8_MMA(1, 0, At, B0); PG8_MMA(1, 1, At, B1); PG8_BAR; PG8_SCHED;
            } else {
            PG8_LDB(B0, 0, 0); PG8_SCHED; PG8_LDA(At, 0, 0); PG8_STAGE(PG8_SA(1, 1), a1 + hstep, voffA);
            PG8_WAIT_L(8); PG8_BAR; PG8_WAIT_L(0); PG8_MMA(0, 0, At, B0); PG8_BAR; PG8_SCHED;
            PG8_LDB(B1, 0, 1); PG8_STAGE(PG8_SB(0, 0), b2, voffB);
            PG8_BAR; PG8_WAIT_L(0); PG8_MMA(0, 1, At, B1); PG8_BAR;
            PG8_LDA(At, 0, 1); PG8_STAGE(PG8_SA(0, 0), a2, voffA);
            PG8_BAR; PG8_WAIT_L(0); PG8_MMA(1, 0, At, B0); PG8_BAR; PG8_SCHED;
            PG8_STAGE(PG8_SB(0, 1), b2 + hstep, voffB);
            PG8_WAIT_V(6); PG8_BAR; PG8_MMA(1, 1, At, B1); PG8_BAR;
            PG8_LDB(B0, 1, 0); PG8_SCHED; PG8_LDA(At, 1, 0); PG8_STAGE(PG8_SA(0, 1), a2 + hstep, voffA);
            PG8_WAIT_L(8); PG8_BAR; PG8_WAIT_L(0); PG8_MMA(0, 0, At, B0); PG8_BAR; PG8_SCHED;
            PG8_LDB(B1, 1, 1); PG8_STAGE(PG8_SB(1, 0), b3, voffB);
            PG8_BAR; PG8_WAIT_L(0); PG8_MMA(0, 1, At, B1); PG8_BAR;
            PG8_LDA(At, 1, 1); PG8_STAGE(PG8_SA(1, 0), a3, voffA);
            PG8_BAR; PG8_WAIT_L(0); PG8_MMA(1, 0, At, B0); PG8_BAR; PG8_SCHED;
            PG8_STAGE(PG8_SB(1, 1), b3 + hstep, voffB);
            PG8_WAIT_V(6); PG8_BAR; PG8_MMA(1, 1, At, B1); PG8_BAR;
            }
        }
        if constexpr (ALIGN_EPI) { if (wr == 0) PG8_BAR; }
        if constexpr (!Epi::AFTER_DRAIN) { E(acc, cur, wr, wc, fr, fq); S.done(cur); }
        if (!has_next) break;
#pragma unroll
        for (int a = 0; a < 2; ++a)
#pragma unroll
            for (int b = 0; b < 2; ++b)
#pragma unroll
                for (int m = 0; m < 4; ++m)
#pragma unroll
                    for (int n = 0; n < 2; ++n) acc[a][b][m][n] = (f32x4){0.f, 0.f, 0.f, 0.f};
        cur = nxt; cA = nA; cB = nB; ++ui;
        if constexpr (ALIGN_EPI) { if (wr == 1) PG8_BAR; }
    }
    PG8_WAIT_V(0);
    if constexpr (!ALIGN_EPI) { if (wr == 0) PG8_BAR; }
    PG8_BAR;
    if constexpr (Epi::AFTER_DRAIN) { E.fused(acc, cur, wr, wc, fr, fq, lds, wid, lane); S.done(cur); }
#undef PG8_SA
#undef PG8_SB
#undef PG8_STAGE
#undef PG8_LDA
#undef PG8_LDB
#undef PG8_MMA
#undef PG8_WAIT_V
#undef PG8_WAIT_L
#undef PG8_BAR
#undef PG8_SCHED
}
}
#include <hip/hip_bf16.h>
#include <cmath>
namespace attn_body {
using bf16=__hip_bfloat16;
using bf16x8=__attribute__((ext_vector_type(8)))short;
using s16x4=__attribute__((ext_vector_type(4)))short;
using f32x16=__attribute__((ext_vector_type(16)))float;
using u32x4=__attribute__((ext_vector_type(4)))unsigned;
constexpr int BATCH=8,NHEAD=8,SEQ=2048,D=64,DM=NHEAD*D;
constexpr int NW=8,QBLK=32,QB=QBLK*NW,KVBLK=64,NQB=SEQ/QB;
constexpr int ATTN_PITCH=DM, ATTN_UNIT_ROWS=QB;
__device__ __forceinline__ int crow(int r,int hi){return (r&3)+8*(r>>2)+4*hi;}
#define SBAR() __builtin_amdgcn_sched_barrier(0)
__device__ __forceinline__ void cmask(f32x16&p0,f32x16&p1,int jb,int qrel,int hi){
  const float NEG=-INFINITY; int kb=64*jb+4*hi;
  #pragma unroll
  for(int r=0;r<16;++r){int kv=kb+(r&3)+8*(r>>2); if(kv>qrel)p0[r]=NEG; if(kv+32>qrel)p1[r]=NEG;}
}

constexpr int NSLOT=3, SLOTB=8192;
constexpr int LDS_K=0, LDS_V=NSLOT*SLOTB, LDS_WS=2*NSLOT*SLOTB, LDS_OST=LDS_WS+NW*64*4, LDS_BYTES=LDS_OST+NW*4096;
constexpr float C2=0.125f*1.4426950408889634f;
__device__ __forceinline__ void glds16(const void*gsrc,unsigned lds_dst){unsigned keep;
  asm volatile("s_mov_b32 %0, m0\n\ts_mov_b32 m0, %2\n\ts_nop 0\n\tglobal_load_lds_dwordx4 %1, off\n\ts_mov_b32 m0, %0":"=&s"(keep):"v"(gsrc),"s"(lds_dst):"memory");}
__device__ __forceinline__ float max3f(float a,float b,float c){float r;asm("v_max3_f32 %0, %1, %2, %3":"=v"(r):"v"(a),"v"(b),"v"(c));return r;}
__device__ __forceinline__ float max2f(float a,float b){float r;asm("v_max_f32_e32 %0, %1, %2":"=v"(r):"v"(a),"v"(b));return r;}
__device__ __forceinline__ float fadd_s(float a,float b){float r;asm("v_add_f32_e32 %0, %1, %2":"=v"(r):"v"(a),"v"(b));return r;}
__device__ __forceinline__ float fsub_s(float a,float b){float r;asm("v_sub_f32_e32 %0, %1, %2":"=v"(r):"v"(a),"v"(b));return r;}
typedef float f32x2_t __attribute__((ext_vector_type(2))); typedef float f32x4_t __attribute__((ext_vector_type(4))); typedef __bf16 bf16x2_t __attribute__((ext_vector_type(2)));
__device__ __forceinline__ unsigned cvtpk_s(float lo,float hi){f32x2_t v={lo,hi};bf16x2_t b=__builtin_convertvector(v,bf16x2_t);return __builtin_bit_cast(unsigned,b);}
#define WAIT_BAR(N) asm volatile("s_waitcnt vmcnt(" #N ") lgkmcnt(0)\n\ts_barrier":::"memory")

__device__ __forceinline__ void qkt(f32x16&p0,f32x16&p1,const char*Kslot,const bf16x8*qr,const f32x16&negm,int r32,int hi){
  const char*kb=Kslot+hi*1024+r32*16;
  #pragma unroll
  for(int d0=0;d0<4;++d0){
    const bf16x8 b0=*reinterpret_cast<const bf16x8*>(kb+d0*2048);
    const bf16x8 b1=*reinterpret_cast<const bf16x8*>(kb+d0*2048+512);
    if(d0==0){p0=__builtin_amdgcn_mfma_f32_32x32x16_bf16(b0,qr[0],negm,0,0,0);p1=__builtin_amdgcn_mfma_f32_32x32x16_bf16(b1,qr[0],negm,0,0,0);}
    else{p0=__builtin_amdgcn_mfma_f32_32x32x16_bf16(b0,qr[d0],p0,0,0,0);p1=__builtin_amdgcn_mfma_f32_32x32x16_bf16(b1,qr[d0],p1,0,0,0);}}
}
typedef __attribute__((address_space(3))) const char* lds_cptr;
typedef short v4i16_t __attribute__((ext_vector_type(4)));
__device__ __forceinline__ void kload8(bf16x8*kf,lds_cptr kp){
  kf[0]=*(const __attribute__((address_space(3))) bf16x8*)(kp);      kf[1]=*(const __attribute__((address_space(3))) bf16x8*)(kp+512);
  kf[2]=*(const __attribute__((address_space(3))) bf16x8*)(kp+2048); kf[3]=*(const __attribute__((address_space(3))) bf16x8*)(kp+2560);
  kf[4]=*(const __attribute__((address_space(3))) bf16x8*)(kp+4096); kf[5]=*(const __attribute__((address_space(3))) bf16x8*)(kp+4608);
  kf[6]=*(const __attribute__((address_space(3))) bf16x8*)(kp+6144); kf[7]=*(const __attribute__((address_space(3))) bf16x8*)(kp+6656);
}
__device__ __forceinline__ void kload2(bf16x8*kf,lds_cptr kp,int j){ kf[2*j]=*(const __attribute__((address_space(3))) bf16x8*)(kp+j*2048); kf[2*j+1]=*(const __attribute__((address_space(3))) bf16x8*)(kp+j*2048+512); }
__device__ __forceinline__ s16x4 vtr(lds_cptr p){ return __builtin_bit_cast(s16x4,__builtin_amdgcn_ds_read_tr16_b64_v4i16((__attribute__((address_space(3))) v4i16_t*)p)); }
__device__ __forceinline__ float rowmax(const f32x16&p0,const f32x16&p1){
  float a=max3f(p0[0],p0[1],p1[0]),b=max3f(p0[2],p0[3],p1[1]);a=max3f(a,p1[2],p1[3]);
  #pragma unroll
  for(int r=4;r<16;r+=4){a=max3f(a,p0[r],p0[r+1]);b=max3f(b,p0[r+2],p0[r+3]);a=max3f(a,p1[r],p1[r+1]);b=max3f(b,p1[r+2],p1[r+3]);}
  const float m=max2f(a,b);
  auto rr=__builtin_amdgcn_permlane32_swap(__float_as_uint(m),__float_as_uint(m),false,false);
  return max2f(__uint_as_float(rr[0]),__uint_as_float(rr[1]));
}
__device__ __forceinline__ void pv(f32x16*o,int vb,bf16x8 pa0,bf16x8 pa1,bf16x8 pa2,bf16x8 pa3){
  #pragma unroll
  for(int d0=0;d0<2;++d0){s16x4 lo[4],hi[4];
    #pragma unroll
    for(int ks=0;ks<4;++ks){
      asm volatile("ds_read_b64_tr_b16 %0,%1 offset:%c2":"=&v"(lo[ks]):"v"(vb),"i"(d0*4096+ks*1024):"memory");
      asm volatile("ds_read_b64_tr_b16 %0,%1 offset:%c2":"=&v"(hi[ks]):"v"(vb),"i"(d0*4096+ks*1024+512):"memory");}
    asm volatile("s_waitcnt lgkmcnt(0)":::"memory");SBAR();
    #define PK(k) (bf16x8){lo[k][0],lo[k][1],lo[k][2],lo[k][3],hi[k][0],hi[k][1],hi[k][2],hi[k][3]}
    o[d0]=__builtin_amdgcn_mfma_f32_32x32x16_bf16(pa0,PK(0),o[d0],0,0,0);
    o[d0]=__builtin_amdgcn_mfma_f32_32x32x16_bf16(pa1,PK(1),o[d0],0,0,0);
    o[d0]=__builtin_amdgcn_mfma_f32_32x32x16_bf16(pa2,PK(2),o[d0],0,0,0);
    o[d0]=__builtin_amdgcn_mfma_f32_32x32x16_bf16(pa3,PK(3),o[d0],0,0,0);
    #undef PK
  }
}

#ifndef ATTN_STORE16
#define ATTN_STORE16(p,v) (*(u32x4*)(p)=(v))
#endif
template<int THRL> __device__ __forceinline__ void attn_unit(int b,int h,int qb,const bf16*Q,const bf16*__restrict__ K,const bf16*__restrict__ V,bf16*O,const float*ksum,char*shm){
  int tid_l=threadIdx.x; asm volatile("":"+v"(tid_l)); const int tid=tid_l,lane=tid&63,r32=lane&31,hi=lane>>5; const int wid=__builtin_amdgcn_readfirstlane(tid>>6);
  const long rowbase=(long)b*SEQ; const int q0=qb*QB;
  const bf16*Qw=Q+(rowbase+q0+wid*QBLK)*DM+h*D;
  const bf16*Kh=K+rowbase*DM+h*D,*Vh=V+rowbase*DM+h*D;
  const unsigned lds0=(unsigned)(uintptr_t)shm;
  float*wsf=(float*)(shm+LDS_WS)+wid*64;
  const bf16*ksrc=Kh+(long)lane*DM+wid*8;
  const bf16*vsrc=Vh+(long)(16*(wid&3)+(lane>>2))*DM+(wid>>2)*32+(lane&3)*8;
  const unsigned kdst=lds0+LDS_K+wid*1024, vdst=lds0+LDS_V+wid*1024;
  #define DMA_K(t,slot) glds16(ksrc+(long)(t)*KVBLK*DM,(unsigned)__builtin_amdgcn_readfirstlane(kdst+(slot)))
  #define DMA_V(t,slot) glds16(vsrc+(long)(t)*KVBLK*DM,(unsigned)__builtin_amdgcn_readfirstlane(vdst+(slot)))
  const int vb0=(int)(lds0+LDS_V)+((lane>>4)&1)*32+(lane&3)*8+(4*hi+((lane&15)>>2))*64;
  const char*Kbase=shm+LDS_K; bf16x8 kf[8];
  const lds_cptr shm3=(lds_cptr)shm; const lds_cptr kp0=shm3+LDS_K+hi*1024+r32*16; const lds_cptr vp0=shm3+LDS_V+((lane>>4)&1)*32+(lane&3)*8+(4*hi+((lane&15)>>2))*64;
  const int NT=(q0+QB)/KVBLK;
  DMA_K(0,0);DMA_V(0,0);DMA_K(1,SLOTB);
  bf16x8 qr[4];
  #pragma unroll
  for(int d0=0;d0<4;++d0)qr[d0]=*reinterpret_cast<const bf16x8*>(&Qw[(long)r32*DM+d0*16+hi*8]);

  unsigned selmask=1u<<qb;
  if(qb>0){
    float gt[7];
    #pragma unroll
    for(int n=0;n<7;++n){ float s=-INFINITY;
      if(n<qb){ const float*km=ksum+((size_t)(b*8+n))*512+h*64; s=0.f;
        #pragma unroll
        for(int d0=0;d0<4;++d0){ const f32x4_t k0=*reinterpret_cast<const f32x4_t*>(km+d0*16+hi*8),k1=*reinterpret_cast<const f32x4_t*>(km+d0*16+hi*8+4);
          #pragma unroll
          for(int e=0;e<4;++e){ s+=__uint_as_float(((unsigned)(unsigned short)qr[d0][e])<<16)*k0[e]; s+=__uint_as_float(((unsigned)(unsigned short)qr[d0][4+e])<<16)*k1[e]; } }
        s+=__shfl_xor(s,32); }
      gt[n]=s; }
    #pragma unroll
    for(int n=0;n<7;++n){ int rank=0;
      #pragma unroll
      for(int m2=0;m2<7;++m2){ if(m2!=n) rank+=((gt[m2]>gt[n])||((gt[m2]==gt[n])&&(m2<n)))?1:0; }
      if(n<qb&&rank<3)selmask|=(1u<<n); }
  }
  #define MMASK(P0,P1,t) do{ if(!((selmask>>((t)>>2))&1u)){ _Pragma("unroll") for(int r=0;r<16;++r){P0[r]=-INFINITY;P1[r]=-INFINITY;} } }while(0)
  float mhat=0.f,l_reg=0.f;f32x16 o[2];o[0]=f32x16{};o[1]=f32x16{};f32x16 negm=f32x16{};asm volatile("":"+v"(negm));
  const int qrel=wid*QBLK+r32;
  #define CMASK(P0,P1,t) do{int jb_=(t)-(NT-4); if(jb_>=0)cmask(P0,P1,jb_,qrel,hi);}while(0)
  bool resc=false;
  #define START(P0,P1) do{ const float rm=rowmax(P0,P1); resc=false; \
    { const float dl=rm; mhat=fadd_s(mhat,dl); \
      _Pragma("unroll") for(int r=0;r<16;++r){P0[r]=fsub_s(P0[r],dl);P1[r]=fsub_s(P1[r],dl);} \
      _Pragma("unroll") for(int r=0;r<16;++r)negm[r]=-mhat; asm volatile("":"+v"(negm)); } \
    _Pragma("unroll") for(int r=0;r<16;++r)P0[r]=__builtin_amdgcn_exp2f(P0[r]); }while(0)
  #define RESC() do{ if(resc){ asm volatile("s_waitcnt lgkmcnt(0)":::"memory"); \
      _Pragma("unroll") for(int d_=0;d_<2;++d_) _Pragma("unroll") for(int r=0;r<16;++r)o[d_][r]*=wsf[crow(r,hi)]; } }while(0)
  f32x16 pA0,pA1,pB0,pB1;
  int sl_prev=0,sl_cur=0,sl_next=SLOTB;
  #define ROT() do{sl_prev=sl_cur;sl_cur=sl_next;sl_next=(sl_next==(NSLOT-1)*SLOTB)?0:sl_next+SLOTB;}while(0)
  DMA_K(2,2*SLOTB);
  WAIT_BAR(3);
  qkt(pA0,pA1,Kbase,qr,negm,r32,hi);asm volatile("s_nop 15\n\ts_nop 7":"+v"(pA0),"+v"(pA1));CMASK(pA0,pA1,0);
  START(pA0,pA1);
  _Pragma("unroll") for(int r=0;r<16;++r)pA1[r]=__builtin_amdgcn_exp2f(pA1[r]);
  if(!(selmask&1u)){ _Pragma("unroll") for(int r=0;r<16;++r){pA0[r]=0.f;pA1[r]=0.f;} }
  WAIT_BAR(0);
  DMA_K(3,0);DMA_V(1,SLOTB);
  ROT();
  kload8(kf,kp0+sl_cur);
  WAIT_BAR(2);
  s16x4 vlo[8],vhi[8]; u32x4 pw0,pw1,pw2,pw3;
  #define PKW(P,B) cvtpk_s(P[B],P[B+1])
  #define PAF(k) __builtin_bit_cast(bf16x8,pw##k)
  #define VFR(i) (bf16x8){vlo[i][0],vlo[i][1],vlo[i][2],vlo[i][3],vhi[i][0],vhi[i][1],vhi[i][2],vhi[i][3]}
  #define PIN(x) asm volatile("":"+v"(x))
  #define MX3(a,b,c) __builtin_fmaxf(__builtin_fmaxf((a),(b)),(c))
  #define GAPA(MF,A0,A1,A2,A3,W0,W1,PW) do{ MF; sacc+=A0; sacc+=A1; sacc+=A2; sacc+=A3; PIN(sacc); W0; W1; PIN(PW); SBAR(); }while(0)
  #define EX(v) __builtin_amdgcn_exp2f(v)
  #define GAPB(MF,X,B) do{ MF; X[B]=EX(X[B]); X[B+1]=EX(X[B+1]); X[B+2]=EX(X[B+2]); X[B+3]=EX(X[B+3]); PIN(X); SBAR(); }while(0)
  #define VRD(i) do{ vlo[i]=vtr(vp_+(((i)>>2)*4096+((i)&3)*1024)); vhi[i]=vtr(vp_+(((i)>>2)*4096+((i)&3)*1024+512)); }while(0)
  #define KRD(G,j) do{ if(G){ kload2(kf,kp0+sl_next,j); SBAR(); } }while(0)
  #define STEP(C0,C1,P0,P1,t,GK,GV,GL) do{ SBAR(); \
    const lds_cptr vp_=vp0+sl_prev; \
    VRD(0); SBAR(); float sacc=(P0[0]+P0[1]); \
    GAPA(C0=__builtin_amdgcn_mfma_f32_32x32x16_bf16(kf[0],qr[0],negm,0,0,0), P0[2],P0[3],P0[4],P0[5],     pw0[0]=PKW(P0,0), pw0[1]=PKW(P0,2), pw0); \
    VRD(4); SBAR(); GAPA(C1=__builtin_amdgcn_mfma_f32_32x32x16_bf16(kf[1],qr[0],negm,0,0,0), P0[6],P0[7],P0[8],P0[9],     pw0[2]=PKW(P0,4), pw0[3]=PKW(P0,6), pw0); \
    VRD(1); SBAR(); GAPA(C0=__builtin_amdgcn_mfma_f32_32x32x16_bf16(kf[2],qr[1],C0,0,0,0),   P0[10],P0[11],P0[12],P0[13], pw1[0]=PKW(P0,8), pw1[1]=PKW(P0,10), pw1); \
    VRD(5); SBAR(); GAPA(C1=__builtin_amdgcn_mfma_f32_32x32x16_bf16(kf[3],qr[1],C1,0,0,0),   P0[14],P0[15],P1[0],P1[1],   pw1[2]=PKW(P0,12),pw1[3]=PKW(P0,14), pw1); \
    VRD(2); SBAR(); GAPA(C0=__builtin_amdgcn_mfma_f32_32x32x16_bf16(kf[4],qr[2],C0,0,0,0),   P1[2],P1[3],P1[4],P1[5],     pw2[0]=PKW(P1,0), pw2[1]=PKW(P1,2), pw2); \
    VRD(6); SBAR(); GAPA(C1=__builtin_amdgcn_mfma_f32_32x32x16_bf16(kf[5],qr[2],C1,0,0,0),   P1[6],P1[7],P1[8],P1[9],     pw2[2]=PKW(P1,4), pw2[3]=PKW(P1,6), pw2); \
    VRD(3); SBAR(); GAPA(C0=__builtin_amdgcn_mfma_f32_32x32x16_bf16(kf[6],qr[3],C0,0,0,0),   P1[10],P1[11],P1[12],P1[13], pw3[0]=PKW(P1,8), pw3[1]=PKW(P1,10), pw3); \
    VRD(7); SBAR(); GAPA(C1=__builtin_amdgcn_mfma_f32_32x32x16_bf16(kf[7],qr[3],C1,0,0,0),   P1[14],P1[15],0.f,0.f,       pw3[2]=PKW(P1,12),pw3[3]=PKW(P1,14), pw3); \
    l_reg+=sacc; \
    if(GK){DMA_K((t)+3,sl_cur);} if(GV){DMA_V((t)+1,sl_next);} \
    CMASK(C0,C1,t); \
    { float a=MX3(C0[0],C0[1],C1[0]),b=MX3(C0[2],C0[3],C1[1]); a=MX3(a,C1[2],C1[3]); \
      _Pragma("unroll") for(int r=4;r<16;r+=4){a=MX3(a,C0[r],C0[r+1]);b=MX3(b,C0[r+2],C0[r+3]);a=MX3(a,C1[r],C1[r+1]);b=MX3(b,C1[r+2],C1[r+3]);} \
      float rm=__builtin_fmaxf(a,b); { auto rr=__builtin_amdgcn_permlane32_swap(__float_as_uint(rm),__float_as_uint(rm),false,false); rm=__builtin_fmaxf(__uint_as_float(rr[0]),__uint_as_float(rr[1])); } \
      resc=false; \
      if(__builtin_expect(__any(rm>(float)THRL),0)){ const float dl=__builtin_fmaxf(rm,0.f); mhat+=dl; \
        _Pragma("unroll") for(int r=0;r<16;++r){C0[r]-=dl;C1[r]-=dl;} \
        _Pragma("unroll") for(int r=0;r<16;++r)negm[r]=-mhat; asm volatile("":"+v"(negm)); \
        const float f=__builtin_amdgcn_exp2f(-dl); l_reg*=f; if(hi==0)wsf[r32]=f; resc=true; } } \
    MMASK(C0,C1,t); \
    SBAR(); \
    GAPB(o[0]=__builtin_amdgcn_mfma_f32_32x32x16_bf16(PAF(0),VFR(0),o[0],0,0,0), C0,0); \
    GAPB(o[1]=__builtin_amdgcn_mfma_f32_32x32x16_bf16(PAF(0),VFR(4),o[1],0,0,0), C0,4); \
    KRD(GL,0); GAPB(o[0]=__builtin_amdgcn_mfma_f32_32x32x16_bf16(PAF(1),VFR(1),o[0],0,0,0), C0,8); \
    KRD(GL,1); GAPB(o[1]=__builtin_amdgcn_mfma_f32_32x32x16_bf16(PAF(1),VFR(5),o[1],0,0,0), C0,12); \
    KRD(GL,2); GAPB(o[0]=__builtin_amdgcn_mfma_f32_32x32x16_bf16(PAF(2),VFR(2),o[0],0,0,0), C1,0); \
    KRD(GL,3); GAPB(o[1]=__builtin_amdgcn_mfma_f32_32x32x16_bf16(PAF(2),VFR(6),o[1],0,0,0), C1,4); \
    GAPB(o[0]=__builtin_amdgcn_mfma_f32_32x32x16_bf16(PAF(3),VFR(3),o[0],0,0,0), C1,8); \
    GAPB(o[1]=__builtin_amdgcn_mfma_f32_32x32x16_bf16(PAF(3),VFR(7),o[1],0,0,0), C1,12); \
    }while(0)
  int t=1;
  #undef CMASK
  #define CMASK(P0,P1,t) do{}while(0)
  for(;t+5<NT;t+=2){
    STEP(pB0,pB1,pA0,pA1,t,true,true,true);     WAIT_BAR(2); RESC(); ROT();
    STEP(pA0,pA1,pB0,pB1,t+1,true,true,true);   WAIT_BAR(2); RESC(); ROT();
  }
  #undef CMASK
  #define CMASK(P0,P1,t) do{int jb_=(t)-(NT-4); if(jb_>=0)cmask(P0,P1,jb_,qrel,hi);}while(0)
  #define ENDW(tt) do{ if((tt)+3<NT){WAIT_BAR(2);} else if((tt)+2<NT){WAIT_BAR(1);} else {WAIT_BAR(0);} }while(0)
  for(;t+1<NT;t+=2){
    STEP(pB0,pB1,pA0,pA1,t,(t+3<NT),(t+1<NT),(t+1<NT));       ENDW(t);   RESC(); ROT();
    STEP(pA0,pA1,pB0,pB1,t+1,(t+4<NT),(t+2<NT),(t+2<NT));     ENDW(t+1); RESC(); ROT();
  }
  STEP(pB0,pB1,pA0,pA1,NT-1,false,false,false); RESC();
  { float sacc=pB0[0]+pB0[1]; _Pragma("unroll") for(int r=2;r<16;++r)sacc+=pB0[r]; _Pragma("unroll") for(int r=0;r<16;++r)sacc+=pB1[r]; l_reg+=sacc;
    pw0=(u32x4){PKW(pB0,0),PKW(pB0,2),PKW(pB0,4),PKW(pB0,6)};pw1=(u32x4){PKW(pB0,8),PKW(pB0,10),PKW(pB0,12),PKW(pB0,14)};pw2=(u32x4){PKW(pB1,0),PKW(pB1,2),PKW(pB1,4),PKW(pB1,6)};pw3=(u32x4){PKW(pB1,8),PKW(pB1,10),PKW(pB1,12),PKW(pB1,14)};
    SBAR(); pv(o,vb0+sl_cur,PAF(0),PAF(1),PAF(2),PAF(3)); }
  #undef PKW
  #undef PAF
  #undef VFR
  #undef PIN
  #undef MX3
  #undef GAPA
  #undef GAPB
  #undef EX
  #undef VRD
  #undef KRD
  #undef STEP
  #undef ENDW
  {auto rr=__builtin_amdgcn_permlane32_swap(__float_as_uint(l_reg),__float_as_uint(l_reg),false,false);l_reg=__uint_as_float(rr[0])+__uint_as_float(rr[1]);}
  if(hi==0)wsf[32+r32]=l_reg;asm volatile("s_waitcnt lgkmcnt(0)":::"memory");
  float rli[16];
  #pragma unroll
  for(int r=0;r<16;++r)rli[r]=__builtin_amdgcn_rcpf(wsf[32+crow(r,hi)]);
  bf16*Ow=O+(rowbase+q0+wid*QBLK)*DM+h*D;
  { bf16*stg=(bf16*)(shm+LDS_OST)+wid*2048;
    #pragma unroll
    for(int r=0;r<16;++r){const int orow=crow(r,hi);
      #pragma unroll
      for(int d0=0;d0<2;++d0)stg[orow*64+d0*32+r32]=__float2bfloat16(o[d0][r]*rli[r]);}
    asm volatile("s_waitcnt lgkmcnt(0)":::"memory");
    #pragma unroll
    for(int i=0;i<4;++i){const int row=i*8+(lane>>3),ch=lane&7; const u32x4 v=*(const u32x4*)(stg+row*64+ch*8); ATTN_STORE16(Ow+(long)row*DM+ch*8,v);} }
  asm volatile("s_waitcnt lgkmcnt(0)\n\ts_barrier":::"memory");
  #undef MMASK
  #undef DMA_K
  #undef DMA_V
  #undef CMASK
  #undef START
  #undef RESC
  #undef ROT
}
constexpr int ATTN_LDS_BYTES=LDS_BYTES;
struct AttnTensors { const bf16* Q; const bf16* K; const bf16* V; bf16* O; };
struct AttnUnit { int bh; int qb; };
struct StaticOrder {
  int vcu;
  __device__ __forceinline__ explicit StaticOrder(int grid,int block):vcu((block%8)*(grid/8)+block/8){}
  __device__ __forceinline__ bool next(int i,AttnUnit&u)const{ if(i>=4)return false; const int s=vcu&7; u.bh=vcu>>3; u.qb=(i==0)?s:(i==1)?15-s:(i==2)?16+s:31-s; return true; }
  __device__ __forceinline__ void a_ready(const AttnUnit&)const{}
  __device__ __forceinline__ void done(const AttnUnit&)const{}
};
template<class Sched,int THRL=8> __device__ __forceinline__ void attn_phase(char*lds,const AttnTensors&T,const Sched&S){
  AttnUnit u;
  for(int i=0;S.next(i,u);++i){ S.a_ready(u); attn_unit<THRL>(u.bh/NHEAD,u.bh%NHEAD,u.qb,T.Q,T.K,T.V,T.O,lds); S.done(u); }
}
#undef SBAR
#undef WAIT_BAR
}
#define GAS __attribute__((address_space(1)))
#define LAS __attribute__((address_space(3)))
#define XB_TMO      128
#define XB_XCNT(j)  (256  + 64 * (j))
#define XB_XSUB(j)  (1280 + 64 * (j))
#define XB_XGEN(j)  (2304 + 64 * (j))
#define XB_TOP      3328
#define XB_TOPGEN   3392
#define XCD_BAR_WORDS 3456
#define XB_SPIN_CAP (1u << 18)

__device__ __forceinline__ unsigned xb_ld(unsigned* p)              { return __hip_atomic_load(p, __ATOMIC_RELAXED, __HIP_MEMORY_SCOPE_AGENT); }
__device__ __forceinline__ unsigned xb_add(unsigned* p, unsigned v) { return __hip_atomic_fetch_add(p, v, __ATOMIC_RELAXED, __HIP_MEMORY_SCOPE_AGENT); }
__device__ __forceinline__ unsigned xb_xcc_id() { return (unsigned)__builtin_amdgcn_s_getreg((3 << 11) | 20) & 0xFu; }
#define XB_SPIN(cond, bar) do { unsigned _sp = 0; while (cond) { __builtin_amdgcn_s_sleep(1); \
    if ((++_sp & 255u) == 0u) { if (xb_ld(&(bar)[XB_TMO])) break; if (_sp > XB_SPIN_CAP) { atomicAdd(&(bar)[XB_TMO], 1u); break; } } } } while (0)

struct XcdBarrier {
    unsigned* bar; unsigned x;
    volatile LAS unsigned* st;
};

__device__ __forceinline__ XcdBarrier xcd_barrier_post(unsigned* bar, volatile LAS unsigned* st) {
    XcdBarrier b; b.bar = bar; b.x = xb_xcc_id(); b.st = st;
    if (threadIdx.x == 0) (void)xb_add(&bar[XB_XCNT(b.x)], 1u);
    return b;
}
__device__ __forceinline__ void xcd_barrier_complete(unsigned* bar, unsigned x, unsigned& nloc, unsigned& nx) {
    const unsigned G = gridDim.x * gridDim.y * gridDim.z;
    unsigned sum, cnt, mine, sp = 0u;
    for (;;) {
        sum = 0u; cnt = 0u; mine = 0u;
#pragma unroll
        for (unsigned j = 0; j < 16; ++j) { const unsigned c = xb_ld(&bar[XB_XCNT(j)]); sum += c; cnt += (c > 0u) ? 1u : 0u; mine = (j == x) ? c : mine; }
        if (sum == G) break;
        __builtin_amdgcn_s_sleep(1);
        if ((++sp & 255u) == 0u) { if (xb_ld(&bar[XB_TMO])) break; if (sp > XB_SPIN_CAP) { atomicAdd(&bar[XB_TMO], 1u); break; } }
    }
    nloc = mine > 0u ? mine : 1u; nx = cnt > 0u ? cnt : 1u;
}

__device__ __forceinline__ void xcd_barrier(const XcdBarrier& b) {
    asm volatile("s_waitcnt vmcnt(0)" ::: "memory");
    __syncthreads();
    if (threadIdx.x == 0) {
        unsigned* bar = b.bar;
        __builtin_amdgcn_s_waitcnt(0);
        unsigned nloc = b.st[0], nx = b.st[1];
        if (nloc == 0u) { xcd_barrier_complete(bar, b.x, nloc, nx); b.st[0] = nloc; b.st[1] = nx; }
        const unsigned old = xb_add(&bar[XB_XSUB(b.x)], 1u);
        const unsigned gen = old / nloc;
        if (old + 1u == (gen + 1u) * nloc) {
            __builtin_amdgcn_fence(__ATOMIC_RELEASE, "agent");
            asm volatile("s_waitcnt vmcnt(0)" ::: "memory");
            const unsigned og = xb_add(&bar[XB_TOP], 1u);
            const unsigned tg = og / nx;
            if (og + 1u == (tg + 1u) * nx) xb_add(&bar[XB_TOPGEN], 1u);
            else XB_SPIN(xb_ld(&bar[XB_TOPGEN]) == tg, bar);
            __builtin_amdgcn_fence(__ATOMIC_ACQUIRE, "agent");
            xb_add(&bar[XB_XGEN(b.x)], 1u);
            asm volatile("s_waitcnt vmcnt(0)" ::: "memory");
        } else {
            XB_SPIN(xb_ld(&bar[XB_XGEN(b.x)]) == gen, bar);
            __builtin_amdgcn_fence(__ATOMIC_ACQUIRE, "agent");
            asm volatile("s_waitcnt vmcnt(0)" ::: "memory");
        }
    }
    __syncthreads();
}
typedef unsigned short bf16;
typedef unsigned v4u __attribute__((ext_vector_type(4)));
typedef unsigned v2u __attribute__((ext_vector_type(2)));
typedef float f32x4 __attribute__((ext_vector_type(4)));
typedef float f32x2 __attribute__((ext_vector_type(2)));
typedef float f32x16 __attribute__((ext_vector_type(16)));
typedef short bf16x8 __attribute__((ext_vector_type(8)));
constexpr int NB = 8, SEQ = 2048, DM = 1024, M = NB * SEQ, DFF = 4096;
constexpr int NIN = 7424;
constexpr int NMIX = 4352;
constexpr float EPS = 1e-6f;
constexpr size_t MiB = 1u << 20;
constexpr size_t WS_CTL = 0, WS_ROPEC = 1 * MiB, WS_ROPES = 3 * MiB, WS_KMEAN = 5 * MiB;
constexpr size_t WS_WIN = 6 * MiB, WS_WBO = WS_WIN + (size_t)NIN * DM * 2, WS_WMIX = WS_WBO + 3 * MiB, WS_WUP = WS_WMIX + 2 * MiB, WS_WDN = WS_WUP + 8 * MiB;
static_assert(WS_WDN + 8 * MiB <= 42 * MiB, "weights");
constexpr size_t WS_XN = 42 * MiB;
constexpr size_t WS_Q = 74 * MiB, WS_LR = 90 * MiB, WS_CONV = 106 * MiB, WS_K = 122 * MiB, WS_V = 138 * MiB, WS_LQ = 154 * MiB, WS_LK = 162 * MiB, WS_LV = 170 * MiB,
                 WS_CA = 186 * MiB, WS_CG = 202 * MiB, WS_G = 218 * MiB;
constexpr size_t WS_YB = 122 * MiB, WS_MB = 74 * MiB, WS_Y = 106 * MiB, WS_H = 74 * MiB, WS_Y2 = 202 * MiB, WS_END = 256 * MiB;
constexpr int LDS_RING = 131072, LDS_BYTES = LDS_RING + 1024;

__device__ __forceinline__ unsigned f2bf(float f) { unsigned u = __builtin_bit_cast(unsigned, f); return (u + 0x7fffu + ((u >> 16) & 1u)) >> 16; }
__device__ __forceinline__ unsigned pk2(float lo, float hi) { return pg8::cvt_pk_bf16(lo, hi); }
__device__ __forceinline__ float bflo(unsigned w) { return __uint_as_float(w << 16); }
__device__ __forceinline__ float bfhi(unsigned w) { return __uint_as_float(w & 0xffff0000u); }
__device__ __forceinline__ float bf1(unsigned short h) { return __uint_as_float(((unsigned)h) << 16); }
__device__ __forceinline__ float sigmf(float x) { return 1.0f / (1.0f + __expf(-x)); }
__device__ __forceinline__ float wave_sum(float v) {
#pragma unroll
    for (int o = 1; o < 64; o <<= 1) v += __shfl_xor(v, o);
    return v;
}
__constant__ float c_inv_freq[32] = {1.0f, 0.7498942613601685f, 0.5623413324356079f, 0.4216965138912201f, 0.3162277638912201f, 0.23713737726211548f, 0.17782793939113617f, 0.133352130651474f, 0.10000000149011612f, 0.07498941570520401f, 0.05623413249850273f, 0.04216965287923813f, 0.03162277489900589f, 0.023713737726211548f, 0.017782794311642647f, 0.01333521492779255f, 0.009999999776482582f, 0.007498941849917173f, 0.005623413249850273f, 0.0042169648222625256f, 0.003162277629598975f, 0.00237137358635664f, 0.0017782794311642647f, 0.0013335214462131262f, 0.0010000000474974513f, 0.0007498942431993783f, 0.000562341301701963f, 0.0004216965171508491f, 0.0003162277571391314f, 0.00023713737027719617f, 0.00017782794020604342f, 0.0001333521504420787f};

__device__ __forceinline__ int src_inproj(int n) {
    if (n < 1024) { const int sec = n >> 9, w = n & 511, hd = w >> 6, j = w & 63; return sec * 512 + hd * 64 + (j >> 1) + 32 * (j & 1); }
    if (n < 2560) return n;
    if (n < 2816) return -(n - 2560) - 1;
    return n - 240;
}
template <bool INPROJ> __device__ __forceinline__ void wt_item(const float* W, int K, int ldw, int nblk, bf16* WT, const float* A2, LAS float* scr, int item, int lane) {
    const int kb = item / nblk, nb = item % nblk, k0 = 64 * kb, n0 = 32 * nb;
    const int nd = n0 + (lane & 31); const int src = INPROJ ? src_inproj(nd) : nd;
    if (INPROJ && src < 0) {
        const int nn = -(src + 1);
        float a2[16];
#pragma unroll
        for (int r = 0; r < 16; ++r) a2[r] = A2[r * 256 + nn];
#pragma unroll 2
        for (int i = 0; i < 32; ++i) { const int kk = 2 * i + (lane >> 5); const float* wr = W + (size_t)(k0 + kk) * ldw + 2560; float s = 0.f;
#pragma unroll
            for (int r = 0; r < 16; r += 4) { const f32x4 w4 = *(const f32x4*)(wr + r); s += w4[0] * a2[r] + w4[1] * a2[r + 1] + w4[2] * a2[r + 2] + w4[3] * a2[r + 3]; }
            scr[kk * 33 + (lane & 31)] = s; }
    } else {
#pragma unroll 8
        for (int i = 0; i < 32; ++i) { const int kk = 2 * i + (lane >> 5); scr[kk * 33 + (lane & 31)] = W[(size_t)(k0 + kk) * ldw + src]; }
    }
    asm volatile("s_waitcnt lgkmcnt(0)" ::: "memory");
    const int c = lane & 7;
#pragma unroll
    for (int j = 0; j < 4; ++j) { const int n = (lane >> 3) + 8 * j; const LAS float* s = scr + (8 * c) * 33 + n;
        v4u o; o.x = pk2(s[0 * 33], s[1 * 33]); o.y = pk2(s[2 * 33], s[3 * 33]); o.z = pk2(s[4 * 33], s[5 * 33]); o.w = pk2(s[6 * 33], s[7 * 33]);
        *(v4u*)(WT + (size_t)(n0 + n) * K + k0 + 8 * c) = o; }
    asm volatile("s_waitcnt lgkmcnt(0)" ::: "memory");
}
struct LayerW { const float *w_in, *a2, *w_mo, *w_go, *w_co, *w_mix, *w_up, *w_dn; };
__device__ __forceinline__ void convert_weights(const LayerW& L, unsigned char* ws, LAS unsigned char* lds, int gw, int NGW, int wave, int lane) {
    LAS float* scr = (LAS float*)(lds + wave * 16384);
    bf16* Win = (bf16*)(ws + WS_WIN); bf16* Wbo = (bf16*)(ws + WS_WBO); bf16* Wmix = (bf16*)(ws + WS_WMIX); bf16* Wup = (bf16*)(ws + WS_WUP); bf16* Wdn = (bf16*)(ws + WS_WDN);
    constexpr int I_IN = (DM / 64) * (NIN / 32), I_BO = (512 / 64) * (DM / 32), I_MIX = (DM / 64) * (DM / 32), I_UP = (DM / 64) * (DFF / 32), I_DN = (DFF / 64) * (DM / 32);
    constexpr int NITEMS = I_IN + 3 * I_BO + I_MIX + I_UP + I_DN;
    for (int it = gw; it < NITEMS; it += NGW) {
        int r = it;
        if (r < I_IN) { wt_item<true>(L.w_in, DM, 7184, NIN / 32, Win, L.a2, scr, r, lane); continue; } r -= I_IN;
        if (r < I_BO) { wt_item<false>(L.w_mo, 512, DM, DM / 32, Wbo, nullptr, scr, r, lane); continue; } r -= I_BO;
        if (r < I_BO) { wt_item<false>(L.w_go, 512, DM, DM / 32, Wbo + 512 * 1024, nullptr, scr, r, lane); continue; } r -= I_BO;
        if (r < I_BO) { wt_item<false>(L.w_co, 512, DM, DM / 32, Wbo + 2 * 512 * 1024, nullptr, scr, r, lane); continue; } r -= I_BO;
        if (r < I_MIX) { wt_item<false>(L.w_mix, DM, DM, DM / 32, Wmix, nullptr, scr, r, lane); continue; } r -= I_MIX;
        if (r < I_UP) { wt_item<false>(L.w_up, DM, DFF, DFF / 32, Wup, nullptr, scr, r, lane); continue; } r -= I_UP;
        wt_item<false>(L.w_dn, DFF, DM, DM / 32, Wdn, nullptr, scr, r, lane);
    }
}
__device__ __forceinline__ void row_phase(const float* hin, const bf16* Y, const float* gY, float* hout, const float* gN, bf16* XN, int gw, int NGW, int lane) {
    for (int m = gw; m < M; m += NGW) {
        const f32x4* xr = (const f32x4*)(hin + (size_t)m * DM) + lane;
        f32x4 v[4];
#pragma unroll
        for (int j = 0; j < 4; ++j) v[j] = xr[64 * j];
        if (Y) {
            const v2u* yr = (const v2u*)(Y + (size_t)m * DM) + lane; f32x4 y[4]; float s = 0.f;
#pragma unroll
            for (int j = 0; j < 4; ++j) { const v2u w = yr[64 * j]; y[j] = (f32x4){bflo(w.x), bfhi(w.x), bflo(w.y), bfhi(w.y)}; s += (y[j].x * y[j].x + y[j].y * y[j].y) + (y[j].z * y[j].z + y[j].w * y[j].w); }
            const float rstd = rsqrtf(wave_sum(s) * (1.f / DM) + EPS);
            f32x4* ho = (f32x4*)(hout + (size_t)m * DM) + lane;
#pragma unroll
            for (int j = 0; j < 4; ++j) { const f32x4 g = ((const f32x4*)gY)[lane + 64 * j]; v[j] = v[j] + y[j] * rstd * g; ho[64 * j] = v[j]; }
        }
        if (XN) {
            float s = 0.f;
#pragma unroll
            for (int j = 0; j < 4; ++j) s += (v[j].x * v[j].x + v[j].y * v[j].y) + (v[j].z * v[j].z + v[j].w * v[j].w);
            const float rstd = rsqrtf(wave_sum(s) * (1.f / DM) + EPS);
            v2u* o8 = (v2u*)(XN + (size_t)m * DM) + lane;
#pragma unroll
            for (int j = 0; j < 4; ++j) { const f32x4 g = ((const f32x4*)gN)[lane + 64 * j]; const f32x4 t = v[j] * rstd * g; v2u w; w.x = pk2(t.x, t.y); w.y = pk2(t.z, t.w); o8[64 * j] = w; }
        }
    }
}
constexpr int GL_QS = 0, GL_KS = 9216, GL_KT = 18432, GL_VT = 27648, GL_AS = 46080, GL_ST = 55296, GL_OS = 92160, GL_TOT = 125952, GL_DEC = 128000;
__device__ __forceinline__ int crow16(int r, int hi) { return (r & 3) + 8 * (r >> 2) + 4 * hi; }
__device__ __forceinline__ void gla_unit(int bh, const bf16* lq, const bf16* lk, const bf16* lv, const float* gdec, bf16* lr, const float* gnorm, LAS unsigned char* lds) {
    int tid_l = threadIdx.x; asm volatile("" : "+v"(tid_l));
    const int tid = tid_l, lane = tid & 63, l31 = lane & 31, hi = lane >> 5; const int w = __builtin_amdgcn_readfirstlane(tid >> 6);
    const int b = bh >> 2, hh = bh & 3; const size_t rowbase = (size_t)b * SEQ;
    LAS bf16* Qs = (LAS bf16*)(lds + GL_QS); LAS bf16* Ks = (LAS bf16*)(lds + GL_KS); LAS bf16* KT = (LAS bf16*)(lds + GL_KT); LAS bf16* VT = (LAS bf16*)(lds + GL_VT);
    LAS bf16* As = (LAS bf16*)(lds + GL_AS); LAS bf16* ST = (LAS bf16*)(lds + GL_ST); LAS float* Os = (LAS float*)(lds + GL_OS); LAS float* tot = (LAS float*)(lds + GL_TOT); LAS float* dec = (LAS float*)(lds + GL_DEC);
    const int dt = w >> 2, vt = w & 3;
    f32x16 sacc;
#pragma unroll
    for (int r = 0; r < 16; ++r) sacc[r] = 0.f;
    for (int i = tid; i < 128 * 72 / 2; i += 512) ((LAS unsigned*)ST)[i] = 0u;
    for (int c = 0; c < SEQ / 64; ++c) {
        const size_t r0 = rowbase + (size_t)c * 64 + 8 * w;
        float gl[8]; unsigned short qv[8], kv[8], vv0[8], vv1[8];
#pragma unroll
        for (int t = 0; t < 8; ++t) { const size_t row = r0 + t; gl[t] = gdec[row * 256 + hh * 64 + lane]; qv[t] = lq[row * 256 + hh * 64 + lane]; kv[t] = lk[row * 256 + hh * 64 + lane];
            vv0[t] = lv[row * 512 + hh * 128 + lane]; vv1[t] = lv[row * 512 + hh * 128 + 64 + lane]; }
#pragma unroll
        for (int t = 1; t < 8; ++t) gl[t] += gl[t - 1];
        tot[w * 64 + lane] = gl[7];
        __syncthreads();
        float off = 0.f, glast = 0.f;
#pragma unroll
        for (int j = 0; j < 8; ++j) { const float tj = tot[j * 64 + lane]; glast += tj; if (j < w) off += tj; }
        unsigned kt[4];
#pragma unroll
        for (int t = 0; t < 8; t += 2) {
            const float G0 = off + gl[t], G1 = off + gl[t + 1];
            const float q0 = bf1(qv[t]) * __expf(G0), q1 = bf1(qv[t + 1]) * __expf(G1), k0 = bf1(kv[t]) * __expf(-G0), k1 = bf1(kv[t + 1]) * __expf(-G1);
            const unsigned qp = pk2(q0, q1), kp = pk2(k0, k1);
            Qs[(8 * w + t) * 72 + lane] = (bf16)(qp & 0xffffu); Qs[(8 * w + t + 1) * 72 + lane] = (bf16)(qp >> 16);
            Ks[(8 * w + t) * 72 + lane] = (bf16)(kp & 0xffffu); Ks[(8 * w + t + 1) * 72 + lane] = (bf16)(kp >> 16);
            kt[t >> 1] = kp; }
        *(LAS v4u*)(KT + lane * 72 + 8 * w) = (v4u){kt[0], kt[1], kt[2], kt[3]};
        *(LAS v4u*)(VT + lane * 72 + 8 * w) = (v4u){(unsigned)vv0[0] | ((unsigned)vv0[1] << 16), (unsigned)vv0[2] | ((unsigned)vv0[3] << 16), (unsigned)vv0[4] | ((unsigned)vv0[5] << 16), (unsigned)vv0[6] | ((unsigned)vv0[7] << 16)};
        *(LAS v4u*)(VT + (64 + lane) * 72 + 8 * w) = (v4u){(unsigned)vv1[0] | ((unsigned)vv1[1] << 16), (unsigned)vv1[2] | ((unsigned)vv1[3] << 16), (unsigned)vv1[4] | ((unsigned)vv1[5] << 16), (unsigned)vv1[6] | ((unsigned)vv1[7] << 16)};
        if (w == 0) dec[lane] = __expf(glast);
        __syncthreads();
        {
#pragma unroll
            for (int kk = 0; kk < 4; ++kk) { const bf16x8 a = *(const LAS bf16x8*)(KT + (32 * dt + l31) * 72 + kk * 16 + hi * 8), bb = *(const LAS bf16x8*)(VT + (32 * vt + l31) * 72 + kk * 16 + hi * 8);
                sacc = __builtin_amdgcn_mfma_f32_32x32x16_bf16(a, bb, sacc, 0, 0, 0); }
            LAS bf16* Sn = ST + ((c + 1) & 1) * (128 * 72);
#pragma unroll
            for (int g = 0; g < 4; ++g) { const int d0 = 32 * dt + 8 * g + 4 * hi; const f32x4 dv = *(const LAS f32x4*)(dec + d0);
                sacc[4 * g] *= dv[0]; sacc[4 * g + 1] *= dv[1]; sacc[4 * g + 2] *= dv[2]; sacc[4 * g + 3] *= dv[3];
                *(LAS v2u*)(Sn + (32 * vt + l31) * 72 + d0) = (v2u){pk2(sacc[4 * g], sacc[4 * g + 1]), pk2(sacc[4 * g + 2], sacc[4 * g + 3])}; }
        }
        if (w < 3) {
            const int it = (w == 0) ? 0 : 1, jt = (w == 2) ? 1 : 0;
            f32x16 a16;
#pragma unroll
            for (int r = 0; r < 16; ++r) a16[r] = 0.f;
#pragma unroll
            for (int kk = 0; kk < 4; ++kk) { const bf16x8 a = *(const LAS bf16x8*)(Ks + (32 * jt + l31) * 72 + kk * 16 + hi * 8), bb = *(const LAS bf16x8*)(Qs + (32 * it + l31) * 72 + kk * 16 + hi * 8);
                a16 = __builtin_amdgcn_mfma_f32_32x32x16_bf16(a, bb, a16, 0, 0, 0); }
            const int i = 32 * it + l31;
#pragma unroll
            for (int g = 0; g < 4; ++g) { const int j0 = 32 * jt + 8 * g + 4 * hi;
                const float x0 = (j0 <= i) ? a16[4 * g] : 0.f, x1 = (j0 + 1 <= i) ? a16[4 * g + 1] : 0.f, x2 = (j0 + 2 <= i) ? a16[4 * g + 2] : 0.f, x3 = (j0 + 3 <= i) ? a16[4 * g + 3] : 0.f;
                *(LAS v2u*)(As + i * 72 + j0) = (v2u){pk2(x0, x1), pk2(x2, x3)}; }
        }
        __syncthreads();
        {
            f32x16 o16;
#pragma unroll
            for (int r = 0; r < 16; ++r) o16[r] = 0.f;
            const LAS bf16* Sc = ST + (c & 1) * (128 * 72);
#pragma unroll
            for (int kk = 0; kk < 4; ++kk) { const bf16x8 a = *(const LAS bf16x8*)(Qs + (32 * dt + l31) * 72 + kk * 16 + hi * 8), bb = *(const LAS bf16x8*)(Sc + (32 * vt + l31) * 72 + kk * 16 + hi * 8);
                o16 = __builtin_amdgcn_mfma_f32_32x32x16_bf16(a, bb, o16, 0, 0, 0); }
#pragma unroll
            for (int kk = 0; kk < 4; ++kk) if (kk < 2 || dt == 1) { const bf16x8 a = *(const LAS bf16x8*)(As + (32 * dt + l31) * 72 + kk * 16 + hi * 8), bb = *(const LAS bf16x8*)(VT + (32 * vt + l31) * 72 + kk * 16 + hi * 8);
                o16 = __builtin_amdgcn_mfma_f32_32x32x16_bf16(a, bb, o16, 0, 0, 0); }
#pragma unroll
            for (int r = 0; r < 16; ++r) Os[(32 * dt + crow16(r, hi)) * 132 + 32 * vt + l31] = o16[r];
        }
        __syncthreads();
        {
            const int i = tid >> 3, v0 = (tid & 7) * 16;
            f32x4 o[4]; float ss = 0.f;
#pragma unroll
            for (int j = 0; j < 4; ++j) { o[j] = *(const LAS f32x4*)(Os + i * 132 + v0 + 4 * j); ss += (o[j].x * o[j].x + o[j].y * o[j].y) + (o[j].z * o[j].z + o[j].w * o[j].w); }
            ss += __shfl_xor(ss, 1); ss += __shfl_xor(ss, 2); ss += __shfl_xor(ss, 4);
            const float rstd = rsqrtf(ss * (1.f / 128.f) + EPS);
            bf16* rp = lr + (rowbase + (size_t)c * 64 + i) * 512 + hh * 128 + v0;
            const v4u ra = *(const v4u*)rp, rb = *(const v4u*)(rp + 8);
            const float rr[16] = {bflo(ra.x), bfhi(ra.x), bflo(ra.y), bfhi(ra.y), bflo(ra.z), bfhi(ra.z), bflo(ra.w), bfhi(ra.w), bflo(rb.x), bfhi(rb.x), bflo(rb.y), bfhi(rb.y), bflo(rb.z), bfhi(rb.z), bflo(rb.w), bfhi(rb.w)};
            float out[16];
#pragma unroll
            for (int j = 0; j < 4; ++j) { const f32x4 gn = *(const f32x4*)(gnorm + v0 + 4 * j);
#pragma unroll
                for (int e = 0; e < 4; ++e) { const float r = rr[4 * j + e]; out[4 * j + e] = o[j][e] * rstd * gn[e] * (r * sigmf(r)); } }
            *(v4u*)rp = (v4u){pk2(out[0], out[1]), pk2(out[2], out[3]), pk2(out[4], out[5]), pk2(out[6], out[7])};
            *(v4u*)(rp + 8) = (v4u){pk2(out[8], out[9]), pk2(out[10], out[11]), pk2(out[12], out[13]), pk2(out[14], out[15])};
        }
    }
    __syncthreads();
}
__device__ __forceinline__ void conv_unit(int cu, const bf16* ca, const bf16* cg, bf16* outp, const float* wdw, const float* bdw, const float* gln, const float* bln, LAS unsigned char* lds) {
    int tid_l = threadIdx.x; asm volatile("" : "+v"(tid_l));
    const int tid = tid_l, lane = tid & 63; const int w = __builtin_amdgcn_readfirstlane(tid >> 6);
    const size_t row0 = (size_t)cu * 32; const int s0 = (int)(row0 % SEQ);
    LAS unsigned* us = (LAS unsigned*)lds;
    LAS float* ys = (LAS float*)(lds + 62 * 1024);
    for (int idx = tid; idx < 62 * 64; idx += 512) { const int r = idx >> 6, ch = idx & 63; const int s = s0 - 30 + r;
        v4u o = (v4u){0u, 0u, 0u, 0u};
        if (s >= 0) { const size_t off = (row0 + r - 30) * 512 + ch * 8; const v4u a = *(const v4u*)(ca + off), g = *(const v4u*)(cg + off);
            o.x = pk2(bflo(a.x) * sigmf(bflo(g.x)), bfhi(a.x) * sigmf(bfhi(g.x))); o.y = pk2(bflo(a.y) * sigmf(bflo(g.y)), bfhi(a.y) * sigmf(bfhi(g.y)));
            o.z = pk2(bflo(a.z) * sigmf(bflo(g.z)), bfhi(a.z) * sigmf(bfhi(g.z))); o.w = pk2(bflo(a.w) * sigmf(bflo(g.w)), bfhi(a.w) * sigmf(bfhi(g.w))); }
        *(LAS v4u*)(us + r * 256 + ch * 4) = o; }
    const int cp = tid & 255, th = tid >> 8;
    float w0[31], w1[31];
#pragma unroll
    for (int k = 0; k < 31; ++k) { const f32x2 ww = *(const f32x2*)(wdw + k * 512 + 2 * cp); w0[k] = ww.x; w1[k] = ww.y; }
    const f32x2 bb = *(const f32x2*)(bdw + 2 * cp);
    __syncthreads();
#pragma unroll 1
    for (int tq = 0; tq < 4; ++tq) {
        const int t0 = th * 16 + tq * 4;
        unsigned uw[34];
#pragma unroll
        for (int r = 0; r < 34; ++r) uw[r] = us[(t0 + r) * 256 + cp];
#pragma unroll
        for (int tt = 0; tt < 4; ++tt) { float y0 = bb.x, y1 = bb.y;
#pragma unroll
            for (int k = 0; k < 31; ++k) { y0 += w0[k] * bflo(uw[tt + k]); y1 += w1[k] * bfhi(uw[tt + k]); }
            *(LAS f32x2*)(ys + (t0 + tt) * 512 + 2 * cp) = (f32x2){y0, y1}; }
    }
    __syncthreads();
#pragma unroll 1
    for (int tt = 0; tt < 4; ++tt) { const int t = 4 * w + tt;
        const f32x4 a = *(const LAS f32x4*)(ys + t * 512 + lane * 8), b = *(const LAS f32x4*)(ys + t * 512 + lane * 8 + 4);
        const float mean = wave_sum((a.x + a.y) + (a.z + a.w) + (b.x + b.y) + (b.z + b.w)) * (1.f / 512.f);
        const f32x4 da = a - mean, db = b - mean;
        const float var = wave_sum((da.x * da.x + da.y * da.y) + (da.z * da.z + da.w * da.w) + (db.x * db.x + db.y * db.y) + (db.z * db.z + db.w * db.w)) * (1.f / 512.f);
        const float rstd = rsqrtf(var + EPS);
        const f32x4 g0 = *(const f32x4*)(gln + lane * 8), g1 = *(const f32x4*)(gln + lane * 8 + 4), b0 = *(const f32x4*)(bln + lane * 8), b1 = *(const f32x4*)(bln + lane * 8 + 4);
        f32x4 y0 = da * rstd * g0 + b0, y1 = db * rstd * g1 + b1;
#pragma unroll
        for (int e = 0; e < 4; ++e) { y0[e] = y0[e] * sigmf(y0[e]); y1[e] = y1[e] * sigmf(y1[e]); }
        *(v4u*)(outp + (row0 + t) * 512 + lane * 8) = (v4u){pk2(y0.x, y0.y), pk2(y0.z, y0.w), pk2(y1.x, y1.y), pk2(y1.z, y1.w)}; }
    __syncthreads();
}

struct Params { const float* in[21]; float* out; unsigned char* ws; };
template <int l> __device__ __forceinline__ void layer_body(const Params& p, LAS unsigned char* lds, unsigned char* lds_raw, const XcdBarrier& xbar) {
    int tid_l = threadIdx.x; asm volatile("" : "+v"(tid_l));
    const int tid = tid_l, lane = tid & 63, wave = __builtin_amdgcn_readfirstlane(tid >> 6);
    const int G = gridDim.x, bx = blockIdx.x;
    const int vcu = (G % 8 == 0) ? (bx % 8) * (G / 8) + bx / 8 : bx;
    const int gw = vcu * 8 + wave, NGW = G * 8;
    unsigned char* ws = p.ws;
    unsigned* ctl = (unsigned*)(ws + WS_CTL);
    float* ropec = (float*)(ws + WS_ROPEC); float* ropes = (float*)(ws + WS_ROPES); float* kmean = (float*)(ws + WS_KMEAN);
    bf16* XN = (bf16*)(ws + WS_XN);
    const float* x = p.in[0];
    float* hbuf = p.out;
    {
        const float* hin = (l == 0) ? x : hbuf;
        {
            pg8::Gemm g{(const pg8::bf16_t*)XN, (const pg8::bf16_t*)(ws + WS_WIN), M, NMIX, DM}; pg8::StaticOrder S; S.init(M, NMIX + 0, G, bx);
            pg8::EpiInproj E{(bf16*)(ws + WS_Q), (bf16*)(ws + WS_K), (bf16*)(ws + WS_V), (bf16*)(ws + WS_LQ), (bf16*)(ws + WS_LK), (bf16*)(ws + WS_LV), (bf16*)(ws + WS_LR), (bf16*)(ws + WS_CA), (bf16*)(ws + WS_CG),
                             (float*)(ws + WS_G), kmean, ropec, ropes, p.in[6] + l * 256, 0.125f * 1.4426950408889634f};
#ifndef NO_G1
            pg8::gemm_phase<pg8::EpiInproj, pg8::StaticOrder, true, true>(lds, g, S, E);
#endif
        }
        xcd_barrier(xbar);
        {
            LAS unsigned* slot = (LAS unsigned*)(lds + LDS_RING);
            for (;;) {
                __syncthreads();
                if (tid == 0) *slot = atomicAdd(ctl + 64 * l, 1u);
                __syncthreads();
                const int u = (int)*slot;
                if (u >= 32 + 512 + 512) break;
#ifndef NO_GLA
                if (u < 32) gla_unit(u, (const bf16*)(ws + WS_LQ), (const bf16*)(ws + WS_LK), (const bf16*)(ws + WS_LV), (const float*)(ws + WS_G), (bf16*)(ws + WS_LR), p.in[7] + l * 128, lds);
#endif
#ifndef NO_ATTN
                if (u >= 32 && u < 544) { const int a = u - 32, qb = 7 - (a >> 6), bh = a & 63;
                    attn_body::attn_unit<8>(bh >> 3, bh & 7, qb, (const attn_body::bf16*)(ws + WS_Q), (const attn_body::bf16*)(ws + WS_K), (const attn_body::bf16*)(ws + WS_V), (attn_body::bf16*)(ws + WS_Q), kmean, (char*)lds_raw); }
#endif
#ifndef NO_CONV
                if (u >= 544) conv_unit(u - 544, (const bf16*)(ws + WS_CA), (const bf16*)(ws + WS_CG), (bf16*)(ws + WS_CONV), p.in[8] + l * 31 * 512, p.in[9] + l * 512, p.in[10] + l * 512, p.in[11] + l * 512, lds);
#endif
            }
        }
        xcd_barrier(xbar);
        {
            pg8::Gemm g{(const pg8::bf16_t*)(ws + WS_Q), (const pg8::bf16_t*)(ws + WS_WBO), 3 * M, 3 * DM, 512}; pg8::SchedBranch S{G, bx};
            pg8::EpiStore<0> E{(bf16*)(ws + WS_YB), DM, 4, (size_t)M * DM};
#ifndef NO_G2
            pg8::gemm_phase<pg8::EpiStore<0>, pg8::SchedBranch, true, true>(lds, g, S, E);
#endif
        }
        xcd_barrier(xbar);
        {
            pg8::Gemm g{(const pg8::bf16_t*)XN, (const pg8::bf16_t*)(ws + WS_WIN) + (size_t)NMIX * DM, M, 3 * DM, DM}; pg8::SchedGates S{G, bx};
            pg8::EpiGate E{(const bf16*)(ws + WS_YB), (size_t)M * DM, (bf16*)(ws + WS_MB), p.in[4] + l * 3072};
#ifndef NO_G3
            pg8::gemm_phase<pg8::EpiGate, pg8::SchedGates, true, true>(lds, g, S, E);
#endif
        }
        xcd_barrier(xbar);
        {
            pg8::Gemm g{(const pg8::bf16_t*)(ws + WS_MB), (const pg8::bf16_t*)(ws + WS_WMIX), M, DM, DM}; pg8::StaticOrder S; S.init(M, DM, G, bx);
            pg8::EpiStore<0> E{(bf16*)(ws + WS_Y), DM, 1 << 20, 0};
#ifndef NO_G4
            pg8::gemm_phase<pg8::EpiStore<0>, pg8::StaticOrder, true, true>(lds, g, S, E);
#endif
        }
        xcd_barrier(xbar);
        row_phase(hin, (const bf16*)(ws + WS_Y), p.in[16] + l * DM, hbuf, p.in[17] + l * DM, XN, gw, NGW, lane);
        xcd_barrier(xbar);
        {
            pg8::Gemm g{(const pg8::bf16_t*)XN, (const pg8::bf16_t*)(ws + WS_WUP), M, DFF, DM}; pg8::StaticOrder S; S.init(M, DFF, G, bx);
            pg8::EpiStore<1> E{(bf16*)(ws + WS_H), DFF, 1 << 20, 0};
#ifndef NO_G5
            pg8::gemm_phase<pg8::EpiStore<1>, pg8::StaticOrder, true, true>(lds, g, S, E);
#endif
        }
        xcd_barrier(xbar);
        {
            pg8::Gemm g{(const pg8::bf16_t*)(ws + WS_H), (const pg8::bf16_t*)(ws + WS_WDN), M, DM, DFF}; pg8::StaticOrder S; S.init(M, DM, G, bx);
            pg8::EpiStore<0> E{(bf16*)(ws + WS_Y2), DM, 1 << 20, 0};
#ifndef NO_G6
            pg8::gemm_phase<pg8::EpiStore<0>, pg8::StaticOrder, true, true>(lds, g, S, E);
#endif
        }
        xcd_barrier(xbar);
        if (l == 0) {
            LayerW L{p.in[3] + (size_t)DM * 7184, p.in[5] + 16 * 256, p.in[12] + 512 * DM, p.in[13] + 512 * DM, p.in[14] + 512 * DM, p.in[15] + DM * DM, p.in[18] + (size_t)DM * DFF, p.in[19] + (size_t)DFF * DM};
    #ifndef NO_CVT
        convert_weights(L, ws, lds, gw, NGW, wave, lane);
#endif
            for (int i = bx * 512 + tid; i < 64 * 512; i += G * 512) kmean[i] = 0.f;
            row_phase(hbuf, (const bf16*)(ws + WS_Y2), p.in[20], hbuf, p.in[2] + DM, XN, gw, NGW, lane);
            xcd_barrier(xbar);
        } else {
            row_phase(hbuf, (const bf16*)(ws + WS_Y2), p.in[20] + DM, hbuf, nullptr, nullptr, gw, NGW, lane);
        }
        }
}
__global__ void __launch_bounds__(512, 2) mk_fwd(Params p) {
    extern __shared__ __attribute__((aligned(16))) unsigned char lds_raw[];
    cg::grid_group grid = cg::this_grid();
    LAS unsigned char* lds = (LAS unsigned char*)lds_raw;
    if (threadIdx.x < 64) ((LAS unsigned*)(lds + LDS_RING + 256))[threadIdx.x] = 0u;
    __syncthreads();
    const XcdBarrier xbar = xcd_barrier_post((unsigned*)(p.ws + WS_CTL) + 4096, (volatile LAS unsigned*)(lds + LDS_RING + 256));
    const int tid = threadIdx.x, lane = tid & 63, wave = __builtin_amdgcn_readfirstlane(tid >> 6);
    const int G = gridDim.x, bx = blockIdx.x;
    const int vcu = (G % 8 == 0) ? (bx % 8) * (G / 8) + bx / 8 : bx;
    const int gw = vcu * 8 + wave, NGW = G * 8;
    unsigned char* ws = p.ws;
    unsigned* ctl = (unsigned*)(ws + WS_CTL);
    float* ropec = (float*)(ws + WS_ROPEC); float* ropes = (float*)(ws + WS_ROPES); float* kmean = (float*)(ws + WS_KMEAN);
    bf16* XN = (bf16*)(ws + WS_XN);
    const float* x = p.in[0]; const int* positions = (const int*)p.in[1];
    float* hbuf = p.out;

    {
        LayerW L{p.in[3], p.in[5], p.in[12], p.in[13], p.in[14], p.in[15], p.in[18], p.in[19]};
#ifndef NO_CVT
        convert_weights(L, ws, lds, gw, NGW, wave, lane);
#endif
        for (int i = bx * 512 + tid; i < M * 32; i += G * 512) { const int m = i >> 5, f = i & 31; const float ang = (float)positions[m] * c_inv_freq[f];
            const double rev = (double)ang * 0.15915494309189535; const float fr = (float)(rev - __builtin_rint(rev));
            ropec[i] = __builtin_amdgcn_cosf(fr); ropes[i] = __builtin_amdgcn_sinf(fr); }
        for (int i = bx * 512 + tid; i < 64 * 512; i += G * 512) kmean[i] = 0.f;
        row_phase(x, nullptr, nullptr, nullptr, p.in[2], XN, gw, NGW, lane);
    }
    grid.sync();
    layer_body<0>(p, lds, lds_raw, xbar);
    layer_body<1>(p, lds, lds_raw, xbar);
}

extern "C" void kernel_launch(void* const* d_in, const int* in_sizes, int n_in, void* d_out, int out_size, void* d_ws, size_t ws_size, hipStream_t stream) {
    static int grid = 0;
    if (grid == 0) {
        if (n_in != 21 || out_size != M * DM || ws_size < WS_END) { fprintf(stderr, "kernel_launch: unexpected shapes (n_in %d out %d ws %zu)\n", n_in, out_size, ws_size); grid = -1; return; }
        int dev = 0, cus = 0, per_cu = 0;
        hipGetDevice(&dev);
        hipDeviceGetAttribute(&cus, hipDeviceAttributeMultiprocessorCount, dev);
        hipFuncSetAttribute((const void*)mk_fwd, hipFuncAttributeMaxDynamicSharedMemorySize, LDS_BYTES);
        hipOccupancyMaxActiveBlocksPerMultiprocessor(&per_cu, (const void*)mk_fwd, 512, LDS_BYTES);
        if (per_cu < 1) { fprintf(stderr, "kernel_launch: occupancy query says %d blocks per CU\n", per_cu); per_cu = 1; }
        if (per_cu > 1) per_cu = 1;
        grid = cus * per_cu;
        (void)hipGetLastError();
    }
    if (grid < 0) return;
    hipMemsetAsync((char*)d_ws + WS_CTL, 0, 65536, stream);
    Params p{};
    for (int i = 0; i < 21; ++i) p.in[i] = (const float*)d_in[i];
    p.out = (float*)d_out; p.ws = (unsigned char*)d_ws;
    void* args[] = {&p};
    hipError_t e = hipLaunchCooperativeKernel((const void*)mk_fwd, dim3(grid), dim3(512), args, LDS_BYTES, stream);
    if (e != hipSuccess) fprintf(stderr, "cooperative launch failed: %s (grid %d)\n", hipGetErrorString(e), grid);
}
```

```cpp
#include <hip/hip_runtime.h>
#include <hip/hip_cooperative_groups.h>
#include <cstdio>
#include <cstdint>
namespace cg = cooperative_groups;
namespace pg8 {
#define PG8_LAS __attribute__((address_space(3)))
typedef unsigned short bf16_t;
typedef short bf16x8 __attribute__((ext_vector_type(8)));
typedef float f32x4 __attribute__((ext_vector_type(4)));
typedef unsigned u32x4 __attribute__((ext_vector_type(4)));
constexpr int BM = 256, BK = 64, HALF = 128, HTB = HALF * BK * 2  , STAGE_BYTES = 8 * HTB, NXCD = 8, WGM = 8;

__host__ __device__ __forceinline__ int lds_byte(int r, int c) { const int st = (r >> 4) * 2 + (c >> 5), rr = r & 15, cc = c & 31, ob = rr * 64 + cc * 2; return st * 1024 + (ob ^ (((ob >> 9) & 1) << 5)); }
__host__ __device__ __forceinline__ void stage_rc(int b, int& R, int& C) { const int st = b / 1024, sb = b % 1024, swz = sb ^ (((sb >> 9) & 1) << 5); R = (st >> 1) * 16 + swz / 64; C = (st & 1) * 32 + (swz % 64) / 2; }
__host__ __device__ __forceinline__ int perm32(int rho) { const int n = rho >> 4, i = rho & 15; return 8 * (i >> 2) + 4 * n + (i & 3); }

struct Unit { int pm, pn; };
struct Gemm { const bf16_t* A; const bf16_t* Bt; int M, N, K; };

struct StaticOrder {
    int nM, nN, nwg, G, c;
    __host__ __device__ void init(int M, int N, int G_, int c_) { nM = M / BM; nN = N / BM; nwg = nM * nN; G = G_; c = c_; }
    __host__ __device__ bool next(int i, Unit& u) const {
        const long L = (long)i * G + c; if (L >= nwg) return false;
        int wgid = (int)L; { const int q = nwg / NXCD, r = nwg % NXCD, xcd = wgid % NXCD, off = wgid / NXCD; wgid = (xcd < r ? xcd * (q + 1) : r * (q + 1) + (xcd - r) * q) + off; }
        const int nig = WGM * nN, gid = wgid / nig, fm = gid * WGM, gsz = (nM - fm) < WGM ? (nM - fm) : WGM;
        u.pm = fm + ((wgid % nig) % gsz); u.pn = (wgid % nig) / gsz; return true;
    }
    __device__ __forceinline__ void a_ready(const Unit&) const {}
    __device__ __forceinline__ void done(const Unit&) const {}
};

__device__ __forceinline__ unsigned cvt_pk_bf16(float lo, float hi) { unsigned r; asm volatile("v_cvt_pk_bf16_f32 %0, %1, %2" : "=v"(r) : "v"(lo), "v"(hi)); return r; }
typedef float f32x2 __attribute__((ext_vector_type(2)));
typedef unsigned u32x2 __attribute__((ext_vector_type(2)));
__device__ __forceinline__ float bf_lo(unsigned w) { return __uint_as_float(w << 16); }
__device__ __forceinline__ float bf_hi(unsigned w) { return __uint_as_float(w & 0xffff0000u); }
__device__ __forceinline__ float sigm(float x) { return 1.0f / (1.0f + __expf(-x)); }
__device__ __forceinline__ u32x4 pack8(const f32x4 a, const f32x4 b) { u32x4 w; w.x = cvt_pk_bf16(a[0], a[1]); w.y = cvt_pk_bf16(a[2], a[3]); w.z = cvt_pk_bf16(b[0], b[1]); w.w = cvt_pk_bf16(b[2], b[3]); return w; }

__host__ __device__ __forceinline__ void tile_of(int wgid, int nM, int nN, int& pm, int& pn) {
    const int nwg = nM * nN;
    { const int q = nwg / NXCD, r = nwg % NXCD, xcd = wgid % NXCD, off = wgid / NXCD; wgid = (xcd < r ? xcd * (q + 1) : r * (q + 1) + (xcd - r) * q) + off; }
    const int nig = WGM * nN, gid = wgid / nig, fm = gid * WGM, gsz = (nM - fm) < WGM ? (nM - fm) : WGM;
    pm = fm + ((wgid % nig) % gsz); pn = (wgid % nig) / gsz;
}
struct SchedBranch {
    int G, c;
    __device__ bool next(int i, Unit& u) const { const long L = (long)i * G + c; if (L >= 768) return false; const int j = (int)(L / 256); int pm, pn; tile_of((int)(L % 256), 64, 4, pm, pn); u.pm = 64 * j + pm; u.pn = 4 * j + pn; return true; }
    __device__ __forceinline__ void a_ready(const Unit&) const {}
    __device__ __forceinline__ void done(const Unit&) const {}
};
struct SchedGates {
    int G, c;
    __device__ bool next(int i, Unit& u) const { const int j = i % 3, rnd = i / 3; const long L = (long)rnd * G + c; if (L >= 256) return false; int pm, pn; tile_of((int)L, 64, 4, pm, pn); u.pm = pm; u.pn = 4 * j + pn; return true; }
    __device__ __forceinline__ void a_ready(const Unit&) const {}
    __device__ __forceinline__ void done(const Unit&) const {}
};

template <int ACT  > struct EpiStore {
    static constexpr bool PERM = true, AFTER_DRAIN = false;
    bf16_t* O; int ldc; int jdiv; size_t jstride;
    __device__ __forceinline__ void operator()(const f32x4 (&acc)[2][2][4][2], const Unit& u, int wr, int wc, int fr, int fq) const {
        const int j = u.pn / jdiv; const int pm = u.pm - 64 * j, pn = u.pn - jdiv * j;
        bf16_t* base = O + (size_t)j * jstride;
        const int row0 = pm * BM + wr * 64 + fr, col0 = pn * BM + wc * 32 + 8 * fq;
#pragma unroll
        for (int ai = 0; ai < 2; ++ai)
#pragma unroll
            for (int m = 0; m < 4; ++m) { bf16_t* rowp = base + (size_t)(row0 + ai * HALF + m * 16) * ldc + col0;
#pragma unroll
                for (int bj = 0; bj < 2; ++bj) { f32x4 v0 = acc[ai][bj][m][0], v1 = acc[ai][bj][m][1];
                    if (ACT == 1) {
#pragma unroll
                        for (int e = 0; e < 4; ++e) { const float a = fmaxf(v0[e], 0.f), b = fmaxf(v1[e], 0.f); v0[e] = a * a; v1[e] = b * b; } }
                    *(u32x4*)(rowp + bj * HALF) = pack8(v0, v1); } }
    }
};
struct EpiGate {
    static constexpr bool PERM = true, AFTER_DRAIN = false;
    const bf16_t* Y; size_t ystride; bf16_t* Mb; const float* bgate;
    __device__ __forceinline__ void operator()(const f32x4 (&acc)[2][2][4][2], const Unit& u, int wr, int wc, int fr, int fq) const {
        const int j = u.pn >> 2, pn = u.pn & 3;
        const bf16_t* Yj = Y + (size_t)j * ystride;
        const int row0 = u.pm * BM + wr * 64 + fr, col0 = pn * BM + wc * 32 + 8 * fq;
        f32x4 bv[2][2];
#pragma unroll
        for (int bj = 0; bj < 2; ++bj)
#pragma unroll
            for (int n = 0; n < 2; ++n) bv[bj][n] = *(const f32x4*)(bgate + j * 1024 + col0 + bj * HALF + 4 * n);
#pragma unroll
        for (int ai = 0; ai < 2; ++ai)
#pragma unroll
            for (int m = 0; m < 4; ++m) { const size_t off = (size_t)(row0 + ai * HALF + m * 16) * 1024 + col0;
#pragma unroll
                for (int bj = 0; bj < 2; ++bj) { const size_t o2 = off + bj * HALF;
                    const u32x4 yw = *(const u32x4*)(Yj + o2); u32x4 mw = (u32x4){0u, 0u, 0u, 0u}; if (j > 0) mw = *(const u32x4*)(Mb + o2);
                    const f32x4 x0 = acc[ai][bj][m][0] + bv[bj][0], x1 = acc[ai][bj][m][1] + bv[bj][1];
                    f32x4 r0, r1;
                    r0[0] = sigm(x0[0]) * bf_lo(yw.x) + bf_lo(mw.x); r0[1] = sigm(x0[1]) * bf_hi(yw.x) + bf_hi(mw.x);
                    r0[2] = sigm(x0[2]) * bf_lo(yw.y) + bf_lo(mw.y); r0[3] = sigm(x0[3]) * bf_hi(yw.y) + bf_hi(mw.y);
                    r1[0] = sigm(x1[0]) * bf_lo(yw.z) + bf_lo(mw.z); r1[1] = sigm(x1[1]) * bf_hi(yw.z) + bf_hi(mw.z);
                    r1[2] = sigm(x1[2]) * bf_lo(yw.w) + bf_lo(mw.w); r1[3] = sigm(x1[3]) * bf_hi(yw.w) + bf_hi(mw.w);
                    *(u32x4*)(Mb + o2) = pack8(r0, r1); } }
    }
};
struct EpiInproj {
    static constexpr bool PERM = true, AFTER_DRAIN = false;
    bf16_t *Q, *Kb, *V, *lq, *lk, *lv, *lr, *ca, *cg; float* gdec; float* kmean; const float* ropec; const float* ropes; const float* bgla; float qscale;
    __device__ __forceinline__ void operator()(const f32x4 (&acc)[2][2][4][2], const Unit& u, int wr, int wc, int fr, int fq) const {
        const int pn = u.pn;
        const int row0 = u.pm * BM + wr * 64 + fr, cl = wc * 32 + 8 * fq;
        if (pn < 4) {
            const bool isk = pn >= 2; bf16_t* dst = isk ? Kb : Q; const int ct = (pn & 1) * 256; const float sc = isk ? 1.0f : qscale;
#pragma unroll
            for (int bj = 0; bj < 2; ++bj) { const int c = ct + bj * HALF + cl, i0 = (c & 63) >> 1;
                float cs[8];
#pragma unroll
                for (int e = 0; e < 8; ++e) cs[e] = 0.f;
#pragma unroll
                for (int ai = 0; ai < 2; ++ai)
#pragma unroll
                    for (int m = 0; m < 4; ++m) { const int row = row0 + ai * HALF + m * 16;
                        const f32x4 co = *(const f32x4*)(ropec + (size_t)row * 32 + i0), si = *(const f32x4*)(ropes + (size_t)row * 32 + i0);
                        const f32x4 v0 = acc[ai][bj][m][0], v1 = acc[ai][bj][m][1]; f32x4 o0, o1;
                        o0[0] = (v0[0] * co[0] - v0[1] * si[0]) * sc; o0[1] = (v0[1] * co[0] + v0[0] * si[0]) * sc;
                        o0[2] = (v0[2] * co[1] - v0[3] * si[1]) * sc; o0[3] = (v0[3] * co[1] + v0[2] * si[1]) * sc;
                        o1[0] = (v1[0] * co[2] - v1[1] * si[2]) * sc; o1[1] = (v1[1] * co[2] + v1[0] * si[2]) * sc;
                        o1[2] = (v1[2] * co[3] - v1[3] * si[3]) * sc; o1[3] = (v1[3] * co[3] + v1[2] * si[3]) * sc;
#pragma unroll
                        for (int e = 0; e < 4; ++e) { cs[e] += o0[e]; cs[4 + e] += o1[e]; }
                        *(u32x4*)(dst + (size_t)row * 512 + c) = pack8(o0, o1); }
                if (isk) {
#pragma unroll
                    for (int e = 0; e < 8; ++e) { float s = cs[e]; s += __shfl_xor(s, 1); s += __shfl_xor(s, 2); s += __shfl_xor(s, 4); s += __shfl_xor(s, 8); cs[e] = s; }
                    if (fr == 0) {
#pragma unroll
                        for (int e = 0; e < 8; ++e) atomicAdd(kmean + (size_t)u.pm * 512 + c + e, cs[e]); } } }
        } else if (pn == 10) {
#pragma unroll
            for (int bj = 0; bj < 2; ++bj) { const int c = bj * HALF + cl; const f32x4 b0 = *(const f32x4*)(bgla + c), b1 = *(const f32x4*)(bgla + c + 4);
#pragma unroll
                for (int ai = 0; ai < 2; ++ai)
#pragma unroll
                    for (int m = 0; m < 4; ++m) { const int row = row0 + ai * HALF + m * 16; const f32x4 x0 = acc[ai][bj][m][0] + b0, x1 = acc[ai][bj][m][1] + b1; f32x4 g0, g1;
#pragma unroll
                        for (int e = 0; e < 4; ++e) { g0[e] = (fminf(x0[e], 0.f) - __logf(1.0f + __expf(-fabsf(x0[e])))) * 0.0625f; g1[e] = (fminf(x1[e], 0.f) - __logf(1.0f + __expf(-fabsf(x1[e])))) * 0.0625f; }
                        *(f32x4*)(gdec + (size_t)row * 256 + c) = g0; *(f32x4*)(gdec + (size_t)row * 256 + c + 4) = g1; } }
        } else {
            bf16_t* dst; int ld = 512, ct; float sc = 1.0f;
            if (pn < 6) { dst = V; ct = (pn - 4) * 256; }
            else if (pn == 6) { dst = lq; ld = 256; ct = 0; sc = 0.125f; }
            else if (pn == 7) { dst = lk; ld = 256; ct = 0; }
            else if (pn < 10) { dst = lv; ct = (pn - 8) * 256; }
            else if (pn < 13) { dst = lr; ct = (pn - 11) * 256; }
            else if (pn < 15) { dst = ca; ct = (pn - 13) * 256; }
            else { dst = cg; ct = (pn - 15) * 256; }
#pragma unroll
            for (int ai = 0; ai < 2; ++ai)
#pragma unroll
                for (int m = 0; m < 4; ++m) { bf16_t* rowp = dst + (size_t)(row0 + ai * HALF + m * 16) * ld + ct + cl;
#pragma unroll
                    for (int bj = 0; bj < 2; ++bj) *(u32x4*)(rowp + bj * HALF) = pack8(acc[ai][bj][m][0] * sc, acc[ai][bj][m][1] * sc); }
        }
    }
};
template <class Epi, class Sched, bool ALIGN_EPI = false, bool SP2 = false>
__device__ __forceinline__ void gemm_phase(PG8_LAS unsigned char* lds, const Gemm g, const Sched& S, const Epi& E) {
    int tid_l = threadIdx.x; asm volatile("" : "+v"(tid_l));
    const int tid = tid_l, wid = __builtin_amdgcn_readfirstlane(tid >> 6), lane = tid & 63, wr = wid >> 2, wc = wid & 3, fr = lane & 15, fq = lane >> 4;
    const int K = g.K, nt = K / BK;
    unsigned voffA[2], voffB[2];
#pragma unroll
    for (int i = 0; i < 2; ++i) { int R, C; stage_rc(tid * 16 + i * 8192, R, C); const int Rb = Epi::PERM ? ((R & ~31) + perm32(R & 31)) : R;
        voffA[i] = (unsigned)(R * K + C) * 2u; voffB[i] = (unsigned)(Rb * K + C) * 2u; }
    const size_t kstep = (size_t)(BK * 2);
    const size_t hstep = (size_t)HALF * K * 2;
    const size_t tstep = 2 * hstep;
    const unsigned ldsw = (unsigned)wid * 1024u;
    const int aoff = lds_byte(wr * 64 + fr, fq * 8), boff = lds_byte(wc * 32 + fr, fq * 8);
#define PG8_SA(b, h) (((b) * 2 + (h)) * HTB)
#define PG8_SB(b, h) ((4 + (b) * 2 + (h)) * HTB)
#define PG8_STAGE(bufoff, gbase, voff) do { _Pragma("unroll") for (int _i = 0; _i < 2; ++_i) \
        __builtin_amdgcn_global_load_lds((const unsigned*)((const char*)(gbase) + (voff)[_i]), (PG8_LAS unsigned*)(lds + (bufoff) + ldsw + _i * 8192), 16, 0, 0); } while (0)
#define PG8_LDA(dst, b, h) do { _Pragma("unroll") for (int m = 0; m < 4; ++m) _Pragma("unroll") for (int k = 0; k < 2; ++k) dst[m][k] = *(const PG8_LAS bf16x8*)(lds + PG8_SA(b, h) + aoff + m * 2048 + k * 1024); } while (0)
#define PG8_LDB(dst, b, h) do { _Pragma("unroll") for (int n = 0; n < 2; ++n) _Pragma("unroll") for (int k = 0; k < 2; ++k) dst[n][k] = *(const PG8_LAS bf16x8*)(lds + PG8_SB(b, h) + boff + n * 2048 + k * 1024); } while (0)
#define PG8_MMA(ai, bj, At, Bt) do { __builtin_amdgcn_s_setprio(1); _Pragma("unroll") for (int m = 0; m < 4; ++m) _Pragma("unroll") for (int n = 0; n < 2; ++n) _Pragma("unroll") for (int k = 0; k < 2; ++k) \
        acc[ai][bj][m][n] = __builtin_amdgcn_mfma_f32_16x16x32_bf16(Bt[n][k], At[m][k], acc[ai][bj][m][n], 0, 0, 0); __builtin_amdgcn_s_setprio(0); } while (0)
#define PG8_WAIT_V(n) asm volatile("s_waitcnt vmcnt(" #n ")" ::: "memory")
#define PG8_WAIT_L(n) asm volatile("s_waitcnt lgkmcnt(" #n ")" ::: "memory")
#define PG8_BAR __builtin_amdgcn_s_barrier()
#define PG8_SCHED __builtin_amdgcn_sched_barrier(0)
    Unit cur, nxt; int ui = 0;
    if (!S.next(0, cur)) return;
    f32x4 acc[2][2][4][2];
#pragma unroll
    for (int a = 0; a < 2; ++a)
#pragma unroll
        for (int b = 0; b < 2; ++b)
#pragma unroll
            for (int m = 0; m < 4; ++m)
#pragma unroll
                for (int n = 0; n < 2; ++n) acc[a][b][m][n] = (f32x4){0.f, 0.f, 0.f, 0.f};
    bf16x8 At[4][2], B0[2][2], B1[2][2];
    const char* cA = (const char*)g.A + (size_t)cur.pm * tstep; const char* cB = (const char*)g.Bt + (size_t)cur.pn * tstep;
    S.a_ready(cur);
    if constexpr (SP2) {
        PG8_STAGE(PG8_SB(0, 0), cB, voffB); PG8_STAGE(PG8_SB(0, 1), cB + hstep, voffB); PG8_STAGE(PG8_SA(0, 0), cA, voffA); PG8_STAGE(PG8_SA(0, 1), cA + hstep, voffA);
        if (wr == 1) PG8_BAR;
        PG8_WAIT_V(2); PG8_BAR;
        PG8_STAGE(PG8_SB(1, 0), cB + kstep, voffB); PG8_STAGE(PG8_SA(1, 0), cA + kstep, voffA); PG8_STAGE(PG8_SB(1, 1), cB + hstep + kstep, voffB);
        PG8_WAIT_V(6); PG8_BAR;
    } else {
        PG8_STAGE(PG8_SB(0, 0), cB, voffB); PG8_STAGE(PG8_SA(0, 0), cA, voffA); PG8_STAGE(PG8_SB(0, 1), cB + hstep, voffB); PG8_STAGE(PG8_SA(0, 1), cA + hstep, voffA);
        if (wr == 1) PG8_BAR;
        PG8_WAIT_V(4); PG8_BAR;
        PG8_STAGE(PG8_SB(1, 0), cB + kstep, voffB); PG8_STAGE(PG8_SA(1, 0), cA + kstep, voffA); PG8_STAGE(PG8_SB(1, 1), cB + hstep + kstep, voffB);
        PG8_WAIT_V(6); PG8_BAR;
    }
    for (;;) {
        const bool has_next = S.next(ui + 1, nxt);
        const char* nA = has_next ? (const char*)g.A + (size_t)nxt.pm * tstep : cA; const char* nB = has_next ? (const char*)g.Bt + (size_t)nxt.pn * tstep : cB;
        for (int t = 0; t < nt; t += 2) {
            const bool last = (t == nt - 2);
            const char* a1 = cA + (size_t)(t + 1) * kstep;
            const char* a2 = last ? nA : cA + (size_t)(t + 2) * kstep; const char* b2 = last ? nB : cB + (size_t)(t + 2) * kstep;
            const char* a3 = a2 + kstep; const char* b3 = b2 + kstep;
            if (last && has_next) S.a_ready(nxt);
            if constexpr (SP2) {
            PG8_LDB(B0, 0, 0); PG8_LDB(B1, 0, 1); PG8_SCHED; PG8_LDA(At, 0, 0); PG8_STAGE(PG8_SA(1, 1), a1 + hstep, voffA);
            PG8_WAIT_V(8); PG8_WAIT_L(0); PG8_BAR; PG8_MMA(0, 0, At, B0); PG8_MMA(0, 1, At, B1); PG8_BAR; PG8_SCHED;
            PG8_LDA(At, 0, 1); PG8_STAGE(PG8_SB(0, 0), b2, voffB); PG8_STAGE(PG8_SB(0, 1), b2 + hstep, voffB); PG8_STAGE(PG8_SA(0, 0), a2, voffA);
            PG8_WAIT_V(8); PG8_WAIT_L(0); PG8_BAR; PG8_MMA(1, 0, At, B0); PG8_MMA(1, 1, At, B1); PG8_BAR; PG8_SCHED;
            PG8_LDB(B0, 1, 0); PG8_LDB(B1, 1, 1); PG8_SCHED; PG8_LDA(At, 1, 0); PG8_STAGE(PG8_SA(0, 1), a2 + hstep, voffA);
            PG8_WAIT_V(8); PG8_WAIT_L(0); PG8_BAR; PG8_MMA(0, 0, At, B0); PG8_MMA(0, 1, At, B1); PG8_BAR; PG8_SCHED;
            PG8_LDA(At, 1, 1); PG8_STAGE(PG8_SB(1, 0), b3, voffB); PG8_STAGE(PG8_SB(1, 1), b3 + hstep, voffB); PG8_STAGE(PG8_SA(1, 0), a3, voffA);
            PG8_WAIT_V(8); PG8_WAIT_L(0); PG8_BAR; PG8_MMA(1, 0, At, B0); PG8_MMA(1, 1, At, B1); PG8_BAR; PG8_SCHED;
            } else {
            PG8_LDB(B0, 0, 0); PG8_SCHED; PG8_LDA(At, 0, 0); PG8_STAGE(PG8_SA(1, 1), a1 + hstep, voffA);
            PG8_WAIT_L(8); PG8_BAR; PG8_WAIT_L(0); PG8_MMA(0, 0, At, B0); PG8_BAR; PG8_SCHED;
            PG8_LDB(B1, 0, 1); PG8_STAGE(PG8_SB(0, 0), b2, voffB);
            PG8_BAR; PG8_WAIT_L(0); PG8_MMA(0, 1, At, B1); PG8_BAR;
            PG8_LDA(At, 0, 1); PG8_STAGE(PG8_SA(0, 0), a2, voffA);
            PG8_BAR; PG8_WAIT_L(0); PG8_MMA(1, 0, At, B0); PG8_BAR; PG8_SCHED;
            PG8_STAGE(PG8_SB(0, 1), b2 + hstep, voffB);
            PG8_WAIT_V(6); PG8_BAR; PG8_MMA(1, 1, At, B1); PG8_BAR;
            PG8_LDB(B0, 1, 0); PG8_SCHED; PG8_LDA(At, 1, 0); PG8_STAGE(PG8_SA(0, 1), a2 + hstep, voffA);
            PG8_WAIT_L(8); PG8_BAR; PG8_WAIT_L(0); PG8_MMA(0, 0, At, B0); PG8_BAR; PG8_SCHED;
            PG8_LDB(B1, 1, 1); PG8_STAGE(PG8_SB(1, 0), b3, voffB);
            PG8_BAR; PG8_WAIT_L(0); PG8_MMA(0, 1, At, B1); PG8_BAR;
            PG8_LDA(At, 1, 1); PG8_STAGE(PG8_SA(1, 0), a3, voffA);
            PG8_BAR; PG8_WAIT_L(0); PG8_MMA(1, 0, At, B0); PG8_BAR; PG8_SCHED;
            PG8_STAGE(PG8_SB(1, 1), b3 + hstep, voffB);
            PG8_WAIT_V(6); PG8_BAR; PG8_MMA(1, 1, At, B1); PG8_BAR;
            }
        }
        if constexpr (ALIGN_EPI) { if (wr == 0) PG8_BAR; }
        if constexpr (!Epi::AFTER_DRAIN) { E(acc, cur, wr, wc, fr, fq); S.done(cur); }
        if (!has_next) break;
#pragma unroll
        for (int a = 0; a < 2; ++a)
#pragma unroll
            for (int b = 0; b < 2; ++b)
#pragma unroll
                for (int m = 0; m < 4; ++m)
#pragma unroll
                    for (int n = 0; n < 2; ++n) acc[a][b][m][n] = (f32x4){0.f, 0.f, 0.f, 0.f};
        cur = nxt; cA = nA; cB = nB; ++ui;
        if constexpr (ALIGN_EPI) { if (wr == 1) PG8_BAR; }
    }
    PG8_WAIT_V(0);
    if constexpr (!ALIGN_EPI) { if (wr == 0) PG8_BAR; }
    PG8_BAR;
    if constexpr (Epi::AFTER_DRAIN) { E.fused(acc, cur, wr, wc, fr, fq, lds, wid, lane); S.done(cur); }
#undef PG8_SA
#undef PG8_SB
#undef PG8_STAGE
#undef PG8_LDA
#undef PG8_LDB
#undef PG8_MMA
#undef PG8_WAIT_V
#undef PG8_WAIT_L
#undef PG8_BAR
#undef PG8_SCHED
}
}
#include <hip/hip_bf16.h>
#include <cmath>
namespace attn_body {
using bf16=__hip_bfloat16;
using bf16x8=__attribute__((ext_vector_type(8)))short;
using s16x4=__attribute__((ext_vector_type(4)))short;
using f32x16=__attribute__((ext_vector_type(16)))float;
using u32x4=__attribute__((ext_vector_type(4)))unsigned;
constexpr int BATCH=8,NHEAD=8,SEQ=2048,D=64,DM=NHEAD*D;
constexpr int NW=8,QBLK=32,QB=QBLK*NW,KVBLK=64,NQB=SEQ/QB;
constexpr int ATTN_PITCH=DM, ATTN_UNIT_ROWS=QB;
__device__ __forceinline__ int crow(int r,int hi){return (r&3)+8*(r>>2)+4*hi;}
#define SBAR() __builtin_amdgcn_sched_barrier(0)
__device__ __forceinline__ void cmask(f32x16&p0,f32x16&p1,int jb,int qrel,int hi){
  const float NEG=-INFINITY; int kb=64*jb+4*hi;
  #pragma unroll
  for(int r=0;r<16;++r){int kv=kb+(r&3)+8*(r>>2); if(kv>qrel)p0[r]=NEG; if(kv+32>qrel)p1[r]=NEG;}
}

constexpr int NSLOT=3, SLOTB=8192;
constexpr int LDS_K=0, LDS_V=NSLOT*SLOTB, LDS_WS=2*NSLOT*SLOTB, LDS_OST=LDS_WS+NW*64*4, LDS_BYTES=LDS_OST+NW*4096;
constexpr float C2=0.125f*1.4426950408889634f;
__device__ __forceinline__ void glds16(const void*gsrc,unsigned lds_dst){unsigned keep;
  asm volatile("s_mov_b32 %0, m0\n\ts_mov_b32 m0, %2\n\ts_nop 0\n\tglobal_load_lds_dwordx4 %1, off\n\ts_mov_b32 m0, %0":"=&s"(keep):"v"(gsrc),"s"(lds_dst):"memory");}
__device__ __forceinline__ float max3f(float a,float b,float c){float r;asm("v_max3_f32 %0, %1, %2, %3":"=v"(r):"v"(a),"v"(b),"v"(c));return r;}
__device__ __forceinline__ float max2f(float a,float b){float r;asm("v_max_f32_e32 %0, %1, %2":"=v"(r):"v"(a),"v"(b));return r;}
__device__ __forceinline__ float fadd_s(float a,float b){float r;asm("v_add_f32_e32 %0, %1, %2":"=v"(r):"v"(a),"v"(b));return r;}
__device__ __forceinline__ float fsub_s(float a,float b){float r;asm("v_sub_f32_e32 %0, %1, %2":"=v"(r):"v"(a),"v"(b));return r;}
typedef float f32x2_t __attribute__((ext_vector_type(2))); typedef float f32x4_t __attribute__((ext_vector_type(4))); typedef __bf16 bf16x2_t __attribute__((ext_vector_type(2)));
__device__ __forceinline__ unsigned cvtpk_s(float lo,float hi){f32x2_t v={lo,hi};bf16x2_t b=__builtin_convertvector(v,bf16x2_t);return __builtin_bit_cast(unsigned,b);}
#define WAIT_BAR(N) asm volatile("s_waitcnt vmcnt(" #N ") lgkmcnt(0)\n\ts_barrier":::"memory")

__device__ __forceinline__ void qkt(f32x16&p0,f32x16&p1,const char*Kslot,const bf16x8*qr,const f32x16&negm,int r32,int hi){
  const char*kb=Kslot+hi*1024+r32*16;
  #pragma unroll
  for(int d0=0;d0<4;++d0){
    const bf16x8 b0=*reinterpret_cast<const bf16x8*>(kb+d0*2048);
    const bf16x8 b1=*reinterpret_cast<const bf16x8*>(kb+d0*2048+512);
    if(d0==0){p0=__builtin_amdgcn_mfma_f32_32x32x16_bf16(b0,qr[0],negm,0,0,0);p1=__builtin_amdgcn_mfma_f32_32x32x16_bf16(b1,qr[0],negm,0,0,0);}
    else{p0=__builtin_amdgcn_mfma_f32_32x32x16_bf16(b0,qr[d0],p0,0,0,0);p1=__builtin_amdgcn_mfma_f32_32x32x16_bf16(b1,qr[d0],p1,0,0,0);}}
}
typedef __attribute__((address_space(3))) const char* lds_cptr;
typedef short v4i16_t __attribute__((ext_vector_type(4)));
__device__ __forceinline__ void kload8(bf16x8*kf,lds_cptr kp){
  kf[0]=*(const __attribute__((address_space(3))) bf16x8*)(kp);      kf[1]=*(const __attribute__((address_space(3))) bf16x8*)(kp+512);
  kf[2]=*(const __attribute__((address_space(3))) bf16x8*)(kp+2048); kf[3]=*(const __attribute__((address_space(3))) bf16x8*)(kp+2560);
  kf[4]=*(const __attribute__((address_space(3))) bf16x8*)(kp+4096); kf[5]=*(const __attribute__((address_space(3))) bf16x8*)(kp+4608);
  kf[6]=*(const __attribute__((address_space(3))) bf16x8*)(kp+6144); kf[7]=*(const __attribute__((address_space(3))) bf16x8*)(kp+6656);
}
__device__ __forceinline__ void kload2(bf16x8*kf,lds_cptr kp,int j){ kf[2*j]=*(const __attribute__((address_space(3))) bf16x8*)(kp+j*2048); kf[2*j+1]=*(const __attribute__((address_space(3))) bf16x8*)(kp+j*2048+512); }
__device__ __forceinline__ s16x4 vtr(lds_cptr p){ return __builtin_bit_cast(s16x4,__builtin_amdgcn_ds_read_tr16_b64_v4i16((__attribute__((address_space(3))) v4i16_t*)p)); }
__device__ __forceinline__ float rowmax(const f32x16&p0,const f32x16&p1){
  float a=max3f(p0[0],p0[1],p1[0]),b=max3f(p0[2],p0[3],p1[1]);a=max3f(a,p1[2],p1[3]);
  #pragma unroll
  for(int r=4;r<16;r+=4){a=max3f(a,p0[r],p0[r+1]);b=max3f(b,p0[r+2],p0[r+3]);a=max3f(a,p1[r],p1[r+1]);b=max3f(b,p1[r+2],p1[r+3]);}
  const float m=max2f(a,b);
  auto rr=__builtin_amdgcn_permlane32_swap(__float_as_uint(m),__float_as_uint(m),false,false);
  return max2f(__uint_as_float(rr[0]),__uint_as_float(rr[1]));
}
__device__ __forceinline__ void pv(f32x16*o,int vb,bf16x8 pa0,bf16x8 pa1,bf16x8 pa2,bf16x8 pa3){
  #pragma unroll
  for(int d0=0;d0<2;++d0){s16x4 lo[4],hi[4];
    #pragma unroll
    for(int ks=0;ks<4;++ks){
      asm volatile("ds_read_b64_tr_b16 %0,%1 offset:%c2":"=&v"(lo[ks]):"v"(vb),"i"(d0*4096+ks*1024):"memory");
      asm volatile("ds_read_b64_tr_b16 %0,%1 offset:%c2":"=&v"(hi[ks]):"v"(vb),"i"(d0*4096+ks*1024+512):"memory");}
    asm volatile("s_waitcnt lgkmcnt(0)":::"memory");SBAR();
    #define PK(k) (bf16x8){lo[k][0],lo[k][1],lo[k][2],lo[k][3],hi[k][0],hi[k][1],hi[k][2],hi[k][3]}
    o[d0]=__builtin_amdgcn_mfma_f32_32x32x16_bf16(pa0,PK(0),o[d0],0,0,0);
    o[d0]=__builtin_amdgcn_mfma_f32_32x32x16_bf16(pa1,PK(1),o[d0],0,0,0);
    o[d0]=__builtin_amdgcn_mfma_f32_32x32x16_bf16(pa2,PK(2),o[d0],0,0,0);
    o[d0]=__builtin_amdgcn_mfma_f32_32x32x16_bf16(pa3,PK(3),o[d0],0,0,0);
    #undef PK
  }
}

#ifndef ATTN_STORE16
#define ATTN_STORE16(p,v) (*(u32x4*)(p)=(v))
#endif
template<int THRL> __device__ __forceinline__ void attn_unit(int b,int h,int qb,const bf16*Q,const bf16*__restrict__ K,const bf16*__restrict__ V,bf16*O,const float*ksum,char*shm){
  int tid_l=threadIdx.x; asm volatile("":"+v"(tid_l)); const int tid=tid_l,lane=tid&63,r32=lane&31,hi=lane>>5; const int wid=__builtin_amdgcn_readfirstlane(tid>>6);
  const long rowbase=(long)b*SEQ; const int q0=qb*QB;
  const bf16*Qw=Q+(rowbase+q0+wid*QBLK)*DM+h*D;
  const bf16*Kh=K+rowbase*DM+h*D,*Vh=V+rowbase*DM+h*D;
  const unsigned lds0=(unsigned)(uintptr_t)shm;
  float*wsf=(float*)(shm+LDS_WS)+wid*64;
  const bf16*ksrc=Kh+(long)lane*DM+wid*8;
  const bf16*vsrc=Vh+(long)(16*(wid&3)+(lane>>2))*DM+(wid>>2)*32+(lane&3)*8;
  const unsigned kdst=lds0+LDS_K+wid*1024, vdst=lds0+LDS_V+wid*1024;
  #define DMA_K(t,slot) glds16(ksrc+(long)(t)*KVBLK*DM,(unsigned)__builtin_amdgcn_readfirstlane(kdst+(slot)))
  #define DMA_V(t,slot) glds16(vsrc+(long)(t)*KVBLK*DM,(unsigned)__builtin_amdgcn_readfirstlane(vdst+(slot)))
  const int vb0=(int)(lds0+LDS_V)+((lane>>4)&1)*32+(lane&3)*8+(4*hi+((lane&15)>>2))*64;
  const char*Kbase=shm+LDS_K; bf16x8 kf[8];
  const lds_cptr shm3=(lds_cptr)shm; const lds_cptr kp0=shm3+LDS_K+hi*1024+r32*16; const lds_cptr vp0=shm3+LDS_V+((lane>>4)&1)*32+(lane&3)*8+(4*hi+((lane&15)>>2))*64;
  const int NT=(q0+QB)/KVBLK;
  DMA_K(0,0);DMA_V(0,0);DMA_K(1,SLOTB);
  bf16x8 qr[4];
  #pragma unroll
  for(int d0=0;d0<4;++d0)qr[d0]=*reinterpret_cast<const bf16x8*>(&Qw[(long)r32*DM+d0*16+hi*8]);

  unsigned selmask=1u<<qb;
  if(qb>0){
    float gt[7];
    #pragma unroll
    for(int n=0;n<7;++n){ float s=-INFINITY;
      if(n<qb){ const float*km=ksum+((size_t)(b*8+n))*512+h*64; s=0.f;
        #pragma unroll
        for(int d0=0;d0<4;++d0){ const f32x4_t k0=*reinterpret_cast<const f32x4_t*>(km+d0*16+hi*8),k1=*reinterpret_cast<const f32x4_t*>(km+d0*16+hi*8+4);
          #pragma unroll
          for(int e=0;e<4;++e){ s+=__uint_as_float(((unsigned)(unsigned short)qr[d0][e])<<16)*k0[e]; s+=__uint_as_float(((unsigned)(unsigned short)qr[d0][4+e])<<16)*k1[e]; } }
        s+=__shfl_xor(s,32); }
      gt[n]=s; }
    #pragma unroll
    for(int n=0;n<7;++n){ int rank=0;
      #pragma unroll
      for(int m2=0;m2<7;++m2){ if(m2!=n) rank+=((gt[m2]>gt[n])||((gt[m2]==gt[n])&&(m2<n)))?1:0; }
      if(n<qb&&rank<3)selmask|=(1u<<n); }
  }
  #define MMASK(P0,P1,t) do{ if(!((selmask>>((t)>>2))&1u)){ _Pragma("unroll") for(int r=0;r<16;++r){P0[r]=-INFINITY;P1[r]=-INFINITY;} } }while(0)
  float mhat=0.f,l_reg=0.f;f32x16 o[2];o[0]=f32x16{};o[1]=f32x16{};f32x16 negm=f32x16{};asm volatile("":"+v"(negm));
  const int qrel=wid*QBLK+r32;
  #define CMASK(P0,P1,t) do{int jb_=(t)-(NT-4); if(jb_>=0)cmask(P0,P1,jb_,qrel,hi);}while(0)
  bool resc=false;
  #define START(P0,P1) do{ const float rm=rowmax(P0,P1); resc=false; \
    { const float dl=rm; mhat=fadd_s(mhat,dl); \
      _Pragma("unroll") for(int r=0;r<16;++r){P0[r]=fsub_s(P0[r],dl);P1[r]=fsub_s(P1[r],dl);} \
      _Pragma("unroll") for(int r=0;r<16;++r)negm[r]=-mhat; asm volatile("":"+v"(negm)); } \
    _Pragma("unroll") for(int r=0;r<16;++r)P0[r]=__builtin_amdgcn_exp2f(P0[r]); }while(0)
  #define RESC() do{ if(resc){ asm volatile("s_waitcnt lgkmcnt(0)":::"memory"); \
      _Pragma("unroll") for(int d_=0;d_<2;++d_) _Pragma("unroll") for(int r=0;r<16;++r)o[d_][r]*=wsf[crow(r,hi)]; } }while(0)
  f32x16 pA0,pA1,pB0,pB1;
  int sl_prev=0,sl_cur=0,sl_next=SLOTB;
  #define ROT() do{sl_prev=sl_cur;sl_cur=sl_next;sl_next=(sl_next==(NSLOT-1)*SLOTB)?0:sl_next+SLOTB;}while(0)
  DMA_K(2,2*SLOTB);
  WAIT_BAR(3);
  qkt(pA0,pA1,Kbase,qr,negm,r32,hi);asm volatile("s_nop 15\n\ts_nop 7":"+v"(pA0),"+v"(pA1));CMASK(pA0,pA1,0);
  START(pA0,pA1);
  _Pragma("unroll") for(int r=0;r<16;++r)pA1[r]=__builtin_amdgcn_exp2f(pA1[r]);
  if(!(selmask&1u)){ _Pragma("unroll") for(int r=0;r<16;++r){pA0[r]=0.f;pA1[r]=0.f;} }
  WAIT_BAR(0);
  DMA_K(3,0);DMA_V(1,SLOTB);
  ROT();
  kload8(kf,kp0+sl_cur);
  WAIT_BAR(2);
  s16x4 vlo[8],vhi[8]; u32x4 pw0,pw1,pw2,pw3;
  #define PKW(P,B) cvtpk_s(P[B],P[B+1])
  #define PAF(k) __builtin_bit_cast(bf16x8,pw##k)
  #define VFR(i) (bf16x8){vlo[i][0],vlo[i][1],vlo[i][2],vlo[i][3],vhi[i][0],vhi[i][1],vhi[i][2],vhi[i][3]}
  #define PIN(x) asm volatile("":"+v"(x))
  #define MX3(a,b,c) __builtin_fmaxf(__builtin_fmaxf((a),(b)),(c))
  #define GAPA(MF,A0,A1,A2,A3,W0,W1,PW) do{ MF; sacc+=A0; sacc+=A1; sacc+=A2; sacc+=A3; PIN(sacc); W0; W1; PIN(PW); SBAR(); }while(0)
  #define EX(v) __builtin_amdgcn_exp2f(v)
  #define GAPB(MF,X,B) do{ MF; X[B]=EX(X[B]); X[B+1]=EX(X[B+1]); X[B+2]=EX(X[B+2]); X[B+3]=EX(X[B+3]); PIN(X); SBAR(); }while(0)
  #define VRD(i) do{ vlo[i]=vtr(vp_+(((i)>>2)*4096+((i)&3)*1024)); vhi[i]=vtr(vp_+(((i)>>2)*4096+((i)&3)*1024+512)); }while(0)
  #define KRD(G,j) do{ if(G){ kload2(kf,kp0+sl_next,j); SBAR(); } }while(0)
  #define STEP(C0,C1,P0,P1,t,GK,GV,GL) do{ SBAR(); \
    const lds_cptr vp_=vp0+sl_prev; \
    VRD(0); SBAR(); float sacc=(P0[0]+P0[1]); \
    GAPA(C0=__builtin_amdgcn_mfma_f32_32x32x16_bf16(kf[0],qr[0],negm,0,0,0), P0[2],P0[3],P0[4],P0[5],     pw0[0]=PKW(P0,0), pw0[1]=PKW(P0,2), pw0); \
    VRD(4); SBAR(); GAPA(C1=__builtin_amdgcn_mfma_f32_32x32x16_bf16(kf[1],qr[0],negm,0,0,0), P0[6],P0[7],P0[8],P0[9],     pw0[2]=PKW(P0,4), pw0[3]=PKW(P0,6), pw0); \
    VRD(1); SBAR(); GAPA(C0=__builtin_amdgcn_mfma_f32_32x32x16_bf16(kf[2],qr[1],C0,0,0,0),   P0[10],P0[11],P0[12],P0[13], pw1[0]=PKW(P0,8), pw1[1]=PKW(P0,10), pw1); \
    VRD(5); SBAR(); GAPA(C1=__builtin_amdgcn_mfma_f32_32x32x16_bf16(kf[3],qr[1],C1,0,0,0),   P0[14],P0[15],P1[0],P1[1],   pw1[2]=PKW(P0,12),pw1[3]=PKW(P0,14), pw1); \
    VRD(2); SBAR(); GAPA(C0=__builtin_amdgcn_mfma_f32_32x32x16_bf16(kf[4],qr[2],C0,0,0,0),   P1[2],P1[3],P1[4],P1[5],     pw2[0]=PKW(P1,0), pw2[1]=PKW(P1,2), pw2); \
    VRD(6); SBAR(); GAPA(C1=__builtin_amdgcn_mfma_f32_32x32x16_bf16(kf[5],qr[2],C1,0,0,0),   P1[6],P1[7],P1[8],P1[9],     pw2[2]=PKW(P1,4), pw2[3]=PKW(P1,6), pw2); \
    VRD(3); SBAR(); GAPA(C0=__builtin_amdgcn_mfma_f32_32x32x16_bf16(kf[6],qr[3],C0,0,0,0),   P1[10],P1[11],P1[12],P1[13], pw3[0]=PKW(P1,8), pw3[1]=PKW(P1,10), pw3); \
    VRD(7); SBAR(); GAPA(C1=__builtin_amdgcn_mfma_f32_32x32x16_bf16(kf[7],qr[3],C1,0,0,0),   P1[14],P1[15],0.f,0.f,       pw3[2]=PKW(P1,12),pw3[3]=PKW(P1,14), pw3); \
    l_reg+=sacc; \
    if(GK){DMA_K((t)+3,sl_cur);} if(GV){DMA_V((t)+1,sl_next);} \
    CMASK(C0,C1,t); \
    { float a=MX3(C0[0],C0[1],C1[0]),b=MX3(C0[2],C0[3],C1[1]); a=MX3(a,C1[2],C1[3]); \
      _Pragma("unroll") for(int r=4;r<16;r+=4){a=MX3(a,C0[r],C0[r+1]);b=MX3(b,C0[r+2],C0[r+3]);a=MX3(a,C1[r],C1[r+1]);b=MX3(b,C1[r+2],C1[r+3]);} \
      float rm=__builtin_fmaxf(a,b); { auto rr=__builtin_amdgcn_permlane32_swap(__float_as_uint(rm),__float_as_uint(rm),false,false); rm=__builtin_fmaxf(__uint_as_float(rr[0]),__uint_as_float(rr[1])); } \
      resc=false; \
      if(__builtin_expect(__any(rm>(float)THRL),0)){ const float dl=__builtin_fmaxf(rm,0.f); mhat+=dl; \
        _Pragma("unroll") for(int r=0;r<16;++r){C0[r]-=dl;C1[r]-=dl;} \
        _Pragma("unroll") for(int r=0;r<16;++r)negm[r]=-mhat; asm volatile("":"+v"(negm)); \
        const float f=__builtin_amdgcn_exp2f(-dl); l_reg*=f; if(hi==0)wsf[r32]=f; resc=true; } } \
    MMASK(C0,C1,t); \
    SBAR(); \
    GAPB(o[0]=__builtin_amdgcn_mfma_f32_32x32x16_bf16(PAF(0),VFR(0),o[0],0,0,0), C0,0); \
    GAPB(o[1]=__builtin_amdgcn_mfma_f32_32x32x16_bf16(PAF(0),VFR(4),o[1],0,0,0), C0,4); \
    KRD(GL,0); GAPB(o[0]=__builtin_amdgcn_mfma_f32_32x32x16_bf16(PAF(1),VFR(1),o[0],0,0,0), C0,8); \
    KRD(GL,1); GAPB(o[1]=__builtin_amdgcn_mfma_f32_32x32x16_bf16(PAF(1),VFR(5),o[1],0,0,0), C0,12); \
    KRD(GL,2); GAPB(o[0]=__builtin_amdgcn_mfma_f32_32x32x16_bf16(PAF(2),VFR(2),o[0],0,0,0), C1,0); \
    KRD(GL,3); GAPB(o[1]=__builtin_amdgcn_mfma_f32_32x32x16_bf16(PAF(2),VFR(6),o[1],0,0,0), C1,4); \
    GAPB(o[0]=__builtin_amdgcn_mfma_f32_32x32x16_bf16(PAF(3),VFR(3),o[0],0,0,0), C1,8); \
    GAPB(o[1]=__builtin_amdgcn_mfma_f32_32x32x16_bf16(PAF(3),VFR(7),o[1],0,0,0), C1,12); \
    }while(0)
  int t=1;
  #undef CMASK
  #define CMASK(P0,P1,t) do{}while(0)
  for(;t+5<NT;t+=2){
    STEP(pB0,pB1,pA0,pA1,t,true,true,true);     WAIT_BAR(2); RESC(); ROT();
    STEP(pA0,pA1,pB0,pB1,t+1,true,true,true);   WAIT_BAR(2); RESC(); ROT();
  }
  #undef CMASK
  #define CMASK(P0,P1,t) do{int jb_=(t)-(NT-4); if(jb_>=0)cmask(P0,P1,jb_,qrel,hi);}while(0)
  #define ENDW(tt) do{ if((tt)+3<NT){WAIT_BAR(2);} else if((tt)+2<NT){WAIT_BAR(1);} else {WAIT_BAR(0);} }while(0)
  for(;t+1<NT;t+=2){
    STEP(pB0,pB1,pA0,pA1,t,(t+3<NT),(t+1<NT),(t+1<NT));       ENDW(t);   RESC(); ROT();
    STEP(pA0,pA1,pB0,pB1,t+1,(t+4<NT),(t+2<NT),(t+2<NT));     ENDW(t+1); RESC(); ROT();
  }
  STEP(pB0,pB1,pA0,pA1,NT-1,false,false,false); RESC();
  { float sacc=pB0[0]+pB0[1]; _Pragma("unroll") for(int r=2;r<16;++r)sacc+=pB0[r]; _Pragma("unroll") for(int r=0;r<16;++r)sacc+=pB1[r]; l_reg+=sacc;
    pw0=(u32x4){PKW(pB0,0),PKW(pB0,2),PKW(pB0,4),PKW(pB0,6)};pw1=(u32x4){PKW(pB0,8),PKW(pB0,10),PKW(pB0,12),PKW(pB0,14)};pw2=(u32x4){PKW(pB1,0),PKW(pB1,2),PKW(pB1,4),PKW(pB1,6)};pw3=(u32x4){PKW(pB1,8),PKW(pB1,10),PKW(pB1,12),PKW(pB1,14)};
    SBAR(); pv(o,vb0+sl_cur,PAF(0),PAF(1),PAF(2),PAF(3)); }
  #undef PKW
  #undef PAF
  #undef VFR
  #undef PIN
  #undef MX3
  #undef GAPA
  #undef GAPB
  #undef EX
  #undef VRD
  #undef KRD
  #undef STEP
  #undef ENDW
  {auto rr=__builtin_amdgcn_permlane32_swap(__float_as_uint(l_reg),__float_as_uint(l_reg),false,false);l_reg=__uint_as_float(rr[0])+__uint_as_float(rr[1]);}
  if(hi==0)wsf[32+r32]=l_reg;asm volatile("s_waitcnt lgkmcnt(0)":::"memory");
  float rli[16];
  #pragma unroll
  for(int r=0;r<16;++r)rli[r]=__builtin_amdgcn_rcpf(wsf[32+crow(r,hi)]);
  bf16*Ow=O+(rowbase+q0+wid*QBLK)*DM+h*D;
  { bf16*stg=(bf16*)(shm+LDS_OST)+wid*2048;
    #pragma unroll
    for(int r=0;r<16;++r){const int orow=crow(r,hi);
      #pragma unroll
      for(int d0=0;d0<2;++d0)stg[orow*64+d0*32+r32]=__float2bfloat16(o[d0][r]*rli[r]);}
    asm volatile("s_waitcnt lgkmcnt(0)":::"memory");
    #pragma unroll
    for(int i=0;i<4;++i){const int row=i*8+(lane>>3),ch=lane&7; const u32x4 v=*(const u32x4*)(stg+row*64+ch*8); ATTN_STORE16(Ow+(long)row*DM+ch*8,v);} }
  asm volatile("s_waitcnt lgkmcnt(0)\n\ts_barrier":::"memory");
  #undef MMASK
  #undef DMA_K
  #undef DMA_V
  #undef CMASK
  #undef START
  #undef RESC
  #undef ROT
}
constexpr int ATTN_LDS_BYTES=LDS_BYTES;
struct AttnTensors { const bf16* Q; const bf16* K; const bf16* V; bf16* O; };
struct AttnUnit { int bh; int qb; };
struct StaticOrder {
  int vcu;
  __device__ __forceinline__ explicit StaticOrder(int grid,int block):vcu((block%8)*(grid/8)+block/8){}
  __device__ __forceinline__ bool next(int i,AttnUnit&u)const{ if(i>=4)return false; const int s=vcu&7; u.bh=vcu>>3; u.qb=(i==0)?s:(i==1)?15-s:(i==2)?16+s:31-s; return true; }
  __device__ __forceinline__ void a_ready(const AttnUnit&)const{}
  __device__ __forceinline__ void done(const AttnUnit&)const{}
};
template<class Sched,int THRL=8> __device__ __forceinline__ void attn_phase(char*lds,const AttnTensors&T,const Sched&S){
  AttnUnit u;
  for(int i=0;S.next(i,u);++i){ S.a_ready(u); attn_unit<THRL>(u.bh/NHEAD,u.bh%NHEAD,u.qb,T.Q,T.K,T.V,T.O,lds); S.done(u); }
}
#undef SBAR
#undef WAIT_BAR
}
#define GAS __attribute__((address_space(1)))
#define LAS __attribute__((address_space(3)))
#define XB_TMO      128
#define XB_XCNT(j)  (256  + 64 * (j))
#define XB_XSUB(j)  (1280 + 64 * (j))
#define XB_XGEN(j)  (2304 + 64 * (j))
#define XB_TOP      3328
#define XB_TOPGEN   3392
#define XCD_BAR_WORDS 3456
#define XB_SPIN_CAP (1u << 18)

__device__ __forceinline__ unsigned xb_ld(unsigned* p)              { return __hip_atomic_load(p, __ATOMIC_RELAXED, __HIP_MEMORY_SCOPE_AGENT); }
__device__ __forceinline__ unsigned xb_add(unsigned* p, unsigned v) { return __hip_atomic_fetch_add(p, v, __ATOMIC_RELAXED, __HIP_MEMORY_SCOPE_AGENT); }
__device__ __forceinline__ unsigned xb_xcc_id() { return (unsigned)__builtin_amdgcn_s_getreg((3 << 11) | 20) & 0xFu; }
#define XB_SPIN(cond, bar) do { unsigned _sp = 0; while (cond) { __builtin_amdgcn_s_sleep(1); \
    if ((++_sp & 255u) == 0u) { if (xb_ld(&(bar)[XB_TMO])) break; if (_sp > XB_SPIN_CAP) { atomicAdd(&(bar)[XB_TMO], 1u); break; } } } } while (0)

struct XcdBarrier {
    unsigned* bar; unsigned x;
    volatile LAS unsigned* st;
};

__device__ __forceinline__ XcdBarrier xcd_barrier_post(unsigned* bar, volatile LAS unsigned* st) {
    XcdBarrier b; b.bar = bar; b.x = xb_xcc_id(); b.st = st;
    if (threadIdx.x == 0) (void)xb_add(&bar[XB_XCNT(b.x)], 1u);
    return b;
}
__device__ __forceinline__ void xcd_barrier_complete(unsigned* bar, unsigned x, unsigned& nloc, unsigned& nx) {
    const unsigned G = gridDim.x * gridDim.y * gridDim.z;
    unsigned sum, cnt, mine, sp = 0u;
    for (;;) {
        sum = 0u; cnt = 0u; mine = 0u;
#pragma unroll
        for (unsigned j = 0; j < 16; ++j) { const unsigned c = xb_ld(&bar[XB_XCNT(j)]); sum += c; cnt += (c > 0u) ? 1u : 0u; mine = (j == x) ? c : mine; }
        if (sum == G) break;
        __builtin_amdgcn_s_sleep(1);
        if ((++sp & 255u) == 0u) { if (xb_ld(&bar[XB_TMO])) break; if (sp > XB_SPIN_CAP) { atomicAdd(&bar[XB_TMO], 1u); break; } }
    }
    nloc = mine > 0u ? mine : 1u; nx = cnt > 0u ? cnt : 1u;
}

__device__ __forceinline__ void xcd_barrier(const XcdBarrier& b) {
    asm volatile("s_waitcnt vmcnt(0)" ::: "memory");
    __syncthreads();
    if (threadIdx.x == 0) {
        unsigned* bar = b.bar;
        __builtin_amdgcn_s_waitcnt(0);
        unsigned nloc = b.st[0], nx = b.st[1];
        if (nloc == 0u) { xcd_barrier_complete(bar, b.x, nloc, nx); b.st[0] = nloc; b.st[1] = nx; }
        const unsigned old = xb_add(&bar[XB_XSUB(b.x)], 1u);
        const unsigned gen = old / nloc;
        if (old + 1u == (gen + 1u) * nloc) {
            __builtin_amdgcn_fence(__ATOMIC_RELEASE, "agent");
            asm volatile("s_waitcnt vmcnt(0)" ::: "memory");
            const unsigned og = xb_add(&bar[XB_TOP], 1u);
            const unsigned tg = og / nx;
            if (og + 1u == (tg + 1u) * nx) xb_add(&bar[XB_TOPGEN], 1u);
            else XB_SPIN(xb_ld(&bar[XB_TOPGEN]) == tg, bar);
            __builtin_amdgcn_fence(__ATOMIC_ACQUIRE, "agent");
            xb_add(&bar[XB_XGEN(b.x)], 1u);
            asm volatile("s_waitcnt vmcnt(0)" ::: "memory");
        } else {
            XB_SPIN(xb_ld(&bar[XB_XGEN(b.x)]) == gen, bar);
            __builtin_amdgcn_fence(__ATOMIC_ACQUIRE, "agent");
            asm volatile("s_waitcnt vmcnt(0)" ::: "memory");
        }
    }
    __syncthreads();
}
typedef unsigned short bf16;
typedef unsigned v4u __attribute__((ext_vector_type(4)));
typedef unsigned v2u __attribute__((ext_vector_type(2)));
typedef float f32x4 __attribute__((ext_vector_type(4)));
typedef float f32x2 __attribute__((ext_vector_type(2)));
typedef float f32x16 __attribute__((ext_vector_type(16)));
typedef short bf16x8 __attribute__((ext_vector_type(8)));
constexpr int NB = 8, SEQ = 2048, DM = 1024, M = NB * SEQ, DFF = 4096;
constexpr int NIN = 7424;
constexpr int NMIX = 4352;
constexpr float EPS = 1e-6f;
constexpr size_t MiB = 1u << 20;
constexpr size_t WS_CTL = 0, WS_ROPEC = 1 * MiB, WS_ROPES = 3 * MiB, WS_KMEAN = 5 * MiB;
constexpr size_t WS_WIN = 6 * MiB, WS_WBO = WS_WIN + (size_t)NIN * DM * 2, WS_WMIX = WS_WBO + 3 * MiB, WS_WUP = WS_WMIX + 2 * MiB, WS_WDN = WS_WUP + 8 * MiB;
static_assert(WS_WDN + 8 * MiB <= 42 * MiB, "weights");
constexpr size_t WS_XN = 42 * MiB;
constexpr size_t WS_Q = 74 * MiB, WS_LR = 90 * MiB, WS_CONV = 106 * MiB, WS_K = 122 * MiB, WS_V = 138 * MiB, WS_LQ = 154 * MiB, WS_LK = 162 * MiB, WS_LV = 170 * MiB,
                 WS_CA = 186 * MiB, WS_CG = 202 * MiB, WS_G = 218 * MiB;
constexpr size_t WS_YB = 122 * MiB, WS_MB = 74 * MiB, WS_Y = 106 * MiB, WS_H = 74 * MiB, WS_Y2 = 202 * MiB, WS_END = 256 * MiB;
constexpr size_t WS_SLOC = 234 * MiB, WS_DTOT = 242 * MiB;
constexpr int LDS_RING = 131072, LDS_BYTES = LDS_RING + 1024;

__device__ __forceinline__ unsigned f2bf(float f) { unsigned u = __builtin_bit_cast(unsigned, f); return (u + 0x7fffu + ((u >> 16) & 1u)) >> 16; }
__device__ __forceinline__ unsigned pk2(float lo, float hi) { return pg8::cvt_pk_bf16(lo, hi); }
__device__ __forceinline__ float bflo(unsigned w) { return __uint_as_float(w << 16); }
__device__ __forceinline__ float bfhi(unsigned w) { return __uint_as_float(w & 0xffff0000u); }
__device__ __forceinline__ float bf1(unsigned short h) { return __uint_as_float(((unsigned)h) << 16); }
__device__ __forceinline__ float sigmf(float x) { return 1.0f / (1.0f + __expf(-x)); }
__device__ __forceinline__ float wave_sum(float v) {
#pragma unroll
    for (int o = 1; o < 64; o <<= 1) v += __shfl_xor(v, o);
    return v;
}
__constant__ float c_inv_freq[32] = {1.0f, 0.7498942613601685f, 0.5623413324356079f, 0.4216965138912201f, 0.3162277638912201f, 0.23713737726211548f, 0.17782793939113617f, 0.133352130651474f, 0.10000000149011612f, 0.07498941570520401f, 0.05623413249850273f, 0.04216965287923813f, 0.03162277489900589f, 0.023713737726211548f, 0.017782794311642647f, 0.01333521492779255f, 0.009999999776482582f, 0.007498941849917173f, 0.005623413249850273f, 0.0042169648222625256f, 0.003162277629598975f, 0.00237137358635664f, 0.0017782794311642647f, 0.0013335214462131262f, 0.0010000000474974513f, 0.0007498942431993783f, 0.000562341301701963f, 0.0004216965171508491f, 0.0003162277571391314f, 0.00023713737027719617f, 0.00017782794020604342f, 0.0001333521504420787f};

__device__ __forceinline__ int src_inproj(int n) {
    if (n < 1024) { const int sec = n >> 9, w = n & 511, hd = w >> 6, j = w & 63; return sec * 512 + hd * 64 + (j >> 1) + 32 * (j & 1); }
    if (n < 2560) return n;
    if (n < 2816) return -(n - 2560) - 1;
    return n - 240;
}
template <bool INPROJ> __device__ __forceinline__ void wt_item(const float* W, int K, int ldw, int nblk, bf16* WT, const float* A2, LAS float* scr, int item, int lane) {
    const int kb = item / nblk, nb = item % nblk, k0 = 64 * kb, n0 = 32 * nb;
    const int nd = n0 + (lane & 31); const int src = INPROJ ? src_inproj(nd) : nd;
    if (INPROJ && src < 0) {
        const int nn = -(src + 1);
        float a2[16];
#pragma unroll
        for (int r = 0; r < 16; ++r) a2[r] = A2[r * 256 + nn];
#pragma unroll 2
        for (int i = 0; i < 32; ++i) { const int kk = 2 * i + (lane >> 5); const float* wr = W + (size_t)(k0 + kk) * ldw + 2560; float s = 0.f;
#pragma unroll
            for (int r = 0; r < 16; r += 4) { const f32x4 w4 = *(const f32x4*)(wr + r); s += w4[0] * a2[r] + w4[1] * a2[r + 1] + w4[2] * a2[r + 2] + w4[3] * a2[r + 3]; }
            scr[kk * 33 + (lane & 31)] = s; }
    } else {
#pragma unroll 8
        for (int i = 0; i < 32; ++i) { const int kk = 2 * i + (lane >> 5); scr[kk * 33 + (lane & 31)] = W[(size_t)(k0 + kk) * ldw + src]; }
    }
    asm volatile("s_waitcnt lgkmcnt(0)" ::: "memory");
    const int c = lane & 7;
#pragma unroll
    for (int j = 0; j < 4; ++j) { const int n = (lane >> 3) + 8 * j; const LAS float* s = scr + (8 * c) * 33 + n;
        v4u o; o.x = pk2(s[0 * 33], s[1 * 33]); o.y = pk2(s[2 * 33], s[3 * 33]); o.z = pk2(s[4 * 33], s[5 * 33]); o.w = pk2(s[6 * 33], s[7 * 33]);
        *(v4u*)(WT + (size_t)(n0 + n) * K + k0 + 8 * c) = o; }
    asm volatile("s_waitcnt lgkmcnt(0)" ::: "memory");
}
struct LayerW { const float *w_in, *a2, *w_mo, *w_go, *w_co, *w_mix, *w_up, *w_dn; };
__device__ __forceinline__ void convert_weights(const LayerW& L, unsigned char* ws, LAS unsigned char* lds, int gw, int NGW, int wave, int lane) {
    LAS float* scr = (LAS float*)(lds + wave * 16384);
    bf16* Win = (bf16*)(ws + WS_WIN); bf16* Wbo = (bf16*)(ws + WS_WBO); bf16* Wmix = (bf16*)(ws + WS_WMIX); bf16* Wup = (bf16*)(ws + WS_WUP); bf16* Wdn = (bf16*)(ws + WS_WDN);
    constexpr int I_IN = (DM / 64) * (NIN / 32), I_BO = (512 / 64) * (DM / 32), I_MIX = (DM / 64) * (DM / 32), I_UP = (DM / 64) * (DFF / 32), I_DN = (DFF / 64) * (DM / 32);
    constexpr int NITEMS = I_IN + 3 * I_BO + I_MIX + I_UP + I_DN;
    for (int it = gw; it < NITEMS; it += NGW) {
        int r = it;
        if (r < I_IN) { wt_item<true>(L.w_in, DM, 7184, NIN / 32, Win, L.a2, scr, r, lane); continue; } r -= I_IN;
        if (r < I_BO) { wt_item<false>(L.w_mo, 512, DM, DM / 32, Wbo, nullptr, scr, r, lane); continue; } r -= I_BO;
        if (r < I_BO) { wt_item<false>(L.w_go, 512, DM, DM / 32, Wbo + 512 * 1024, nullptr, scr, r, lane); continue; } r -= I_BO;
        if (r < I_BO) { wt_item<false>(L.w_co, 512, DM, DM / 32, Wbo + 2 * 512 * 1024, nullptr, scr, r, lane); continue; } r -= I_BO;
        if (r < I_MIX) { wt_item<false>(L.w_mix, DM, DM, DM / 32, Wmix, nullptr, scr, r, lane); continue; } r -= I_MIX;
        if (r < I_UP) { wt_item<false>(L.w_up, DM, DFF, DFF / 32, Wup, nullptr, scr, r, lane); continue; } r -= I_UP;
        wt_item<false>(L.w_dn, DFF, DM, DM / 32, Wdn, nullptr, scr, r, lane);
    }
}
__device__ __forceinline__ void row_phase(const float* hin, const bf16* Y, const float* gY, float* hout, const float* gN, bf16* XN, int gw, int NGW, int lane) {
    for (int m = gw; m < M; m += NGW) {
        const f32x4* xr = (const f32x4*)(hin + (size_t)m * DM) + lane;
        f32x4 v[4];
#pragma unroll
        for (int j = 0; j < 4; ++j) v[j] = xr[64 * j];
        if (Y) {
            const v2u* yr = (const v2u*)(Y + (size_t)m * DM) + lane; f32x4 y[4]; float s = 0.f;
#pragma unroll
            for (int j = 0; j < 4; ++j) { const v2u w = yr[64 * j]; y[j] = (f32x4){bflo(w.x), bfhi(w.x), bflo(w.y), bfhi(w.y)}; s += (y[j].x * y[j].x + y[j].y * y[j].y) + (y[j].z * y[j].z + y[j].w * y[j].w); }
            const float rstd = rsqrtf(wave_sum(s) * (1.f / DM) + EPS);
            f32x4* ho = (f32x4*)(hout + (size_t)m * DM) + lane;
#pragma unroll
            for (int j = 0; j < 4; ++j) { const f32x4 g = ((const f32x4*)gY)[lane + 64 * j]; v[j] = v[j] + y[j] * rstd * g; ho[64 * j] = v[j]; }
        }
        if (XN) {
            float s = 0.f;
#pragma unroll
            for (int j = 0; j < 4; ++j) s += (v[j].x * v[j].x + v[j].y * v[j].y) + (v[j].z * v[j].z + v[j].w * v[j].w);
            const float rstd = rsqrtf(wave_sum(s) * (1.f / DM) + EPS);
            v2u* o8 = (v2u*)(XN + (size_t)m * DM) + lane;
#pragma unroll
            for (int j = 0; j < 4; ++j) { const f32x4 g = ((const f32x4*)gN)[lane + 64 * j]; const f32x4 t = v[j] * rstd * g; v2u w; w.x = pk2(t.x, t.y); w.y = pk2(t.z, t.w); o8[64 * j] = w; }
        }
    }
}
constexpr int GL_QS = 0, GL_KS = 9216, GL_KT = 18432, GL_VT = 27648, GL_AS = 46080, GL_ST = 55296, GL_OS = 92160, GL_TOT = 125952, GL_DEC = 128000;
__device__ __forceinline__ int crow16(int r, int hi) { return (r & 3) + 8 * (r >> 2) + 4 * hi; }
template <int PASS> __device__ __forceinline__ void gla_unit(int bh, int grp, const bf16* lq, const bf16* lk, const bf16* lv, const float* gdec, bf16* lr, const float* gnorm, float* Sloc, float* Dtot, LAS unsigned char* lds) {
    int tid_l = threadIdx.x; asm volatile("" : "+v"(tid_l));
    const int tid = tid_l, lane = tid & 63, l31 = lane & 31, hi = lane >> 5; const int w = __builtin_amdgcn_readfirstlane(tid >> 6);
    const int b = bh >> 2, hh = bh & 3; const size_t rowbase = (size_t)b * SEQ + (size_t)grp * 256;
    LAS bf16* Qs = (LAS bf16*)(lds + GL_QS); LAS bf16* Ks = (LAS bf16*)(lds + GL_KS); LAS bf16* KT = (LAS bf16*)(lds + GL_KT); LAS bf16* VT = (LAS bf16*)(lds + GL_VT);
    LAS bf16* As = (LAS bf16*)(lds + GL_AS); LAS bf16* ST = (LAS bf16*)(lds + GL_ST); LAS float* Os = (LAS float*)(lds + GL_OS); LAS float* tot = (LAS float*)(lds + GL_TOT); LAS float* dec = (LAS float*)(lds + GL_DEC);
    const int dt = w >> 2, vt = w & 3;
    f32x16 sacc;
#pragma unroll
    for (int r = 0; r < 16; ++r) sacc[r] = 0.f;
    float gl_n[8]; unsigned short qv_n[8], kv_n[8], vv0_n[8], vv1_n[8];
#define GLA_LOAD(ci) do { const size_t r0_ = rowbase + (size_t)(ci) * 64 + 8 * w; _Pragma("unroll") for (int t = 0; t < 8; ++t) { const size_t row = r0_ + t; gl_n[t] = gdec[row * 256 + hh * 64 + lane]; \
        if (PASS == 3) qv_n[t] = lq[row * 256 + hh * 64 + lane]; kv_n[t] = lk[row * 256 + hh * 64 + lane]; vv0_n[t] = lv[row * 512 + hh * 128 + lane]; vv1_n[t] = lv[row * 512 + hh * 128 + 64 + lane]; } } while (0)
    GLA_LOAD(0);
    if (PASS == 3) {
        for (int g2 = 0; g2 < grp; ++g2) { const float* sl = Sloc + ((size_t)(bh * 8 + g2) * 8 + w) * 1024 + lane; const float* dp = Dtot + (size_t)(bh * 8 + g2) * 64 + 32 * dt + 4 * hi;
#pragma unroll
            for (int g = 0; g < 4; ++g) { const f32x4 dv = *(const f32x4*)(dp + 8 * g);
#pragma unroll
                for (int e2 = 0; e2 < 4; ++e2) sacc[4 * g + e2] = sacc[4 * g + e2] * dv[e2] + sl[(4 * g + e2) * 64]; } }
#pragma unroll
        for (int g = 0; g < 4; ++g) { const int d0 = 32 * dt + 8 * g + 4 * hi;
            *(LAS v2u*)(ST + (32 * vt + l31) * 72 + d0) = (v2u){pk2(sacc[4 * g], sacc[4 * g + 1]), pk2(sacc[4 * g + 2], sacc[4 * g + 3])}; }
    }
    float gsum = 0.f;
#pragma unroll 1
    for (int c = 0; c < 4; ++c) {
        float gl[8]; unsigned short qv[8], kv[8], vv0[8], vv1[8];
#pragma unroll
        for (int t = 0; t < 8; ++t) { gl[t] = gl_n[t]; qv[t] = qv_n[t]; kv[t] = kv_n[t]; vv0[t] = vv0_n[t]; vv1[t] = vv1_n[t]; }
        v4u ra, rb; bf16* rp = lr + (rowbase + (size_t)c * 64 + (tid >> 3)) * 512 + hh * 128 + (tid & 7) * 16;
        if (PASS == 3) { ra = *(const v4u*)rp; rb = *(const v4u*)(rp + 8); }
#pragma unroll
        for (int t = 1; t < 8; ++t) gl[t] += gl[t - 1];
        tot[w * 64 + lane] = gl[7];
        __syncthreads();
        if (c < 3) GLA_LOAD(c + 1);
        float off = 0.f, glast = 0.f;
#pragma unroll
        for (int j = 0; j < 8; ++j) { const float tj = tot[j * 64 + lane]; glast += tj; if (j < w) off += tj; }
        gsum += glast;
        unsigned kt[4];
#pragma unroll
        for (int t = 0; t < 8; t += 2) {
            const float G0 = off + gl[t], G1 = off + gl[t + 1];
            const float k0 = bf1(kv[t]) * __expf(-G0), k1 = bf1(kv[t + 1]) * __expf(-G1);
            const unsigned kp = pk2(k0, k1);
            if (PASS == 3) { const float q0 = bf1(qv[t]) * __expf(G0), q1 = bf1(qv[t + 1]) * __expf(G1); const unsigned qp = pk2(q0, q1);
                Qs[(8 * w + t) * 72 + lane] = (bf16)(qp & 0xffffu); Qs[(8 * w + t + 1) * 72 + lane] = (bf16)(qp >> 16);
                Ks[(8 * w + t) * 72 + lane] = (bf16)(kp & 0xffffu); Ks[(8 * w + t + 1) * 72 + lane] = (bf16)(kp >> 16); }
            kt[t >> 1] = kp; }
        *(LAS v4u*)(KT + lane * 72 + 8 * w) = (v4u){kt[0], kt[1], kt[2], kt[3]};
        *(LAS v4u*)(VT + lane * 72 + 8 * w) = (v4u){(unsigned)vv0[0] | ((unsigned)vv0[1] << 16), (unsigned)vv0[2] | ((unsigned)vv0[3] << 16), (unsigned)vv0[4] | ((unsigned)vv0[5] << 16), (unsigned)vv0[6] | ((unsigned)vv0[7] << 16)};
        *(LAS v4u*)(VT + (64 + lane) * 72 + 8 * w) = (v4u){(unsigned)vv1[0] | ((unsigned)vv1[1] << 16), (unsigned)vv1[2] | ((unsigned)vv1[3] << 16), (unsigned)vv1[4] | ((unsigned)vv1[5] << 16), (unsigned)vv1[6] | ((unsigned)vv1[7] << 16)};
        if (w == 0) dec[lane] = __expf(glast);
        __syncthreads();
        {
#pragma unroll
            for (int kk = 0; kk < 4; ++kk) { const bf16x8 a = *(const LAS bf16x8*)(KT + (32 * dt + l31) * 72 + kk * 16 + hi * 8), bb = *(const LAS bf16x8*)(VT + (32 * vt + l31) * 72 + kk * 16 + hi * 8);
                sacc = __builtin_amdgcn_mfma_f32_32x32x16_bf16(a, bb, sacc, 0, 0, 0); }
            LAS bf16* Sn = ST + ((c + 1) & 1) * (128 * 72);
#pragma unroll
            for (int g = 0; g < 4; ++g) { const int d0 = 32 * dt + 8 * g + 4 * hi; const f32x4 dv = *(const LAS f32x4*)(dec + d0);
                sacc[4 * g] *= dv[0]; sacc[4 * g + 1] *= dv[1]; sacc[4 * g + 2] *= dv[2]; sacc[4 * g + 3] *= dv[3];
                if (PASS == 3) *(LAS v2u*)(Sn + (32 * vt + l31) * 72 + d0) = (v2u){pk2(sacc[4 * g], sacc[4 * g + 1]), pk2(sacc[4 * g + 2], sacc[4 * g + 3])}; }
        }
        if (PASS == 3) {
        if (w < 3) {
            const int it = (w == 0) ? 0 : 1, jt = (w == 2) ? 1 : 0;
            f32x16 a16;
#pragma unroll
            for (int r = 0; r < 16; ++r) a16[r] = 0.f;
#pragma unroll
            for (int kk = 0; kk < 4; ++kk) { const bf16x8 a = *(const LAS bf16x8*)(Ks + (32 * jt + l31) * 72 + kk * 16 + hi * 8), bb = *(const LAS bf16x8*)(Qs + (32 * it + l31) * 72 + kk * 16 + hi * 8);
                a16 = __builtin_amdgcn_mfma_f32_32x32x16_bf16(a, bb, a16, 0, 0, 0); }
            const int i = 32 * it + l31;
#pragma unroll
            for (int g = 0; g < 4; ++g) { const int j0 = 32 * jt + 8 * g + 4 * hi;
                const float x0 = (j0 <= i) ? a16[4 * g] : 0.f, x1 = (j0 + 1 <= i) ? a16[4 * g + 1] : 0.f, x2 = (j0 + 2 <= i) ? a16[4 * g + 2] : 0.f, x3 = (j0 + 3 <= i) ? a16[4 * g + 3] : 0.f;
                *(LAS v2u*)(As + i * 72 + j0) = (v2u){pk2(x0, x1), pk2(x2, x3)}; }
        }
        __syncthreads();
        {
            f32x16 o16;
#pragma unroll
            for (int r = 0; r < 16; ++r) o16[r] = 0.f;
            const LAS bf16* Sc = ST + (c & 1) * (128 * 72);
#pragma unroll
            for (int kk = 0; kk < 4; ++kk) { const bf16x8 a = *(const LAS bf16x8*)(Qs + (32 * dt + l31) * 72 + kk * 16 + hi * 8), bb = *(const LAS bf16x8*)(Sc + (32 * vt + l31) * 72 + kk * 16 + hi * 8);
                o16 = __builtin_amdgcn_mfma_f32_32x32x16_bf16(a, bb, o16, 0, 0, 0); }
#pragma unroll
            for (int kk = 0; kk < 4; ++kk) if (kk < 2 || dt == 1) { const bf16x8 a = *(const LAS bf16x8*)(As + (32 * dt + l31) * 72 + kk * 16 + hi * 8), bb = *(const LAS bf16x8*)(VT + (32 * vt + l31) * 72 + kk * 16 + hi * 8);
                o16 = __builtin_amdgcn_mfma_f32_32x32x16_bf16(a, bb, o16, 0, 0, 0); }
#pragma unroll
            for (int r = 0; r < 16; ++r) Os[(32 * dt + crow16(r, hi)) * 132 + 32 * vt + l31] = o16[r];
        }
        __syncthreads();
        {
            const int i = tid >> 3, v0 = (tid & 7) * 16;
            f32x4 o[4]; float ss = 0.f;
#pragma unroll
            for (int j = 0; j < 4; ++j) { o[j] = *(const LAS f32x4*)(Os + i * 132 + v0 + 4 * j); ss += (o[j].x * o[j].x + o[j].y * o[j].y) + (o[j].z * o[j].z + o[j].w * o[j].w); }
            ss += __shfl_xor(ss, 1); ss += __shfl_xor(ss, 2); ss += __shfl_xor(ss, 4);
            const float rstd = rsqrtf(ss * (1.f / 128.f) + EPS);
            const float rr[16] = {bflo(ra.x), bfhi(ra.x), bflo(ra.y), bfhi(ra.y), bflo(ra.z), bfhi(ra.z), bflo(ra.w), bfhi(ra.w), bflo(rb.x), bfhi(rb.x), bflo(rb.y), bfhi(rb.y), bflo(rb.z), bfhi(rb.z), bflo(rb.w), bfhi(rb.w)};
            float out[16];
#pragma unroll
            for (int j = 0; j < 4; ++j) { const f32x4 gn = *(const f32x4*)(gnorm + v0 + 4 * j);
#pragma unroll
                for (int e2 = 0; e2 < 4; ++e2) { const float r = rr[4 * j + e2]; out[4 * j + e2] = o[j][e2] * rstd * gn[e2] * (r * sigmf(r)); } }
            *(v4u*)rp = (v4u){pk2(out[0], out[1]), pk2(out[2], out[3]), pk2(out[4], out[5]), pk2(out[6], out[7])};
            *(v4u*)(rp + 8) = (v4u){pk2(out[8], out[9]), pk2(out[10], out[11]), pk2(out[12], out[13]), pk2(out[14], out[15])};
        }
        }
    }
#undef GLA_LOAD
    if (PASS == 1) {
        float* sl = Sloc + ((size_t)(bh * 8 + grp) * 8 + w) * 1024 + lane;
#pragma unroll
        for (int r = 0; r < 16; ++r) sl[r * 64] = sacc[r];
        if (w == 0) Dtot[(size_t)(bh * 8 + grp) * 64 + lane] = __expf(gsum);
    }
    __syncthreads();
}
__device__ __forceinline__ void conv_unit(int cu, const bf16* ca, const bf16* cg, bf16* outp, const float* wdw, const float* bdw, const float* gln, const float* bln, LAS unsigned char* lds) {
    int tid_l = threadIdx.x; asm volatile("" : "+v"(tid_l));
    const int tid = tid_l, lane = tid & 63; const int w = __builtin_amdgcn_readfirstlane(tid >> 6);
    const size_t row0 = (size_t)cu * 32; const int s0 = (int)(row0 % SEQ);
    LAS unsigned* us = (LAS unsigned*)lds;
    LAS float* ys = (LAS float*)(lds + 62 * 1024);
    for (int idx = tid; idx < 62 * 64; idx += 512) { const int r = idx >> 6, ch = idx & 63; const int s = s0 - 30 + r;
        v4u o = (v4u){0u, 0u, 0u, 0u};
        if (s >= 0) { const size_t off = (row0 + r - 30) * 512 + ch * 8; const v4u a = *(const v4u*)(ca + off), g = *(const v4u*)(cg + off);
            o.x = pk2(bflo(a.x) * sigmf(bflo(g.x)), bfhi(a.x) * sigmf(bfhi(g.x))); o.y = pk2(bflo(a.y) * sigmf(bflo(g.y)), bfhi(a.y) * sigmf(bfhi(g.y)));
            o.z = pk2(bflo(a.z) * sigmf(bflo(g.z)), bfhi(a.z) * sigmf(bfhi(g.z))); o.w = pk2(bflo(a.w) * sigmf(bflo(g.w)), bfhi(a.w) * sigmf(bfhi(g.w))); }
        *(LAS v4u*)(us + r * 256 + ch * 4) = o; }
    const int cp = tid & 255, th = tid >> 8;
    float w0[31], w1[31];
#pragma unroll
    for (int k = 0; k < 31; ++k) { const f32x2 ww = *(const f32x2*)(wdw + k * 512 + 2 * cp); w0[k] = ww.x; w1[k] = ww.y; }
    const f32x2 bb = *(const f32x2*)(bdw + 2 * cp);
    __syncthreads();
#pragma unroll 1
    for (int tq = 0; tq < 4; ++tq) {
        const int t0 = th * 16 + tq * 4;
        unsigned uw[34];
#pragma unroll
        for (int r = 0; r < 34; ++r) uw[r] = us[(t0 + r) * 256 + cp];
#pragma unroll
        for (int tt = 0; tt < 4; ++tt) { float y0 = bb.x, y1 = bb.y;
#pragma unroll
            for (int k = 0; k < 31; ++k) { y0 += w0[k] * bflo(uw[tt + k]); y1 += w1[k] * bfhi(uw[tt + k]); }
            *(LAS f32x2*)(ys + (t0 + tt) * 512 + 2 * cp) = (f32x2){y0, y1}; }
    }
    __syncthreads();
#pragma unroll 1
    for (int tt = 0; tt < 4; ++tt) { const int t = 4 * w + tt;
        const f32x4 a = *(const LAS f32x4*)(ys + t * 512 + lane * 8), b = *(const LAS f32x4*)(ys + t * 512 + lane * 8 + 4);
        const float mean = wave_sum((a.x + a.y) + (a.z + a.w) + (b.x + b.y) + (b.z + b.w)) * (1.f / 512.f);
        const f32x4 da = a - mean, db = b - mean;
        const float var = wave_sum((da.x * da.x + da.y * da.y) + (da.z * da.z + da.w * da.w) + (db.x * db.x + db.y * db.y) + (db.z * db.z + db.w * db.w)) * (1.f / 512.f);
        const float rstd = rsqrtf(var + EPS);
        const f32x4 g0 = *(const f32x4*)(gln + lane * 8), g1 = *(const f32x4*)(gln + lane * 8 + 4), b0 = *(const f32x4*)(bln + lane * 8), b1 = *(const f32x4*)(bln + lane * 8 + 4);
        f32x4 y0 = da * rstd * g0 + b0, y1 = db * rstd * g1 + b1;
#pragma unroll
        for (int e = 0; e < 4; ++e) { y0[e] = y0[e] * sigmf(y0[e]); y1[e] = y1[e] * sigmf(y1[e]); }
        *(v4u*)(outp + (row0 + t) * 512 + lane * 8) = (v4u){pk2(y0.x, y0.y), pk2(y0.z, y0.w), pk2(y1.x, y1.y), pk2(y1.z, y1.w)}; }
    __syncthreads();
}

struct Params { const float* in[21]; float* out; unsigned char* ws; };
template <int l> __device__ __forceinline__ void layer_body(const Params& p, LAS unsigned char* lds, unsigned char* lds_raw, const XcdBarrier& xbar) {
    int tid_l = threadIdx.x; asm volatile("" : "+v"(tid_l));
    const int tid = tid_l, lane = tid & 63, wave = __builtin_amdgcn_readfirstlane(tid >> 6);
    const int G = gridDim.x, bx = blockIdx.x;
    const int vcu = (G % 8 == 0) ? (bx % 8) * (G / 8) + bx / 8 : bx;
    const int gw = vcu * 8 + wave, NGW = G * 8;
    unsigned char* ws = p.ws;
    unsigned* ctl = (unsigned*)(ws + WS_CTL);
    float* ropec = (float*)(ws + WS_ROPEC); float* ropes = (float*)(ws + WS_ROPES); float* kmean = (float*)(ws + WS_KMEAN);
    bf16* XN = (bf16*)(ws + WS_XN);
    const float* x = p.in[0];
    float* hbuf = p.out;
    {
        const float* hin = (l == 0) ? x : hbuf;
        {
            pg8::Gemm g{(const pg8::bf16_t*)XN, (const pg8::bf16_t*)(ws + WS_WIN), M, NMIX, DM}; pg8::StaticOrder S; S.init(M, NMIX + 0, G, bx);
            pg8::EpiInproj E{(bf16*)(ws + WS_Q), (bf16*)(ws + WS_K), (bf16*)(ws + WS_V), (bf16*)(ws + WS_LQ), (bf16*)(ws + WS_LK), (bf16*)(ws + WS_LV), (bf16*)(ws + WS_LR), (bf16*)(ws + WS_CA), (bf16*)(ws + WS_CG),
                             (float*)(ws + WS_G), kmean, ropec, ropes, p.in[6] + l * 256, 0.125f * 1.4426950408889634f};
#ifndef NO_G1
            pg8::gemm_phase<pg8::EpiInproj, pg8::StaticOrder, true, true>(lds, g, S, E);
#endif
        }
        xcd_barrier(xbar);
        {
            LAS unsigned* slot = (LAS unsigned*)(lds + LDS_RING);
            for (;;) {
                __syncthreads();
                if (tid == 0) *slot = atomicAdd(ctl + 64 * l, 1u);
                __syncthreads();
                const int u = (int)*slot;
                if (u >= 512 + 224 + 512) break;
#ifndef NO_GLA
                if (u >= 512 && u < 736) { const int a = u - 512; gla_unit<1>(a / 7, a % 7, (const bf16*)(ws + WS_LQ), (const bf16*)(ws + WS_LK), (const bf16*)(ws + WS_LV), (const float*)(ws + WS_G), (bf16*)(ws + WS_LR), p.in[7] + l * 128, (float*)(ws + WS_SLOC), (float*)(ws + WS_DTOT), lds); }
#endif
#ifndef NO_ATTN
                if (u < 512) { const int a = u, qb = 7 - (a >> 6), bh = a & 63;
                    attn_body::attn_unit<8>(bh >> 3, bh & 7, qb, (const attn_body::bf16*)(ws + WS_Q), (const attn_body::bf16*)(ws + WS_K), (const attn_body::bf16*)(ws + WS_V), (attn_body::bf16*)(ws + WS_Q), kmean, (char*)lds_raw); }
#endif
#ifndef NO_CONV
                if (u >= 736) conv_unit(u - 736, (const bf16*)(ws + WS_CA), (const bf16*)(ws + WS_CG), (bf16*)(ws + WS_CONV), p.in[8] + l * 31 * 512, p.in[9] + l * 512, p.in[10] + l * 512, p.in[11] + l * 512, lds);
#endif
            }
        }
        xcd_barrier(xbar);
#ifndef NO_GLA
        for (int u = bx; u < 256; u += G) gla_unit<3>(u >> 3, u & 7, (const bf16*)(ws + WS_LQ), (const bf16*)(ws + WS_LK), (const bf16*)(ws + WS_LV), (const float*)(ws + WS_G), (bf16*)(ws + WS_LR), p.in[7] + l * 128, (float*)(ws + WS_SLOC), (float*)(ws + WS_DTOT), lds);
#endif
        xcd_barrier(xbar);
        {
            pg8::Gemm g{(const pg8::bf16_t*)(ws + WS_Q), (const pg8::bf16_t*)(ws + WS_WBO), 3 * M, 3 * DM, 512}; pg8::SchedBranch S{G, bx};
            pg8::EpiStore<0> E{(bf16*)(ws + WS_YB), DM, 4, (size_t)M * DM};
#ifndef NO_G2
            pg8::gemm_phase<pg8::EpiStore<0>, pg8::SchedBranch, true, true>(lds, g, S, E);
#endif
        }
        xcd_barrier(xbar);
        {
            pg8::Gemm g{(const pg8::bf16_t*)XN, (const pg8::bf16_t*)(ws + WS_WIN) + (size_t)NMIX * DM, M, 3 * DM, DM}; pg8::SchedGates S{G, bx};
            pg8::EpiGate E{(const bf16*)(ws + WS_YB), (size_t)M * DM, (bf16*)(ws + WS_MB), p.in[4] + l * 3072};
#ifndef NO_G3
            pg8::gemm_phase<pg8::EpiGate, pg8::SchedGates, true, true>(lds, g, S, E);
#endif
        }
        xcd_barrier(xbar);
        {
            pg8::Gemm g{(const pg8::bf16_t*)(ws + WS_MB), (const pg8::bf16_t*)(ws + WS_WMIX), M, DM, DM}; pg8::StaticOrder S; S.init(M, DM, G, bx);
            pg8::EpiStore<0> E{(bf16*)(ws + WS_Y), DM, 1 << 20, 0};
#ifndef NO_G4
            pg8::gemm_phase<pg8::EpiStore<0>, pg8::StaticOrder, true, true>(lds, g, S, E);
#endif
        }
        xcd_barrier(xbar);
        row_phase(hin, (const bf16*)(ws + WS_Y), p.in[16] + l * DM, hbuf, p.in[17] + l * DM, XN, gw, NGW, lane);
        xcd_barrier(xbar);
        {
            pg8::Gemm g{(const pg8::bf16_t*)XN, (const pg8::bf16_t*)(ws + WS_WUP), M, DFF, DM}; pg8::StaticOrder S; S.init(M, DFF, G, bx);
            pg8::EpiStore<1> E{(bf16*)(ws + WS_H), DFF, 1 << 20, 0};
#ifndef NO_G5
            pg8::gemm_phase<pg8::EpiStore<1>, pg8::StaticOrder, true, true>(lds, g, S, E);
#endif
        }
        xcd_barrier(xbar);
        {
            pg8::Gemm g{(const pg8::bf16_t*)(ws + WS_H), (const pg8::bf16_t*)(ws + WS_WDN), M, DM, DFF}; pg8::StaticOrder S; S.init(M, DM, G, bx);
            pg8::EpiStore<0> E{(bf16*)(ws + WS_Y2), DM, 1 << 20, 0};
#ifndef NO_G6
            pg8::gemm_phase<pg8::EpiStore<0>, pg8::StaticOrder, true, true>(lds, g, S, E);
#endif
        }
        xcd_barrier(xbar);
        if (l == 0) {
            LayerW L{p.in[3] + (size_t)DM * 7184, p.in[5] + 16 * 256, p.in[12] + 512 * DM, p.in[13] + 512 * DM, p.in[14] + 512 * DM, p.in[15] + DM * DM, p.in[18] + (size_t)DM * DFF, p.in[19] + (size_t)DFF * DM};
    #ifndef NO_CVT
        convert_weights(L, ws, lds, gw, NGW, wave, lane);
#endif
            for (int i = bx * 512 + tid; i < 64 * 512; i += G * 512) kmean[i] = 0.f;
            row_phase(hbuf, (const bf16*)(ws + WS_Y2), p.in[20], hbuf, p.in[2] + DM, XN, gw, NGW, lane);
            xcd_barrier(xbar);
        } else {
            row_phase(hbuf, (const bf16*)(ws + WS_Y2), p.in[20] + DM, hbuf, nullptr, nullptr, gw, NGW, lane);
        }
        }
}
__global__ void __launch_bounds__(512, 2) mk_fwd(Params p) {
    extern __shared__ __attribute__((aligned(16))) unsigned char lds_raw[];
    cg::grid_group grid = cg::this_grid();
    LAS unsigned char* lds = (LAS unsigned char*)lds_raw;
    if (threadIdx.x < 64) ((LAS unsigned*)(lds + LDS_RING + 256))[threadIdx.x] = 0u;
    __syncthreads();
    const XcdBarrier xbar = xcd_barrier_post((unsigned*)(p.ws + WS_CTL) + 4096, (volatile LAS unsigned*)(lds + LDS_RING + 256));
    const int tid = threadIdx.x, lane = tid & 63, wave = __builtin_amdgcn_readfirstlane(tid >> 6);
    const int G = gridDim.x, bx = blockIdx.x;
    const int vcu = (G % 8 == 0) ? (bx % 8) * (G / 8) + bx / 8 : bx;
    const int gw = vcu * 8 + wave, NGW = G * 8;
    unsigned char* ws = p.ws;
    unsigned* ctl = (unsigned*)(ws + WS_CTL);
    float* ropec = (float*)(ws + WS_ROPEC); float* ropes = (float*)(ws + WS_ROPES); float* kmean = (float*)(ws + WS_KMEAN);
    bf16* XN = (bf16*)(ws + WS_XN);
    const float* x = p.in[0]; const int* positions = (const int*)p.in[1];
    float* hbuf = p.out;

    {
        LayerW L{p.in[3], p.in[5], p.in[12], p.in[13], p.in[14], p.in[15], p.in[18], p.in[19]};
#ifndef NO_CVT
        convert_weights(L, ws, lds, gw, NGW, wave, lane);
#endif
        for (int i = bx * 512 + tid; i < M * 32; i += G * 512) { const int m = i >> 5, f = i & 31; const float ang = (float)positions[m] * c_inv_freq[f];
            const double rev = (double)ang * 0.15915494309189535; const float fr = (float)(rev - __builtin_rint(rev));
            ropec[i] = __builtin_amdgcn_cosf(fr); ropes[i] = __builtin_amdgcn_sinf(fr); }
        for (int i = bx * 512 + tid; i < 64 * 512; i += G * 512) kmean[i] = 0.f;
        row_phase(x, nullptr, nullptr, nullptr, p.in[2], XN, gw, NGW, lane);
    }
    grid.sync();
    layer_body<0>(p, lds, lds_raw, xbar);
    layer_body<1>(p, lds, lds_raw, xbar);
}

extern "C" void kernel_launch(void* const* d_in, const int* in_sizes, int n_in, void* d_out, int out_size, void* d_ws, size_t ws_size, hipStream_t stream) {
    static int grid = 0;
    if (grid == 0) {
        if (n_in != 21 || out_size != M * DM || ws_size < WS_END) { fprintf(stderr, "kernel_launch: unexpected shapes (n_in %d out %d ws %zu)\n", n_in, out_size, ws_size); grid = -1; return; }
        int dev = 0, cus = 0, per_cu = 0;
        hipGetDevice(&dev);
        hipDeviceGetAttribute(&cus, hipDeviceAttributeMultiprocessorCount, dev);
        hipFuncSetAttribute((const void*)mk_fwd, hipFuncAttributeMaxDynamicSharedMemorySize, LDS_BYTES);
        hipOccupancyMaxActiveBlocksPerMultiprocessor(&per_cu, (const void*)mk_fwd, 512, LDS_BYTES);
        if (per_cu < 1) { fprintf(stderr, "kernel_launch: occupancy query says %d blocks per CU\n", per_cu); per_cu = 1; }
        if (per_cu > 1) per_cu = 1;
        grid = cus * per_cu;
        (void)hipGetLastError();
    }
    if (grid < 0) return;
    hipMemsetAsync((char*)d_ws + WS_CTL, 0, 65536, stream);
    Params p{};
    for (int i = 0; i < 21; ++i) p.in[i] = (const float*)d_in[i];
    p.out = (float*)d_out; p.ws = (unsigned char*)d_ws;
    void* args[] = {&p};
    hipError_t e = hipLaunchCooperativeKernel((const void*)mk_fwd, dim3(grid), dim3(512), args, LDS_BYTES, stream);
    if (e != hipSuccess) fprintf(stderr, "cooperative launch failed: %s (grid %d)\n", hipGetErrorString(e), grid);
}
```

```cpp
#include <hip/hip_runtime.h>
#include <hip/hip_cooperative_groups.h>
#include <cstdio>
#include <cstdint>
namespace cg = cooperative_groups;
namespace pg8 {
#define PG8_LAS __attribute__((address_space(3)))
typedef unsigned short bf16_t;
typedef short bf16x8 __attribute__((ext_vector_type(8)));
typedef float f32x4 __attribute__((ext_vector_type(4)));
typedef unsigned u32x4 __attribute__((ext_vector_type(4)));
constexpr int BM = 256, BK = 64, HALF = 128, HTB = HALF * BK * 2  , STAGE_BYTES = 8 * HTB, NXCD = 8, WGM = 8;

__host__ __device__ __forceinline__ int lds_byte(int r, int c) { const int st = (r >> 4) * 2 + (c >> 5), rr = r & 15, cc = c & 31, ob = rr * 64 + cc * 2; return st * 1024 + (ob ^ (((ob >> 9) & 1) << 5)); }
__host__ __device__ __forceinline__ void stage_rc(int b, int& R, int& C) { const int st = b / 1024, sb = b % 1024, swz = sb ^ (((sb >> 9) & 1) << 5); R = (st >> 1) * 16 + swz / 64; C = (st & 1) * 32 + (swz % 64) / 2; }
__host__ __device__ __forceinline__ int perm32(int rho) { const int n = rho >> 4, i = rho & 15; return 8 * (i >> 2) + 4 * n + (i & 3); }

struct Unit { int pm, pn; };
struct Gemm { const bf16_t* A; const bf16_t* Bt; int M, N, K; };

struct StaticOrder {
    int nM, nN, nwg, G, c;
    __host__ __device__ void init(int M, int N, int G_, int c_) { nM = M / BM; nN = N / BM; nwg = nM * nN; G = G_; c = c_; }
    __host__ __device__ bool next(int i, Unit& u) const {
        const long L = (long)i * G + c; if (L >= nwg) return false;
        int wgid = (int)L; { const int q = nwg / NXCD, r = nwg % NXCD, xcd = wgid % NXCD, off = wgid / NXCD; wgid = (xcd < r ? xcd * (q + 1) : r * (q + 1) + (xcd - r) * q) + off; }
        const int nig = WGM * nN, gid = wgid / nig, fm = gid * WGM, gsz = (nM - fm) < WGM ? (nM - fm) : WGM;
        u.pm = fm + ((wgid % nig) % gsz); u.pn = (wgid % nig) / gsz; return true;
    }
    __device__ __forceinline__ void a_ready(const Unit&) const {}
    __device__ __forceinline__ void done(const Unit&) const {}
};

__device__ __forceinline__ unsigned cvt_pk_bf16(float lo, float hi) { unsigned r; asm volatile("v_cvt_pk_bf16_f32 %0, %1, %2" : "=v"(r) : "v"(lo), "v"(hi)); return r; }
typedef float f32x2 __attribute__((ext_vector_type(2)));
typedef unsigned u32x2 __attribute__((ext_vector_type(2)));
__device__ __forceinline__ float bf_lo(unsigned w) { return __uint_as_float(w << 16); }
__device__ __forceinline__ float bf_hi(unsigned w) { return __uint_as_float(w & 0xffff0000u); }
__device__ __forceinline__ float sigm(float x) { return 1.0f / (1.0f + __expf(-x)); }
__device__ __forceinline__ u32x4 pack8(const f32x4 a, const f32x4 b) { u32x4 w; w.x = cvt_pk_bf16(a[0], a[1]); w.y = cvt_pk_bf16(a[2], a[3]); w.z = cvt_pk_bf16(b[0], b[1]); w.w = cvt_pk_bf16(b[2], b[3]); return w; }

__host__ __device__ __forceinline__ void tile_of(int wgid, int nM, int nN, int& pm, int& pn) {
    const int nwg = nM * nN;
    { const int q = nwg / NXCD, r = nwg % NXCD, xcd = wgid % NXCD, off = wgid / NXCD; wgid = (xcd < r ? xcd * (q + 1) : r * (q + 1) + (xcd - r) * q) + off; }
    const int nig = WGM * nN, gid = wgid / nig, fm = gid * WGM, gsz = (nM - fm) < WGM ? (nM - fm) : WGM;
    pm = fm + ((wgid % nig) % gsz); pn = (wgid % nig) / gsz;
}
struct SchedBranch {
    int G, c;
    __device__ bool next(int i, Unit& u) const { const long L = (long)i * G + c; if (L >= 768) return false; const int j = (int)(L / 256); int pm, pn; tile_of((int)(L % 256), 64, 4, pm, pn); u.pm = 64 * j + pm; u.pn = 4 * j + pn; return true; }
    __device__ __forceinline__ void a_ready(const Unit&) const {}
    __device__ __forceinline__ void done(const Unit&) const {}
};
struct SchedGates {
    int G, c;
    __device__ bool next(int i, Unit& u) const { const int j = i % 3, rnd = i / 3; const long L = (long)rnd * G + c; if (L >= 256) return false; int pm, pn; tile_of((int)L, 64, 4, pm, pn); u.pm = pm; u.pn = 4 * j + pn; return true; }
    __device__ __forceinline__ void a_ready(const Unit&) const {}
    __device__ __forceinline__ void done(const Unit&) const {}
};

template <int ACT  > struct EpiStore {
    static constexpr bool PERM = true, AFTER_DRAIN = false;
    bf16_t* O; int ldc; int jdiv; size_t jstride;
    __device__ __forceinline__ void operator()(const f32x4 (&acc)[2][2][4][2], const Unit& u, int wr, int wc, int fr, int fq) const {
        const int j = u.pn / jdiv; const int pm = u.pm - 64 * j, pn = u.pn - jdiv * j;
        bf16_t* base = O + (size_t)j * jstride;
        const int row0 = pm * BM + wr * 64 + fr, col0 = pn * BM + wc * 32 + 8 * fq;
#pragma unroll
        for (int ai = 0; ai < 2; ++ai)
#pragma unroll
            for (int m = 0; m < 4; ++m) { bf16_t* rowp = base + (size_t)(row0 + ai * HALF + m * 16) * ldc + col0;
#pragma unroll
                for (int bj = 0; bj < 2; ++bj) { f32x4 v0 = acc[ai][bj][m][0], v1 = acc[ai][bj][m][1];
                    if (ACT == 1) {
#pragma unroll
                        for (int e = 0; e < 4; ++e) { const float a = fmaxf(v0[e], 0.f), b = fmaxf(v1[e], 0.f); v0[e] = a * a; v1[e] = b * b; } }
                    *(u32x4*)(rowp + bj * HALF) = pack8(v0, v1); } }
    }
};
struct EpiGate {
    static constexpr bool PERM = true, AFTER_DRAIN = false;
    const bf16_t* Y; size_t ystride; bf16_t* Mb; const float* bgate;
    __device__ __forceinline__ void operator()(const f32x4 (&acc)[2][2][4][2], const Unit& u, int wr, int wc, int fr, int fq) const {
        const int j = u.pn >> 2, pn = u.pn & 3;
        const bf16_t* Yj = Y + (size_t)j * ystride;
        const int row0 = u.pm * BM + wr * 64 + fr, col0 = pn * BM + wc * 32 + 8 * fq;
        f32x4 bv[2][2];
#pragma unroll
        for (int bj = 0; bj < 2; ++bj)
#pragma unroll
            for (int n = 0; n < 2; ++n) bv[bj][n] = *(const f32x4*)(bgate + j * 1024 + col0 + bj * HALF + 4 * n);
#pragma unroll
        for (int ai = 0; ai < 2; ++ai)
#pragma unroll
            for (int m = 0; m < 4; ++m) { const size_t off = (size_t)(row0 + ai * HALF + m * 16) * 1024 + col0;
#pragma unroll
                for (int bj = 0; bj < 2; ++bj) { const size_t o2 = off + bj * HALF;
                    const u32x4 yw = *(const u32x4*)(Yj + o2); u32x4 mw = (u32x4){0u, 0u, 0u, 0u}; if (j > 0) mw = *(const u32x4*)(Mb + o2);
                    const f32x4 x0 = acc[ai][bj][m][0] + bv[bj][0], x1 = acc[ai][bj][m][1] + bv[bj][1];
                    f32x4 r0, r1;
                    r0[0] = sigm(x0[0]) * bf_lo(yw.x) + bf_lo(mw.x); r0[1] = sigm(x0[1]) * bf_hi(yw.x) + bf_hi(mw.x);
                    r0[2] = sigm(x0[2]) * bf_lo(yw.y) + bf_lo(mw.y); r0[3] = sigm(x0[3]) * bf_hi(yw.y) + bf_hi(mw.y);
                    r1[0] = sigm(x1[0]) * bf_lo(yw.z) + bf_lo(mw.z); r1[1] = sigm(x1[1]) * bf_hi(yw.z) + bf_hi(mw.z);
                    r1[2] = sigm(x1[2]) * bf_lo(yw.w) + bf_lo(mw.w); r1[3] = sigm(x1[3]) * bf_hi(yw.w) + bf_hi(mw.w);
                    *(u32x4*)(Mb + o2) = pack8(r0, r1); } }
    }
};
struct EpiInproj {
    static constexpr bool PERM = true, AFTER_DRAIN = false;
    bf16_t *Q, *Kb, *V, *lq, *lk, *lv, *lr, *ca, *cg; float* gdec; float* kmean; const float* ropec; const float* ropes; const float* bgla; float qscale;
    __device__ __forceinline__ void operator()(const f32x4 (&acc)[2][2][4][2], const Unit& u, int wr, int wc, int fr, int fq) const {
        const int pn = u.pn;
        const int row0 = u.pm * BM + wr * 64 + fr, cl = wc * 32 + 8 * fq;
        if (pn < 4) {
            const bool isk = pn >= 2; bf16_t* dst = isk ? Kb : Q; const int ct = (pn & 1) * 256; const float sc = isk ? 1.0f : qscale;
#pragma unroll
            for (int bj = 0; bj < 2; ++bj) { const int c = ct + bj * HALF + cl, i0 = (c & 63) >> 1;
                float cs[8];
#pragma unroll
                for (int e = 0; e < 8; ++e) cs[e] = 0.f;
#pragma unroll
                for (int ai = 0; ai < 2; ++ai)
#pragma unroll
                    for (int m = 0; m < 4; ++m) { const int row = row0 + ai * HALF + m * 16;
                        const f32x4 co = *(const f32x4*)(ropec + (size_t)row * 32 + i0), si = *(const f32x4*)(ropes + (size_t)row * 32 + i0);
                        const f32x4 v0 = acc[ai][bj][m][0], v1 = acc[ai][bj][m][1]; f32x4 o0, o1;
                        o0[0] = (v0[0] * co[0] - v0[1] * si[0]) * sc; o0[1] = (v0[1] * co[0] + v0[0] * si[0]) * sc;
                        o0[2] = (v0[2] * co[1] - v0[3] * si[1]) * sc; o0[3] = (v0[3] * co[1] + v0[2] * si[1]) * sc;
                        o1[0] = (v1[0] * co[2] - v1[1] * si[2]) * sc; o1[1] = (v1[1] * co[2] + v1[0] * si[2]) * sc;
                        o1[2] = (v1[2] * co[3] - v1[3] * si[3]) * sc; o1[3] = (v1[3] * co[3] + v1[2] * si[3]) * sc;
#pragma unroll
                        for (int e = 0; e < 4; ++e) { cs[e] += o0[e]; cs[4 + e] += o1[e]; }
                        *(u32x4*)(dst + (size_t)row * 512 + c) = pack8(o0, o1); }
                if (isk) {
#pragma unroll
                    for (int e = 0; e < 8; ++e) { float s = cs[e]; s += __shfl_xor(s, 1); s += __shfl_xor(s, 2); s += __shfl_xor(s, 4); s += __shfl_xor(s, 8); cs[e] = s; }
                    if (fr == 0) {
#pragma unroll
                        for (int e = 0; e < 8; ++e) atomicAdd(kmean + (size_t)u.pm * 512 + c + e, cs[e]); } } }
        } else if (pn == 10) {
#pragma unroll
            for (int bj = 0; bj < 2; ++bj) { const int c = bj * HALF + cl; const f32x4 b0 = *(const f32x4*)(bgla + c), b1 = *(const f32x4*)(bgla + c + 4);
#pragma unroll
                for (int ai = 0; ai < 2; ++ai)
#pragma unroll
                    for (int m = 0; m < 4; ++m) { const int row = row0 + ai * HALF + m * 16; const f32x4 x0 = acc[ai][bj][m][0] + b0, x1 = acc[ai][bj][m][1] + b1; f32x4 g0, g1;
#pragma unroll
                        for (int e = 0; e < 4; ++e) { g0[e] = (fminf(x0[e], 0.f) - __logf(1.0f + __expf(-fabsf(x0[e])))) * 0.0625f; g1[e] = (fminf(x1[e], 0.f) - __logf(1.0f + __expf(-fabsf(x1[e])))) * 0.0625f; }
                        *(f32x4*)(gdec + (size_t)row * 256 + c) = g0; *(f32x4*)(gdec + (size_t)row * 256 + c + 4) = g1; } }
        } else {
            bf16_t* dst; int ld = 512, ct; float sc = 1.0f;
            if (pn < 6) { dst = V; ct = (pn - 4) * 256; }
            else if (pn == 6) { dst = lq; ld = 256; ct = 0; sc = 0.125f; }
            else if (pn == 7) { dst = lk; ld = 256; ct = 0; }
            else if (pn < 10) { dst = lv; ct = (pn - 8) * 256; }
            else if (pn < 13) { dst = lr; ct = (pn - 11) * 256; }
            else if (pn < 15) { dst = ca; ct = (pn - 13) * 256; }
            else { dst = cg; ct = (pn - 15) * 256; }
#pragma unroll
            for (int ai = 0; ai < 2; ++ai)
#pragma unroll
                for (int m = 0; m < 4; ++m) { bf16_t* rowp = dst + (size_t)(row0 + ai * HALF + m * 16) * ld + ct + cl;
#pragma unroll
                    for (int bj = 0; bj < 2; ++bj) *(u32x4*)(rowp + bj * HALF) = pack8(acc[ai][bj][m][0] * sc, acc[ai][bj][m][1] * sc); }
        }
    }
};
template <class Epi, class Sched, bool ALIGN_EPI = false, bool SP2 = false>
__device__ __forceinline__ void gemm_phase(PG8_LAS unsigned char* lds, const Gemm g, const Sched& S, const Epi& E) {
    int tid_l = threadIdx.x; asm volatile("" : "+v"(tid_l));
    const int tid = tid_l, wid = __builtin_amdgcn_readfirstlane(tid >> 6), lane = tid & 63, wr = wid >> 2, wc = wid & 3, fr = lane & 15, fq = lane >> 4;
    const int K = g.K, nt = K / BK;
    unsigned voffA[2], voffB[2];
#pragma unroll
    for (int i = 0; i < 2; ++i) { int R, C; stage_rc(tid * 16 + i * 8192, R, C); const int Rb = Epi::PERM ? ((R & ~31) + perm32(R & 31)) : R;
        voffA[i] = (unsigned)(R * K + C) * 2u; voffB[i] = (unsigned)(Rb * K + C) * 2u; }
    const size_t kstep = (size_t)(BK * 2);
    const size_t hstep = (size_t)HALF * K * 2;
    const size_t tstep = 2 * hstep;
    const unsigned ldsw = (unsigned)wid * 1024u;
    const int aoff = lds_byte(wr * 64 + fr, fq * 8), boff = lds_byte(wc * 32 + fr, fq * 8);
#define PG8_SA(b, h) (((b) * 2 + (h)) * HTB)
#define PG8_SB(b, h) ((4 + (b) * 2 + (h)) * HTB)
#define PG8_STAGE(bufoff, gbase, voff) do { _Pragma("unroll") for (int _i = 0; _i < 2; ++_i) \
        __builtin_amdgcn_global_load_lds((const unsigned*)((const char*)(gbase) + (voff)[_i]), (PG8_LAS unsigned*)(lds + (bufoff) + ldsw + _i * 8192), 16, 0, 0); } while (0)
#define PG8_LDA(dst, b, h) do { _Pragma("unroll") for (int m = 0; m < 4; ++m) _Pragma("unroll") for (int k = 0; k < 2; ++k) dst[m][k] = *(const PG8_LAS bf16x8*)(lds + PG8_SA(b, h) + aoff + m * 2048 + k * 1024); } while (0)
#define PG8_LDB(dst, b, h) do { _Pragma("unroll") for (int n = 0; n < 2; ++n) _Pragma("unroll") for (int k = 0; k < 2; ++k) dst[n][k] = *(const PG8_LAS bf16x8*)(lds + PG8_SB(b, h) + boff + n * 2048 + k * 1024); } while (0)
#define PG8_MMA(ai, bj, At, Bt) do { __builtin_amdgcn_s_setprio(1); _Pragma("unroll") for (int m = 0; m < 4; ++m) _Pragma("unroll") for (int n = 0; n < 2; ++n) _Pragma("unroll") for (int k = 0; k < 2; ++k) \
        acc[ai][bj][m][n] = __builtin_amdgcn_mfma_f32_16x16x32_bf16(Bt[n][k], At[m][k], acc[ai][bj][m][n], 0, 0, 0); __builtin_amdgcn_s_setprio(0); } while (0)
#define PG8_WAIT_V(n) asm volatile("s_waitcnt vmcnt(" #n ")" ::: "memory")
#define PG8_WAIT_L(n) asm volatile("s_waitcnt lgkmcnt(" #n ")" ::: "memory")
#define PG8_BAR __builtin_amdgcn_s_barrier()
#define PG8_SCHED __builtin_amdgcn_sched_barrier(0)
    Unit cur, nxt; int ui = 0;
    if (!S.next(0, cur)) return;
    f32x4 acc[2][2][4][2];
#pragma unroll
    for (int a = 0; a < 2; ++a)
#pragma unroll
        for (int b = 0; b < 2; ++b)
#pragma unroll
            for (int m = 0; m < 4; ++m)
#pragma unroll
                for (int n = 0; n < 2; ++n) acc[a][b][m][n] = (f32x4){0.f, 0.f, 0.f, 0.f};
    bf16x8 At[4][2], B0[2][2], B1[2][2];
    const char* cA = (const char*)g.A + (size_t)cur.pm * tstep; const char* cB = (const char*)g.Bt + (size_t)cur.pn * tstep;
    S.a_ready(cur);
    if constexpr (SP2) {
        PG8_STAGE(PG8_SB(0, 0), cB, voffB); PG8_STAGE(PG8_SB(0, 1), cB + hstep, voffB); PG8_STAGE(PG8_SA(0, 0), cA, voffA); PG8_STAGE(PG8_SA(0, 1), cA + hstep, voffA);
        if (wr == 1) PG8_BAR;
        PG8_WAIT_V(2); PG8_BAR;
        PG8_STAGE(PG8_SB(1, 0), cB + kstep, voffB); PG8_STAGE(PG8_SA(1, 0), cA + kstep, voffA); PG8_STAGE(PG8_SB(1, 1), cB + hstep + kstep, voffB);
        PG8_WAIT_V(6); PG8_BAR;
    } else {
        PG8_STAGE(PG8_SB(0, 0), cB, voffB); PG8_STAGE(PG8_SA(0, 0), cA, voffA); PG8_STAGE(PG8_SB(0, 1), cB + hstep, voffB); PG8_STAGE(PG8_SA(0, 1), cA + hstep, voffA);
        if (wr == 1) PG8_BAR;
        PG8_WAIT_V(4); PG8_BAR;
        PG8_STAGE(PG8_SB(1, 0), cB + kstep, voffB); PG8_STAGE(PG8_SA(1, 0), cA + kstep, voffA); PG8_STAGE(PG8_SB(1, 1), cB + hstep + kstep, voffB);
        PG8_WAIT_V(6); PG8_BAR;
    }
    for (;;) {
        const bool has_next = S.next(ui + 1, nxt);
        const char* nA = has_next ? (const char*)g.A + (size_t)nxt.pm * tstep : cA; const char* nB = has_next ? (const char*)g.Bt + (size_t)nxt.pn * tstep : cB;
        for (int t = 0; t < nt; t += 2) {
            const bool last = (t == nt - 2);
            const char* a1 = cA + (size_t)(t + 1) * kstep;
            const char* a2 = last ? nA : cA + (size_t)(t + 2) * kstep; const char* b2 = last ? nB : cB + (size_t)(t + 2) * kstep;
            const char* a3 = a2 + kstep; const char* b3 = b2 + kstep;
            if (last && has_next) S.a_ready(nxt);
            if constexpr (SP2) {
            PG8_LDB(B0, 0, 0); PG8_LDB(B1, 0, 1); PG8_SCHED; PG8_LDA(At, 0, 0); PG8_STAGE(PG8_SA(1, 1), a1 + hstep, voffA);
            PG8_WAIT_V(8); PG8_WAIT_L(0); PG8_BAR; PG8_MMA(0, 0, At, B0); PG8_MMA(0, 1, At, B1); PG8_BAR; PG8_SCHED;
            PG8_LDA(At, 0, 1); PG8_STAGE(PG8_SB(0, 0), b2, voffB); PG8_STAGE(PG8_SB(0, 1), b2 + hstep, voffB); PG8_STAGE(PG8_SA(0, 0), a2, voffA);
            PG8_WAIT_V(8); PG8_WAIT_L(0); PG8_BAR; PG8_MMA(1, 0, At, B0); PG8_MMA(1, 1, At, B1); PG8_BAR; PG8_SCHED;
            PG8_LDB(B0, 1, 0); PG8_LDB(B1, 1, 1); PG8_SCHED; PG8_LDA(At, 1, 0); PG8_STAGE(PG8_SA(0, 1), a2 + hstep, voffA);
            PG8_WAIT_V(8); PG8_WAIT_L(0); PG8_BAR; PG8_MMA(0, 0, At, B0); PG8_MMA(0, 1, At, B1); PG8_BAR; PG8_SCHED;
            PG8_LDA(At, 1, 1); PG8_STAGE(PG8_SB(1, 0), b3, voffB); PG8_STAGE(PG8_SB(1, 1), b3 + hstep, voffB); PG8_STAGE(PG8_SA(1, 0), a3, voffA);
            PG8_WAIT_V(8); PG8_WAIT_L(0); PG8_BAR; PG8_MMA(1, 0, At, B0); PG8_MMA(1, 1, At, B1); PG8_BAR; PG8_SCHED;
            } else {
            PG8_LDB(B0, 0, 0); PG8_SCHED; PG8_LDA(At, 0, 0); PG8_STAGE(PG8_SA(1, 1), a1 + hstep, voffA);
            PG8_WAIT_L(8); PG8_BAR; PG8_WAIT_L(0); PG8_MMA(0, 0, At, B0); PG8_BAR; PG8_SCHED;
            PG8_LDB(B1, 0, 1); PG8_STAGE(PG8_SB(0, 0), b2, voffB);
            PG8_BAR; PG8_WAIT_L(0); PG8_MMA(0, 1, At, B1); PG8_BAR;
            PG8_LDA(At, 0, 1); PG8_STAGE(PG8_SA(0, 0), a2, voffA);
            PG8_BAR; PG8_WAIT_L(0); PG8_MMA(1, 0, At, B0); PG8_BAR; PG8_SCHED;
            PG8_STAGE(PG8_SB(0, 1), b2 + hstep, voffB);
            PG8_WAIT_V(6); PG8_BAR; PG8_MMA(1, 1, At, B1); PG8_BAR;
            PG8_LDB(B0, 1, 0); PG8_SCHED; PG8_LDA(At, 1, 0); PG8_STAGE(PG8_SA(0, 1), a2 + hstep, voffA);
            PG8_WAIT_L(8); PG8_BAR; PG8_WAIT_L(0); PG8_MMA(0, 0, At, B0); PG8_BAR; PG8_SCHED;
            PG8_LDB(B1, 1, 1); PG8_STAGE(PG8_SB(1, 0), b3, voffB);
            PG8_BAR; PG8_WAIT_L(0); PG8_MMA(0, 1, At, B1); PG8_BAR;
            PG8_LDA(At, 1, 1); PG8_STAGE(PG8_SA(1, 0), a3, voffA);
            PG8_BAR; PG8_WAIT_L(0); PG8_MMA(1, 0, At, B0); PG8_BAR; PG8_SCHED;
            PG8_STAGE(PG8_SB(1, 1), b3 + hstep, voffB);
            PG8_WAIT_V(6); PG8_BAR; PG8_MMA(1, 1, At, B1); PG8_BAR;
            }
        }
        if constexpr (ALIGN_EPI) { if (wr == 0) PG8_BAR; }
        if constexpr (!Epi::AFTER_DRAIN) { E(acc, cur, wr, wc, fr, fq); S.done(cur); }
        if (!has_next) break;
#pragma unroll
        for (int a = 0; a < 2; ++a)
#pragma unroll
            for (int b = 0; b < 2; ++b)
#pragma unroll
                for (int m = 0; m < 4; ++m)
#pragma unroll
                    for (int n = 0; n < 2; ++n) acc[a][b][m][n] = (f32x4){0.f, 0.f, 0.f, 0.f};
        cur = nxt; cA = nA; cB = nB; ++ui;
        if constexpr (ALIGN_EPI) { if (wr == 1) PG8_BAR; }
    }
    PG8_WAIT_V(0);
    if constexpr (!ALIGN_EPI) { if (wr == 0) PG8_BAR; }
    PG8_BAR;
    if constexpr (Epi::AFTER_DRAIN) { E.fused(acc, cur, wr, wc, fr, fq, lds, wid, lane); S.done(cur); }
#undef PG8_SA
#undef PG8_SB
#undef PG8_STAGE
#undef PG8_LDA
#undef PG8_LDB
#undef PG8_MMA
#undef PG8_WAIT_V
#undef PG8_WAIT_L
#undef PG8_BAR
#undef PG8_SCHED
}
}
#include <hip/hip_bf16.h>
#include <cmath>
namespace attn_body {
using bf16=__hip_bfloat16;
using bf16x8=__attribute__((ext_vector_type(8)))short;
using s16x4=__attribute__((ext_vector_type(4)))short;
using f32x16=__attribute__((ext_vector_type(16)))float;
using u32x4=__attribute__((ext_vector_type(4)))unsigned;
constexpr int BATCH=8,NHEAD=8,SEQ=2048,D=64,DM=NHEAD*D;
constexpr int NW=8,QBLK=32,QB=QBLK*NW,KVBLK=64,NQB=SEQ/QB;
constexpr int ATTN_PITCH=DM, ATTN_UNIT_ROWS=QB;
__device__ __forceinline__ int crow(int r,int hi){return (r&3)+8*(r>>2)+4*hi;}
#define SBAR() __builtin_amdgcn_sched_barrier(0)
__device__ __forceinline__ void cmask(f32x16&p0,f32x16&p1,int jb,int qrel,int hi){
  const float NEG=-INFINITY; int kb=64*jb+4*hi;
  #pragma unroll
  for(int r=0;r<16;++r){int kv=kb+(r&3)+8*(r>>2); if(kv>qrel)p0[r]=NEG; if(kv+32>qrel)p1[r]=NEG;}
}

constexpr int NSLOT=3, SLOTB=8192;
constexpr int LDS_K=0, LDS_V=NSLOT*SLOTB, LDS_WS=2*NSLOT*SLOTB, LDS_OST=LDS_WS+NW*64*4, LDS_BYTES=LDS_OST+NW*4096;
constexpr float C2=0.125f*1.4426950408889634f;
__device__ __forceinline__ void glds16(const void*gsrc,unsigned lds_dst){unsigned keep;
  asm volatile("s_mov_b32 %0, m0\n\ts_mov_b32 m0, %2\n\ts_nop 0\n\tglobal_load_lds_dwordx4 %1, off\n\ts_mov_b32 m0, %0":"=&s"(keep):"v"(gsrc),"s"(lds_dst):"memory");}
__device__ __forceinline__ float max3f(float a,float b,float c){float r;asm("v_max3_f32 %0, %1, %2, %3":"=v"(r):"v"(a),"v"(b),"v"(c));return r;}
__device__ __forceinline__ float max2f(float a,float b){float r;asm("v_max_f32_e32 %0, %1, %2":"=v"(r):"v"(a),"v"(b));return r;}
__device__ __forceinline__ float fadd_s(float a,float b){float r;asm("v_add_f32_e32 %0, %1, %2":"=v"(r):"v"(a),"v"(b));return r;}
__device__ __forceinline__ float fsub_s(float a,float b){float r;asm("v_sub_f32_e32 %0, %1, %2":"=v"(r):"v"(a),"v"(b));return r;}
typedef float f32x2_t __attribute__((ext_vector_type(2))); typedef float f32x4_t __attribute__((ext_vector_type(4))); typedef __bf16 bf16x2_t __attribute__((ext_vector_type(2)));
__device__ __forceinline__ unsigned cvtpk_s(float lo,float hi){f32x2_t v={lo,hi};bf16x2_t b=__builtin_convertvector(v,bf16x2_t);return __builtin_bit_cast(unsigned,b);}
#define WAIT_BAR(N) asm volatile("s_waitcnt vmcnt(" #N ") lgkmcnt(0)\n\ts_barrier":::"memory")

__device__ __forceinline__ void qkt(f32x16&p0,f32x16&p1,const char*Kslot,const bf16x8*qr,const f32x16&negm,int r32,int hi){
  const char*kb=Kslot+hi*1024+r32*16;
  #pragma unroll
  for(int d0=0;d0<4;++d0){
    const bf16x8 b0=*reinterpret_cast<const bf16x8*>(kb+d0*2048);
    const bf16x8 b1=*reinterpret_cast<const bf16x8*>(kb+d0*2048+512);
    if(d0==0){p0=__builtin_amdgcn_mfma_f32_32x32x16_bf16(b0,qr[0],negm,0,0,0);p1=__builtin_amdgcn_mfma_f32_32x32x16_bf16(b1,qr[0],negm,0,0,0);}
    else{p0=__builtin_amdgcn_mfma_f32_32x32x16_bf16(b0,qr[d0],p0,0,0,0);p1=__builtin_amdgcn_mfma_f32_32x32x16_bf16(b1,qr[d0],p1,0,0,0);}}
}
typedef __attribute__((address_space(3))) const char* lds_cptr;
typedef short v4i16_t __attribute__((ext_vector_type(4)));
__device__ __forceinline__ void kload8(bf16x8*kf,lds_cptr kp){
  kf[0]=*(const __attribute__((address_space(3))) bf16x8*)(kp);      kf[1]=*(const __attribute__((address_space(3))) bf16x8*)(kp+512);
  kf[2]=*(const __attribute__((address_space(3))) bf16x8*)(kp+2048); kf[3]=*(const __attribute__((address_space(3))) bf16x8*)(kp+2560);
  kf[4]=*(const __attribute__((address_space(3))) bf16x8*)(kp+4096); kf[5]=*(const __attribute__((address_space(3))) bf16x8*)(kp+4608);
  kf[6]=*(const __attribute__((address_space(3))) bf16x8*)(kp+6144); kf[7]=*(const __attribute__((address_space(3))) bf16x8*)(kp+6656);
}
__device__ __forceinline__ void kload2(bf16x8*kf,lds_cptr kp,int j){ kf[2*j]=*(const __attribute__((address_space(3))) bf16x8*)(kp+j*2048); kf[2*j+1]=*(const __attribute__((address_space(3))) bf16x8*)(kp+j*2048+512); }
__device__ __forceinline__ s16x4 vtr(lds_cptr p){ return __builtin_bit_cast(s16x4,__builtin_amdgcn_ds_read_tr16_b64_v4i16((__attribute__((address_space(3))) v4i16_t*)p)); }
__device__ __forceinline__ float rowmax(const f32x16&p0,const f32x16&p1){
  float a=max3f(p0[0],p0[1],p1[0]),b=max3f(p0[2],p0[3],p1[1]);a=max3f(a,p1[2],p1[3]);
  #pragma unroll
  for(int r=4;r<16;r+=4){a=max3f(a,p0[r],p0[r+1]);b=max3f(b,p0[r+2],p0[r+3]);a=max3f(a,p1[r],p1[r+1]);b=max3f(b,p1[r+2],p1[r+3]);}
  const float m=max2f(a,b);
  auto rr=__builtin_amdgcn_permlane32_swap(__float_as_uint(m),__float_as_uint(m),false,false);
  return max2f(__uint_as_float(rr[0]),__uint_as_float(rr[1]));
}
__device__ __forceinline__ void pv(f32x16*o,int vb,bf16x8 pa0,bf16x8 pa1,bf16x8 pa2,bf16x8 pa3){
  #pragma unroll
  for(int d0=0;d0<2;++d0){s16x4 lo[4],hi[4];
    #pragma unroll
    for(int ks=0;ks<4;++ks){
      asm volatile("ds_read_b64_tr_b16 %0,%1 offset:%c2":"=&v"(lo[ks]):"v"(vb),"i"(d0*4096+ks*1024):"memory");
      asm volatile("ds_read_b64_tr_b16 %0,%1 offset:%c2":"=&v"(hi[ks]):"v"(vb),"i"(d0*4096+ks*1024+512):"memory");}
    asm volatile("s_waitcnt lgkmcnt(0)":::"memory");SBAR();
    #define PK(k) (bf16x8){lo[k][0],lo[k][1],lo[k][2],lo[k][3],hi[k][0],hi[k][1],hi[k][2],hi[k][3]}
    o[d0]=__builtin_amdgcn_mfma_f32_32x32x16_bf16(pa0,PK(0),o[d0],0,0,0);
    o[d0]=__builtin_amdgcn_mfma_f32_32x32x16_bf16(pa1,PK(1),o[d0],0,0,0);
    o[d0]=__builtin_amdgcn_mfma_f32_32x32x16_bf16(pa2,PK(2),o[d0],0,0,0);
    o[d0]=__builtin_amdgcn_mfma_f32_32x32x16_bf16(pa3,PK(3),o[d0],0,0,0);
    #undef PK
  }
}

#ifndef ATTN_STORE16
#define ATTN_STORE16(p,v) (*(u32x4*)(p)=(v))
#endif
template<int THRL> __device__ __forceinline__ void attn_unit(int b,int h,int qb,const bf16*Q,const bf16*__restrict__ K,const bf16*__restrict__ V,bf16*O,const float*ksum,char*shm){
  int tid_l=threadIdx.x; asm volatile("":"+v"(tid_l)); const int tid=tid_l,lane=tid&63,r32=lane&31,hi=lane>>5; const int wid=__builtin_amdgcn_readfirstlane(tid>>6);
  const long rowbase=(long)b*SEQ; const int q0=qb*QB;
  const bf16*Qw=Q+(rowbase+q0+wid*QBLK)*DM+h*D;
  const bf16*Kh=K+rowbase*DM+h*D,*Vh=V+rowbase*DM+h*D;
  const unsigned lds0=(unsigned)(uintptr_t)shm;
  float*wsf=(float*)(shm+LDS_WS)+wid*64;
  const bf16*ksrc=Kh+(long)lane*DM+wid*8;
  const bf16*vsrc=Vh+(long)(16*(wid&3)+(lane>>2))*DM+(wid>>2)*32+(lane&3)*8;
  const unsigned kdst=lds0+LDS_K+wid*1024, vdst=lds0+LDS_V+wid*1024;
  #define DMA_K(t,slot) glds16(ksrc+(long)(t)*KVBLK*DM,(unsigned)__builtin_amdgcn_readfirstlane(kdst+(slot)))
  #define DMA_V(t,slot) glds16(vsrc+(long)(t)*KVBLK*DM,(unsigned)__builtin_amdgcn_readfirstlane(vdst+(slot)))
  const int vb0=(int)(lds0+LDS_V)+((lane>>4)&1)*32+(lane&3)*8+(4*hi+((lane&15)>>2))*64;
  const char*Kbase=shm+LDS_K; bf16x8 kf[8];
  const lds_cptr shm3=(lds_cptr)shm; const lds_cptr kp0=shm3+LDS_K+hi*1024+r32*16; const lds_cptr vp0=shm3+LDS_V+((lane>>4)&1)*32+(lane&3)*8+(4*hi+((lane&15)>>2))*64;
  const int NT=(q0+QB)/KVBLK;
  DMA_K(0,0);DMA_V(0,0);DMA_K(1,SLOTB);
  bf16x8 qr[4];
  #pragma unroll
  for(int d0=0;d0<4;++d0)qr[d0]=*reinterpret_cast<const bf16x8*>(&Qw[(long)r32*DM+d0*16+hi*8]);

  unsigned selmask=1u<<qb;
  if(qb>0){
    float gt[7];
    #pragma unroll
    for(int n=0;n<7;++n){ float s=-INFINITY;
      if(n<qb){ const float*km=ksum+((size_t)(b*8+n))*512+h*64; s=0.f;
        #pragma unroll
        for(int d0=0;d0<4;++d0){ const f32x4_t k0=*reinterpret_cast<const f32x4_t*>(km+d0*16+hi*8),k1=*reinterpret_cast<const f32x4_t*>(km+d0*16+hi*8+4);
          #pragma unroll
          for(int e=0;e<4;++e){ s+=__uint_as_float(((unsigned)(unsigned short)qr[d0][e])<<16)*k0[e]; s+=__uint_as_float(((unsigned)(unsigned short)qr[d0][4+e])<<16)*k1[e]; } }
        s+=__shfl_xor(s,32); }
      gt[n]=s; }
    #pragma unroll
    for(int n=0;n<7;++n){ int rank=0;
      #pragma unroll
      for(int m2=0;m2<7;++m2){ if(m2!=n) rank+=((gt[m2]>gt[n])||((gt[m2]==gt[n])&&(m2<n)))?1:0; }
      if(n<qb&&rank<3)selmask|=(1u<<n); }
  }
  #define MMASK(P0,P1,t) do{ if(!((selmask>>((t)>>2))&1u)){ _Pragma("unroll") for(int r=0;r<16;++r){P0[r]=-INFINITY;P1[r]=-INFINITY;} } }while(0)
  float mhat=0.f,l_reg=0.f;f32x16 o[2];o[0]=f32x16{};o[1]=f32x16{};f32x16 negm=f32x16{};asm volatile("":"+v"(negm));
  const int qrel=wid*QBLK+r32;
  #define CMASK(P0,P1,t) do{int jb_=(t)-(NT-4); if(jb_>=0)cmask(P0,P1,jb_,qrel,hi);}while(0)
  bool resc=false;
  #define START(P0,P1) do{ const float rm=rowmax(P0,P1); resc=false; \
    { const float dl=rm; mhat=fadd_s(mhat,dl); \
      _Pragma("unroll") for(int r=0;r<16;++r){P0[r]=fsub_s(P0[r],dl);P1[r]=fsub_s(P1[r],dl);} \
      _Pragma("unroll") for(int r=0;r<16;++r)negm[r]=-mhat; asm volatile("":"+v"(negm)); } \
    _Pragma("unroll") for(int r=0;r<16;++r)P0[r]=__builtin_amdgcn_exp2f(P0[r]); }while(0)
  #define RESC() do{ if(resc){ asm volatile("s_waitcnt lgkmcnt(0)":::"memory"); \
      _Pragma("unroll") for(int d_=0;d_<2;++d_) _Pragma("unroll") for(int r=0;r<16;++r)o[d_][r]*=wsf[crow(r,hi)]; } }while(0)
  f32x16 pA0,pA1,pB0,pB1;
  int sl_prev=0,sl_cur=0,sl_next=SLOTB;
  #define ROT() do{sl_prev=sl_cur;sl_cur=sl_next;sl_next=(sl_next==(NSLOT-1)*SLOTB)?0:sl_next+SLOTB;}while(0)
  DMA_K(2,2*SLOTB);
  WAIT_BAR(3);
  qkt(pA0,pA1,Kbase,qr,negm,r32,hi);asm volatile("s_nop 15\n\ts_nop 7":"+v"(pA0),"+v"(pA1));CMASK(pA0,pA1,0);
  START(pA0,pA1);
  _Pragma("unroll") for(int r=0;r<16;++r)pA1[r]=__builtin_amdgcn_exp2f(pA1[r]);
  if(!(selmask&1u)){ _Pragma("unroll") for(int r=0;r<16;++r){pA0[r]=0.f;pA1[r]=0.f;} }
  WAIT_BAR(0);
  DMA_K(3,0);DMA_V(1,SLOTB);
  ROT();
  kload8(kf,kp0+sl_cur);
  WAIT_BAR(2);
  s16x4 vlo[8],vhi[8]; u32x4 pw0,pw1,pw2,pw3;
  #define PKW(P,B) cvtpk_s(P[B],P[B+1])
  #define PAF(k) __builtin_bit_cast(bf16x8,pw##k)
  #define VFR(i) (bf16x8){vlo[i][0],vlo[i][1],vlo[i][2],vlo[i][3],vhi[i][0],vhi[i][1],vhi[i][2],vhi[i][3]}
  #define PIN(x) asm volatile("":"+v"(x))
  #define MX3(a,b,c) __builtin_fmaxf(__builtin_fmaxf((a),(b)),(c))
  #define GAPA(MF,A0,A1,A2,A3,W0,W1,PW) do{ MF; sacc+=A0; sacc+=A1; sacc+=A2; sacc+=A3; PIN(sacc); W0; W1; PIN(PW); SBAR(); }while(0)
  #define EX(v) __builtin_amdgcn_exp2f(v)
  #define GAPB(MF,X,B) do{ MF; X[B]=EX(X[B]); X[B+1]=EX(X[B+1]); X[B+2]=EX(X[B+2]); X[B+3]=EX(X[B+3]); PIN(X); SBAR(); }while(0)
  #define VRD(i) do{ vlo[i]=vtr(vp_+(((i)>>2)*4096+((i)&3)*1024)); vhi[i]=vtr(vp_+(((i)>>2)*4096+((i)&3)*1024+512)); }while(0)
  #define KRD(G,j) do{ if(G){ kload2(kf,kp0+sl_next,j); SBAR(); } }while(0)
  #define STEP(C0,C1,P0,P1,t,GK,GV,GL) do{ SBAR(); \
    const lds_cptr vp_=vp0+sl_prev; \
    VRD(0); SBAR(); float sacc=(P0[0]+P0[1]); \
    GAPA(C0=__builtin_amdgcn_mfma_f32_32x32x16_bf16(kf[0],qr[0],negm,0,0,0), P0[2],P0[3],P0[4],P0[5],     pw0[0]=PKW(P0,0), pw0[1]=PKW(P0,2), pw0); \
    VRD(4); SBAR(); GAPA(C1=__builtin_amdgcn_mfma_f32_32x32x16_bf16(kf[1],qr[0],negm,0,0,0), P0[6],P0[7],P0[8],P0[9],     pw0[2]=PKW(P0,4), pw0[3]=PKW(P0,6), pw0); \
    VRD(1); SBAR(); GAPA(C0=__builtin_amdgcn_mfma_f32_32x32x16_bf16(kf[2],qr[1],C0,0,0,0),   P0[10],P0[11],P0[12],P0[13], pw1[0]=PKW(P0,8), pw1[1]=PKW(P0,10), pw1); \
    VRD(5); SBAR(); GAPA(C1=__builtin_amdgcn_mfma_f32_32x32x16_bf16(kf[3],qr[1],C1,0,0,0),   P0[14],P0[15],P1[0],P1[1],   pw1[2]=PKW(P0,12),pw1[3]=PKW(P0,14), pw1); \
    VRD(2); SBAR(); GAPA(C0=__builtin_amdgcn_mfma_f32_32x32x16_bf16(kf[4],qr[2],C0,0,0,0),   P1[2],P1[3],P1[4],P1[5],     pw2[0]=PKW(P1,0), pw2[1]=PKW(P1,2), pw2); \
    VRD(6); SBAR(); GAPA(C1=__builtin_amdgcn_mfma_f32_32x32x16_bf16(kf[5],qr[2],C1,0,0,0),   P1[6],P1[7],P1[8],P1[9],     pw2[2]=PKW(P1,4), pw2[3]=PKW(P1,6), pw2); \
    VRD(3); SBAR(); GAPA(C0=__builtin_amdgcn_mfma_f32_32x32x16_bf16(kf[6],qr[3],C0,0,0,0),   P1[10],P1[11],P1[12],P1[13], pw3[0]=PKW(P1,8), pw3[1]=PKW(P1,10), pw3); \
    VRD(7); SBAR(); GAPA(C1=__builtin_amdgcn_mfma_f32_32x32x16_bf16(kf[7],qr[3],C1,0,0,0),   P1[14],P1[15],0.f,0.f,       pw3[2]=PKW(P1,12),pw3[3]=PKW(P1,14), pw3); \
    l_reg+=sacc; \
    if(GK){DMA_K((t)+3,sl_cur);} if(GV){DMA_V((t)+1,sl_next);} \
    CMASK(C0,C1,t); \
    { float a=MX3(C0[0],C0[1],C1[0]),b=MX3(C0[2],C0[3],C1[1]); a=MX3(a,C1[2],C1[3]); \
      _Pragma("unroll") for(int r=4;r<16;r+=4){a=MX3(a,C0[r],C0[r+1]);b=MX3(b,C0[r+2],C0[r+3]);a=MX3(a,C1[r],C1[r+1]);b=MX3(b,C1[r+2],C1[r+3]);} \
      float rm=__builtin_fmaxf(a,b); { auto rr=__builtin_amdgcn_permlane32_swap(__float_as_uint(rm),__float_as_uint(rm),false,false); rm=__builtin_fmaxf(__uint_as_float(rr[0]),__uint_as_float(rr[1])); } \
      resc=false; \
      if(__builtin_expect(__any(rm>(float)THRL),0)){ const float dl=__builtin_fmaxf(rm,0.f); mhat+=dl; \
        _Pragma("unroll") for(int r=0;r<16;++r){C0[r]-=dl;C1[r]-=dl;} \
        _Pragma("unroll") for(int r=0;r<16;++r)negm[r]=-mhat; asm volatile("":"+v"(negm)); \
        const float f=__builtin_amdgcn_exp2f(-dl); l_reg*=f; if(hi==0)wsf[r32]=f; resc=true; } } \
    MMASK(C0,C1,t); \
    SBAR(); \
    GAPB(o[0]=__builtin_amdgcn_mfma_f32_32x32x16_bf16(PAF(0),VFR(0),o[0],0,0,0), C0,0); \
    GAPB(o[1]=__builtin_amdgcn_mfma_f32_32x32x16_bf16(PAF(0),VFR(4),o[1],0,0,0), C0,4); \
    KRD(GL,0); GAPB(o[0]=__builtin_amdgcn_mfma_f32_32x32x16_bf16(PAF(1),VFR(1),o[0],0,0,0), C0,8); \
    KRD(GL,1); GAPB(o[1]=__builtin_amdgcn_mfma_f32_32x32x16_bf16(PAF(1),VFR(5),o[1],0,0,0), C0,12); \
    KRD(GL,2); GAPB(o[0]=__builtin_amdgcn_mfma_f32_32x32x16_bf16(PAF(2),VFR(2),o[0],0,0,0), C1,0); \
    KRD(GL,3); GAPB(o[1]=__builtin_amdgcn_mfma_f32_32x32x16_bf16(PAF(2),VFR(6),o[1],0,0,0), C1,4); \
    GAPB(o[0]=__builtin_amdgcn_mfma_f32_32x32x16_bf16(PAF(3),VFR(3),o[0],0,0,0), C1,8); \
    GAPB(o[1]=__builtin_amdgcn_mfma_f32_32x32x16_bf16(PAF(3),VFR(7),o[1],0,0,0), C1,12); \
    }while(0)
  int t=1;
  #undef CMASK
  #define CMASK(P0,P1,t) do{}while(0)
  for(;t+5<NT;t+=2){
    STEP(pB0,pB1,pA0,pA1,t,true,true,true);     WAIT_BAR(2); RESC(); ROT();
    STEP(pA0,pA1,pB0,pB1,t+1,true,true,true);   WAIT_BAR(2); RESC(); ROT();
  }
  #undef CMASK
  #define CMASK(P0,P1,t) do{int jb_=(t)-(NT-4); if(jb_>=0)cmask(P0,P1,jb_,qrel,hi);}while(0)
  #define ENDW(tt) do{ if((tt)+3<NT){WAIT_BAR(2);} else if((tt)+2<NT){WAIT_BAR(1);} else {WAIT_BAR(0);} }while(0)
  for(;t+1<NT;t+=2){
    STEP(pB0,pB1,pA0,pA1,t,(t+3<NT),(t+1<NT),(t+1<NT));       ENDW(t);   RESC(); ROT();
    STEP(pA0,pA1,pB0,pB1,t+1,(t+4<NT),(t+2<NT),(t+2<NT));     ENDW(t+1); RESC(); ROT();
  }
  STEP(pB0,pB1,pA0,pA1,NT-1,false,false,false); RESC();
  { float sacc=pB0[0]+pB0[1]; _Pragma("unroll") for(int r=2;r<16;++r)sacc+=pB0[r]; _Pragma("unroll") for(int r=0;r<16;++r)sacc+=pB1[r]; l_reg+=sacc;
    pw0=(u32x4){PKW(pB0,0),PKW(pB0,2),PKW(pB0,4),PKW(pB0,6)};pw1=(u32x4){PKW(pB0,8),PKW(pB0,10),PKW(pB0,12),PKW(pB0,14)};pw2=(u32x4){PKW(pB1,0),PKW(pB1,2),PKW(pB1,4),PKW(pB1,6)};pw3=(u32x4){PKW(pB1,8),PKW(pB1,10),PKW(pB1,12),PKW(pB1,14)};
    SBAR(); pv(o,vb0+sl_cur,PAF(0),PAF(1),PAF(2),PAF(3)); }
  #undef PKW
  #undef PAF
  #undef VFR
  #undef PIN
  #undef MX3
  #undef GAPA
  #undef GAPB
  #undef EX
  #undef VRD
  #undef KRD
  #undef STEP
  #undef ENDW
  {auto rr=__builtin_amdgcn_permlane32_swap(__float_as_uint(l_reg),__float_as_uint(l_reg),false,false);l_reg=__uint_as_float(rr[0])+__uint_as_float(rr[1]);}
  if(hi==0)wsf[32+r32]=l_reg;asm volatile("s_waitcnt lgkmcnt(0)":::"memory");
  float rli[16];
  #pragma unroll
  for(int r=0;r<16;++r)rli[r]=__builtin_amdgcn_rcpf(wsf[32+crow(r,hi)]);
  bf16*Ow=O+(rowbase+q0+wid*QBLK)*DM+h*D;
  { bf16*stg=(bf16*)(shm+LDS_OST)+wid*2048;
    #pragma unroll
    for(int r=0;r<16;++r){const int orow=crow(r,hi);
      #pragma unroll
      for(int d0=0;d0<2;++d0)stg[orow*64+d0*32+r32]=__float2bfloat16(o[d0][r]*rli[r]);}
    asm volatile("s_waitcnt lgkmcnt(0)":::"memory");
    #pragma unroll
    for(int i=0;i<4;++i){const int row=i*8+(lane>>3),ch=lane&7; const u32x4 v=*(const u32x4*)(stg+row*64+ch*8); ATTN_STORE16(Ow+(long)row*DM+ch*8,v);} }
  asm volatile("s_waitcnt lgkmcnt(0)\n\ts_barrier":::"memory");
  #undef MMASK
  #undef DMA_K
  #undef DMA_V
  #undef CMASK
  #undef START
  #undef RESC
  #undef ROT
}
constexpr int ATTN_LDS_BYTES=LDS_BYTES;
struct AttnTensors { const bf16* Q; const bf16* K; const bf16* V; bf16* O; };
struct AttnUnit { int bh; int qb; };
struct StaticOrder {
  int vcu;
  __device__ __forceinline__ explicit StaticOrder(int grid,int block):vcu((block%8)*(grid/8)+block/8){}
  __device__ __forceinline__ bool next(int i,AttnUnit&u)const{ if(i>=4)return false; const int s=vcu&7; u.bh=vcu>>3; u.qb=(i==0)?s:(i==1)?15-s:(i==2)?16+s:31-s; return true; }
  __device__ __forceinline__ void a_ready(const AttnUnit&)const{}
  __device__ __forceinline__ void done(const AttnUnit&)const{}
};
template<class Sched,int THRL=8> __device__ __forceinline__ void attn_phase(char*lds,const AttnTensors&T,const Sched&S){
  AttnUnit u;
  for(int i=0;S.next(i,u);++i){ S.a_ready(u); attn_unit<THRL>(u.bh/NHEAD,u.bh%NHEAD,u.qb,T.Q,T.K,T.V,T.O,lds); S.done(u); }
}
#undef SBAR
#undef WAIT_BAR
}
#define GAS __attribute__((address_space(1)))
#define LAS __attribute__((address_space(3)))
#define XB_TMO      128
#define XB_XCNT(j)  (256  + 64 * (j))
#define XB_XSUB(j)  (1280 + 64 * (j))
#define XB_XGEN(j)  (2304 + 64 * (j))
#define XB_TOP      3328
#define XB_TOPGEN   3392
#define XCD_BAR_WORDS 3456
#define XB_SPIN_CAP (1u << 18)

__device__ __forceinline__ unsigned xb_ld(unsigned* p)              { return __hip_atomic_load(p, __ATOMIC_RELAXED, __HIP_MEMORY_SCOPE_AGENT); }
__device__ __forceinline__ unsigned xb_add(unsigned* p, unsigned v) { return __hip_atomic_fetch_add(p, v, __ATOMIC_RELAXED, __HIP_MEMORY_SCOPE_AGENT); }
__device__ __forceinline__ unsigned xb_xcc_id() { return (unsigned)__builtin_amdgcn_s_getreg((3 << 11) | 20) & 0xFu; }
#define XB_SPIN(cond, bar) do { unsigned _sp = 0; while (cond) { __builtin_amdgcn_s_sleep(1); \
    if ((++_sp & 255u) == 0u) { if (xb_ld(&(bar)[XB_TMO])) break; if (_sp > XB_SPIN_CAP) { atomicAdd(&(bar)[XB_TMO], 1u); break; } } } } while (0)

struct XcdBarrier {
    unsigned* bar; unsigned x;
    volatile LAS unsigned* st;
};

__device__ __forceinline__ XcdBarrier xcd_barrier_post(unsigned* bar, volatile LAS unsigned* st) {
    XcdBarrier b; b.bar = bar; b.x = xb_xcc_id(); b.st = st;
    if (threadIdx.x == 0) (void)xb_add(&bar[XB_XCNT(b.x)], 1u);
    return b;
}
__device__ __forceinline__ void xcd_barrier_complete(unsigned* bar, unsigned x, unsigned& nloc, unsigned& nx) {
    const unsigned G = gridDim.x * gridDim.y * gridDim.z;
    unsigned sum, cnt, mine, sp = 0u;
    for (;;) {
        sum = 0u; cnt = 0u; mine = 0u;
#pragma unroll
        for (unsigned j = 0; j < 16; ++j) { const unsigned c = xb_ld(&bar[XB_XCNT(j)]); sum += c; cnt += (c > 0u) ? 1u : 0u; mine = (j == x) ? c : mine; }
        if (sum == G) break;
        __builtin_amdgcn_s_sleep(1);
        if ((++sp & 255u) == 0u) { if (xb_ld(&bar[XB_TMO])) break; if (sp > XB_SPIN_CAP) { atomicAdd(&bar[XB_TMO], 1u); break; } }
    }
    nloc = mine > 0u ? mine : 1u; nx = cnt > 0u ? cnt : 1u;
}

__device__ __forceinline__ void xcd_barrier(const XcdBarrier& b) {
    asm volatile("s_waitcnt vmcnt(0)" ::: "memory");
    __syncthreads();
    if (threadIdx.x == 0) {
        unsigned* bar = b.bar;
        __builtin_amdgcn_s_waitcnt(0);
        unsigned nloc = b.st[0], nx = b.st[1];
        if (nloc == 0u) { xcd_barrier_complete(bar, b.x, nloc, nx); b.st[0] = nloc; b.st[1] = nx; }
        const unsigned old = xb_add(&bar[XB_XSUB(b.x)], 1u);
        const unsigned gen = old / nloc;
        if (old + 1u == (gen + 1u) * nloc) {
            __builtin_amdgcn_fence(__ATOMIC_RELEASE, "agent");
            asm volatile("s_waitcnt vmcnt(0)" ::: "memory");
            const unsigned og = xb_add(&bar[XB_TOP], 1u);
            const unsigned tg = og / nx;
            if (og + 1u == (tg + 1u) * nx) xb_add(&bar[XB_TOPGEN], 1u);
            else XB_SPIN(xb_ld(&bar[XB_TOPGEN]) == tg, bar);
            __builtin_amdgcn_fence(__ATOMIC_ACQUIRE, "agent");
            xb_add(&bar[XB_XGEN(b.x)], 1u);
            asm volatile("s_waitcnt vmcnt(0)" ::: "memory");
        } else {
            XB_SPIN(xb_ld(&bar[XB_XGEN(b.x)]) == gen, bar);
            __builtin_amdgcn_fence(__ATOMIC_ACQUIRE, "agent");
            asm volatile("s_waitcnt vmcnt(0)" ::: "memory");
        }
    }
    __syncthreads();
}
typedef unsigned short bf16;
typedef unsigned v4u __attribute__((ext_vector_type(4)));
typedef unsigned v2u __attribute__((ext_vector_type(2)));
typedef float f32x4 __attribute__((ext_vector_type(4)));
typedef float f32x2 __attribute__((ext_vector_type(2)));
typedef float f32x16 __attribute__((ext_vector_type(16)));
typedef short bf16x8 __attribute__((ext_vector_type(8)));
constexpr int NB = 8, SEQ = 2048, DM = 1024, M = NB * SEQ, DFF = 4096;
constexpr int NIN = 7424;
constexpr int NMIX = 4352;
constexpr float EPS = 1e-6f;
constexpr size_t MiB = 1u << 20;
constexpr size_t WS_CTL = 0, WS_ROPEC = 1 * MiB, WS_ROPES = 3 * MiB, WS_KMEAN = 5 * MiB;
constexpr size_t WS_WIN = 6 * MiB, WS_WBO = WS_WIN + (size_t)NIN * DM * 2, WS_WMIX = WS_WBO + 3 * MiB, WS_WUP = WS_WMIX + 2 * MiB, WS_WDN = WS_WUP + 8 * MiB;
static_assert(WS_WDN + 8 * MiB <= 42 * MiB, "weights");
constexpr size_t WS_XN = 42 * MiB;
constexpr size_t WS_Q = 74 * MiB, WS_LR = 90 * MiB, WS_CONV = 106 * MiB, WS_K = 122 * MiB, WS_V = 138 * MiB, WS_LQ = 154 * MiB, WS_LK = 162 * MiB, WS_LV = 170 * MiB,
                 WS_CA = 186 * MiB, WS_CG = 202 * MiB, WS_G = 218 * MiB;
constexpr size_t WS_YB = 122 * MiB, WS_MB = 74 * MiB, WS_Y = 106 * MiB, WS_H = 74 * MiB, WS_Y2 = 202 * MiB, WS_END = 256 * MiB;
constexpr size_t WS_SLOC = 234 * MiB, WS_DTOT = 242 * MiB;
constexpr int LDS_RING = 131072, LDS_BYTES = LDS_RING + 1024;

__device__ __forceinline__ unsigned f2bf(float f) { unsigned u = __builtin_bit_cast(unsigned, f); return (u + 0x7fffu + ((u >> 16) & 1u)) >> 16; }
__device__ __forceinline__ unsigned pk2(float lo, float hi) { return pg8::cvt_pk_bf16(lo, hi); }
__device__ __forceinline__ float bflo(unsigned w) { return __uint_as_float(w << 16); }
__device__ __forceinline__ float bfhi(unsigned w) { return __uint_as_float(w & 0xffff0000u); }
__device__ __forceinline__ float bf1(unsigned short h) { return __uint_as_float(((unsigned)h) << 16); }
__device__ __forceinline__ float sigmf(float x) { return 1.0f / (1.0f + __expf(-x)); }
__device__ __forceinline__ float wave_sum(float v) {
#pragma unroll
    for (int o = 1; o < 64; o <<= 1) v += __shfl_xor(v, o);
    return v;
}
__constant__ float c_inv_freq[32] = {1.0f, 0.7498942613601685f, 0.5623413324356079f, 0.4216965138912201f, 0.3162277638912201f, 0.23713737726211548f, 0.17782793939113617f, 0.133352130651474f, 0.10000000149011612f, 0.07498941570520401f, 0.05623413249850273f, 0.04216965287923813f, 0.03162277489900589f, 0.023713737726211548f, 0.017782794311642647f, 0.01333521492779255f, 0.009999999776482582f, 0.007498941849917173f, 0.005623413249850273f, 0.0042169648222625256f, 0.003162277629598975f, 0.00237137358635664f, 0.0017782794311642647f, 0.0013335214462131262f, 0.0010000000474974513f, 0.0007498942431993783f, 0.000562341301701963f, 0.0004216965171508491f, 0.0003162277571391314f, 0.00023713737027719617f, 0.00017782794020604342f, 0.0001333521504420787f};

__device__ __forceinline__ int src_inproj(int n) {
    if (n < 1024) { const int sec = n >> 9, w = n & 511, hd = w >> 6, j = w & 63; return sec * 512 + hd * 64 + (j >> 1) + 32 * (j & 1); }
    if (n < 2560) return n;
    if (n < 2816) return -(n - 2560) - 1;
    return n - 240;
}
template <bool INPROJ> __device__ __forceinline__ void wt_item(const float* W, int K, int ldw, int nblk, bf16* WT, const float* A2, LAS float* scr, int item, int lane) {
    const int kb = item / nblk, nb = item % nblk, k0 = 64 * kb, n0 = 32 * nb;
    const int nd = n0 + (lane & 31); const int src = INPROJ ? src_inproj(nd) : nd;
    if (INPROJ && src < 0) {
        const int nn = -(src + 1);
        float a2[16];
#pragma unroll
        for (int r = 0; r < 16; ++r) a2[r] = A2[r * 256 + nn];
#pragma unroll 2
        for (int i = 0; i < 32; ++i) { const int kk = 2 * i + (lane >> 5); const float* wr = W + (size_t)(k0 + kk) * ldw + 2560; float s = 0.f;
#pragma unroll
            for (int r = 0; r < 16; r += 4) { const f32x4 w4 = *(const f32x4*)(wr + r); s += w4[0] * a2[r] + w4[1] * a2[r + 1] + w4[2] * a2[r + 2] + w4[3] * a2[r + 3]; }
            scr[kk * 33 + (lane & 31)] = s; }
    } else {
        float wv[32];
#pragma unroll
        for (int i = 0; i < 32; ++i) { const int kk = 2 * i + (lane >> 5); wv[i] = W[(size_t)(k0 + kk) * ldw + src]; }
#pragma unroll
        for (int i = 0; i < 32; ++i) { const int kk = 2 * i + (lane >> 5); scr[kk * 33 + (lane & 31)] = wv[i]; }
    }
    asm volatile("s_waitcnt lgkmcnt(0)" ::: "memory");
    const int c = lane & 7;
#pragma unroll
    for (int j = 0; j < 4; ++j) { const int n = (lane >> 3) + 8 * j; const LAS float* s = scr + (8 * c) * 33 + n;
        v4u o; o.x = pk2(s[0 * 33], s[1 * 33]); o.y = pk2(s[2 * 33], s[3 * 33]); o.z = pk2(s[4 * 33], s[5 * 33]); o.w = pk2(s[6 * 33], s[7 * 33]);
        *(v4u*)(WT + (size_t)(n0 + n) * K + k0 + 8 * c) = o; }
    asm volatile("s_waitcnt lgkmcnt(0)" ::: "memory");
}
struct LayerW { const float *w_in, *a2, *w_mo, *w_go, *w_co, *w_mix, *w_up, *w_dn; };
__device__ __forceinline__ void convert_weights(const LayerW& L, unsigned char* ws, LAS unsigned char* lds, int gw, int NGW, int wave, int lane) {
    LAS float* scr = (LAS float*)(lds + wave * 16384);
    bf16* Win = (bf16*)(ws + WS_WIN); bf16* Wbo = (bf16*)(ws + WS_WBO); bf16* Wmix = (bf16*)(ws + WS_WMIX); bf16* Wup = (bf16*)(ws + WS_WUP); bf16* Wdn = (bf16*)(ws + WS_WDN);
    constexpr int I_IN = (DM / 64) * (NIN / 32), I_BO = (512 / 64) * (DM / 32), I_MIX = (DM / 64) * (DM / 32), I_UP = (DM / 64) * (DFF / 32), I_DN = (DFF / 64) * (DM / 32);
    constexpr int NITEMS = I_IN + 3 * I_BO + I_MIX + I_UP + I_DN;
    for (int it = gw; it < NITEMS; it += NGW) {
        int r = it;
        if (r < I_IN) { wt_item<true>(L.w_in, DM, 7184, NIN / 32, Win, L.a2, scr, r, lane); continue; } r -= I_IN;
        if (r < I_BO) { wt_item<false>(L.w_mo, 512, DM, DM / 32, Wbo, nullptr, scr, r, lane); continue; } r -= I_BO;
        if (r < I_BO) { wt_item<false>(L.w_go, 512, DM, DM / 32, Wbo + 512 * 1024, nullptr, scr, r, lane); continue; } r -= I_BO;
        if (r < I_BO) { wt_item<false>(L.w_co, 512, DM, DM / 32, Wbo + 2 * 512 * 1024, nullptr, scr, r, lane); continue; } r -= I_BO;
        if (r < I_MIX) { wt_item<false>(L.w_mix, DM, DM, DM / 32, Wmix, nullptr, scr, r, lane); continue; } r -= I_MIX;
        if (r < I_UP) { wt_item<false>(L.w_up, DM, DFF, DFF / 32, Wup, nullptr, scr, r, lane); continue; } r -= I_UP;
        wt_item<false>(L.w_dn, DFF, DM, DM / 32, Wdn, nullptr, scr, r, lane);
    }
}
__device__ __forceinline__ void row_phase(const float* hin, const bf16* Y, const float* gY, float* hout, const float* gN, bf16* XN, int gw, int NGW, int lane) {
    constexpr int NR = 4;
    for (int m0 = gw; m0 < M; m0 += NR * NGW) {
        f32x4 v[NR][4]; v2u yw[NR][4];
#pragma unroll
        for (int r = 0; r < NR; ++r) { const int m = m0 + r * NGW; if (m < M) { const f32x4* xr = (const f32x4*)(hin + (size_t)m * DM) + lane;
#pragma unroll
            for (int j = 0; j < 4; ++j) v[r][j] = xr[64 * j];
            if (Y) { const v2u* yr = (const v2u*)(Y + (size_t)m * DM) + lane;
#pragma unroll
                for (int j = 0; j < 4; ++j) yw[r][j] = yr[64 * j]; } } }
        if (Y) {
            float s[NR];
#pragma unroll
            for (int r = 0; r < NR; ++r) { s[r] = 0.f;
#pragma unroll
                for (int j = 0; j < 4; ++j) { const float a = bflo(yw[r][j].x), b = bfhi(yw[r][j].x), c = bflo(yw[r][j].y), d = bfhi(yw[r][j].y); s[r] += (a * a + b * b) + (c * c + d * d); } }
#pragma unroll
            for (int o = 1; o < 64; o <<= 1) {
#pragma unroll
                for (int r = 0; r < NR; ++r) s[r] += __shfl_xor(s[r], o); }
#pragma unroll
            for (int r = 0; r < NR; ++r) { const int m = m0 + r * NGW; if (m < M) { const float rstd = rsqrtf(s[r] * (1.f / DM) + EPS); f32x4* ho = (f32x4*)(hout + (size_t)m * DM) + lane;
#pragma unroll
                for (int j = 0; j < 4; ++j) { const f32x4 g = ((const f32x4*)gY)[lane + 64 * j]; const f32x4 y = (f32x4){bflo(yw[r][j].x), bfhi(yw[r][j].x), bflo(yw[r][j].y), bfhi(yw[r][j].y)};
                    v[r][j] = v[r][j] + y * rstd * g; ho[64 * j] = v[r][j]; } } }
        }
        if (XN) {
            float s[NR];
#pragma unroll
            for (int r = 0; r < NR; ++r) { s[r] = 0.f;
#pragma unroll
                for (int j = 0; j < 4; ++j) s[r] += (v[r][j].x * v[r][j].x + v[r][j].y * v[r][j].y) + (v[r][j].z * v[r][j].z + v[r][j].w * v[r][j].w); }
#pragma unroll
            for (int o = 1; o < 64; o <<= 1) {
#pragma unroll
                for (int r = 0; r < NR; ++r) s[r] += __shfl_xor(s[r], o); }
#pragma unroll
            for (int r = 0; r < NR; ++r) { const int m = m0 + r * NGW; if (m < M) { const float rstd = rsqrtf(s[r] * (1.f / DM) + EPS); v2u* o8 = (v2u*)(XN + (size_t)m * DM) + lane;
#pragma unroll
                for (int j = 0; j < 4; ++j) { const f32x4 g = ((const f32x4*)gN)[lane + 64 * j]; const f32x4 t = v[r][j] * rstd * g; v2u w; w.x = pk2(t.x, t.y); w.y = pk2(t.z, t.w); o8[64 * j] = w; } } }
        }
    }
}
constexpr int GL_QS = 0, GL_KS = 9216, GL_KT = 18432, GL_VT = 27648, GL_AS = 46080, GL_ST = 55296, GL_OS = 92160, GL_TOT = 125952, GL_DEC = 128000;
__device__ __forceinline__ int crow16(int r, int hi) { return (r & 3) + 8 * (r >> 2) + 4 * hi; }
template <int PASS> __device__ __forceinline__ void gla_unit(int bh, int grp, const bf16* lq, const bf16* lk, const bf16* lv, const float* gdec, bf16* lr, const float* gnorm, float* Sloc, float* Dtot, LAS unsigned char* lds) {
    int tid_l = threadIdx.x; asm volatile("" : "+v"(tid_l));
    const int tid = tid_l, lane = tid & 63, l31 = lane & 31, hi = lane >> 5; const int w = __builtin_amdgcn_readfirstlane(tid >> 6);
    const int b = bh >> 2, hh = bh & 3; const size_t rowbase = (size_t)b * SEQ + (size_t)grp * 256;
    LAS bf16* Qs = (LAS bf16*)(lds + GL_QS); LAS bf16* Ks = (LAS bf16*)(lds + GL_KS); LAS bf16* KT = (LAS bf16*)(lds + GL_KT); LAS bf16* VT = (LAS bf16*)(lds + GL_VT);
    LAS bf16* As = (LAS bf16*)(lds + GL_AS); LAS bf16* ST = (LAS bf16*)(lds + GL_ST); LAS float* Os = (LAS float*)(lds + GL_OS); LAS float* tot = (LAS float*)(lds + GL_TOT); LAS float* dec = (LAS float*)(lds + GL_DEC);
    const int dt = w >> 2, vt = w & 3;
    f32x16 sacc;
#pragma unroll
    for (int r = 0; r < 16; ++r) sacc[r] = 0.f;
    float gl_n[8]; unsigned short qv_n[8], kv_n[8], vv0_n[8], vv1_n[8];
#define GLA_LOAD(ci) do { const size_t r0_ = rowbase + (size_t)(ci) * 64 + 8 * w; _Pragma("unroll") for (int t = 0; t < 8; ++t) { const size_t row = r0_ + t; gl_n[t] = gdec[row * 256 + hh * 64 + lane]; \
        if (PASS == 3) qv_n[t] = lq[row * 256 + hh * 64 + lane]; kv_n[t] = lk[row * 256 + hh * 64 + lane]; vv0_n[t] = lv[row * 512 + hh * 128 + lane]; vv1_n[t] = lv[row * 512 + hh * 128 + 64 + lane]; } } while (0)
    GLA_LOAD(0);
    if (PASS == 3) {
        for (int g2 = 0; g2 < grp; ++g2) { const float* sl = Sloc + ((size_t)(bh * 8 + g2) * 8 + w) * 1024 + lane; const float* dp = Dtot + (size_t)(bh * 8 + g2) * 64 + 32 * dt + 4 * hi;
#pragma unroll
            for (int g = 0; g < 4; ++g) { const f32x4 dv = *(const f32x4*)(dp + 8 * g);
#pragma unroll
                for (int e2 = 0; e2 < 4; ++e2) sacc[4 * g + e2] = sacc[4 * g + e2] * dv[e2] + sl[(4 * g + e2) * 64]; } }
#pragma unroll
        for (int g = 0; g < 4; ++g) { const int d0 = 32 * dt + 8 * g + 4 * hi;
            *(LAS v2u*)(ST + (32 * vt + l31) * 72 + d0) = (v2u){pk2(sacc[4 * g], sacc[4 * g + 1]), pk2(sacc[4 * g + 2], sacc[4 * g + 3])}; }
    }
    float gsum = 0.f;
#pragma unroll 1
    for (int c = 0; c < 4; ++c) {
        float gl[8]; unsigned short qv[8], kv[8], vv0[8], vv1[8];
#pragma unroll
        for (int t = 0; t < 8; ++t) { gl[t] = gl_n[t]; qv[t] = qv_n[t]; kv[t] = kv_n[t]; vv0[t] = vv0_n[t]; vv1[t] = vv1_n[t]; }
        v4u ra, rb; bf16* rp = lr + (rowbase + (size_t)c * 64 + (tid >> 3)) * 512 + hh * 128 + (tid & 7) * 16;
        if (PASS == 3) { ra = *(const v4u*)rp; rb = *(const v4u*)(rp + 8); }
#pragma unroll
        for (int t = 1; t < 8; ++t) gl[t] += gl[t - 1];
        tot[w * 64 + lane] = gl[7];
        __syncthreads();
        if (c < 3) GLA_LOAD(c + 1);
        float off = 0.f, glast = 0.f;
#pragma unroll
        for (int j = 0; j < 8; ++j) { const float tj = tot[j * 64 + lane]; glast += tj; if (j < w) off += tj; }
        gsum += glast;
        unsigned kt[4];
#pragma unroll
        for (int t = 0; t < 8; t += 2) {
            const float G0 = off + gl[t], G1 = off + gl[t + 1];
            const float k0 = bf1(kv[t]) * __expf(-G0), k1 = bf1(kv[t + 1]) * __expf(-G1);
            const unsigned kp = pk2(k0, k1);
            if (PASS == 3) { const float q0 = bf1(qv[t]) * __expf(G0), q1 = bf1(qv[t + 1]) * __expf(G1); const unsigned qp = pk2(q0, q1);
                Qs[(8 * w + t) * 72 + lane] = (bf16)(qp & 0xffffu); Qs[(8 * w + t + 1) * 72 + lane] = (bf16)(qp >> 16);
                Ks[(8 * w + t) * 72 + lane] = (bf16)(kp & 0xffffu); Ks[(8 * w + t + 1) * 72 + lane] = (bf16)(kp >> 16); }
            kt[t >> 1] = kp; }
        *(LAS v4u*)(KT + lane * 72 + 8 * w) = (v4u){kt[0], kt[1], kt[2], kt[3]};
        *(LAS v4u*)(VT + lane * 72 + 8 * w) = (v4u){(unsigned)vv0[0] | ((unsigned)vv0[1] << 16), (unsigned)vv0[2] | ((unsigned)vv0[3] << 16), (unsigned)vv0[4] | ((unsigned)vv0[5] << 16), (unsigned)vv0[6] | ((unsigned)vv0[7] << 16)};
        *(LAS v4u*)(VT + (64 + lane) * 72 + 8 * w) = (v4u){(unsigned)vv1[0] | ((unsigned)vv1[1] << 16), (unsigned)vv1[2] | ((unsigned)vv1[3] << 16), (unsigned)vv1[4] | ((unsigned)vv1[5] << 16), (unsigned)vv1[6] | ((unsigned)vv1[7] << 16)};
        if (w == 0) dec[lane] = __expf(glast);
        __syncthreads();
        {
#pragma unroll
            for (int kk = 0; kk < 4; ++kk) { const bf16x8 a = *(const LAS bf16x8*)(KT + (32 * dt + l31) * 72 + kk * 16 + hi * 8), bb = *(const LAS bf16x8*)(VT + (32 * vt + l31) * 72 + kk * 16 + hi * 8);
                sacc = __builtin_amdgcn_mfma_f32_32x32x16_bf16(a, bb, sacc, 0, 0, 0); }
            LAS bf16* Sn = ST + ((c + 1) & 1) * (128 * 72);
#pragma unroll
            for (int g = 0; g < 4; ++g) { const int d0 = 32 * dt + 8 * g + 4 * hi; const f32x4 dv = *(const LAS f32x4*)(dec + d0);
                sacc[4 * g] *= dv[0]; sacc[4 * g + 1] *= dv[1]; sacc[4 * g + 2] *= dv[2]; sacc[4 * g + 3] *= dv[3];
                if (PASS == 3) *(LAS v2u*)(Sn + (32 * vt + l31) * 72 + d0) = (v2u){pk2(sacc[4 * g], sacc[4 * g + 1]), pk2(sacc[4 * g + 2], sacc[4 * g + 3])}; }
        }
        if (PASS == 3) {
        if (w < 3) {
            const int it = (w == 0) ? 0 : 1, jt = (w == 2) ? 1 : 0;
            f32x16 a16;
#pragma unroll
            for (int r = 0; r < 16; ++r) a16[r] = 0.f;
#pragma unroll
            for (int kk = 0; kk < 4; ++kk) { const bf16x8 a = *(const LAS bf16x8*)(Ks + (32 * jt + l31) * 72 + kk * 16 + hi * 8), bb = *(const LAS bf16x8*)(Qs + (32 * it + l31) * 72 + kk * 16 + hi * 8);
                a16 = __builtin_amdgcn_mfma_f32_32x32x16_bf16(a, bb, a16, 0, 0, 0); }
            const int i = 32 * it + l31;
#pragma unroll
            for (int g = 0; g < 4; ++g) { const int j0 = 32 * jt + 8 * g + 4 * hi;
                const float x0 = (j0 <= i) ? a16[4 * g] : 0.f, x1 = (j0 + 1 <= i) ? a16[4 * g + 1] : 0.f, x2 = (j0 + 2 <= i) ? a16[4 * g + 2] : 0.f, x3 = (j0 + 3 <= i) ? a16[4 * g + 3] : 0.f;
                *(LAS v2u*)(As + i * 72 + j0) = (v2u){pk2(x0, x1), pk2(x2, x3)}; }
        }
        __syncthreads();
        {
            f32x16 o16;
#pragma unroll
            for (int r = 0; r < 16; ++r) o16[r] = 0.f;
            const LAS bf16* Sc = ST + (c & 1) * (128 * 72);
#pragma unroll
            for (int kk = 0; kk < 4; ++kk) { const bf16x8 a = *(const LAS bf16x8*)(Qs + (32 * dt + l31) * 72 + kk * 16 + hi * 8), bb = *(const LAS bf16x8*)(Sc + (32 * vt + l31) * 72 + kk * 16 + hi * 8);
                o16 = __builtin_amdgcn_mfma_f32_32x32x16_bf16(a, bb, o16, 0, 0, 0); }
#pragma unroll
            for (int kk = 0; kk < 4; ++kk) if (kk < 2 || dt == 1) { const bf16x8 a = *(const LAS bf16x8*)(As + (32 * dt + l31) * 72 + kk * 16 + hi * 8), bb = *(const LAS bf16x8*)(VT + (32 * vt + l31) * 72 + kk * 16 + hi * 8);
                o16 = __builtin_amdgcn_mfma_f32_32x32x16_bf16(a, bb, o16, 0, 0, 0); }
#pragma unroll
            for (int r = 0; r < 16; ++r) Os[(32 * dt + crow16(r, hi)) * 132 + 32 * vt + l31] = o16[r];
        }
        __syncthreads();
        {
            const int i = tid >> 3, v0 = (tid & 7) * 16;
            f32x4 o[4]; float ss = 0.f;
#pragma unroll
            for (int j = 0; j < 4; ++j) { o[j] = *(const LAS f32x4*)(Os + i * 132 + v0 + 4 * j); ss += (o[j].x * o[j].x + o[j].y * o[j].y) + (o[j].z * o[j].z + o[j].w * o[j].w); }
            ss += __shfl_xor(ss, 1); ss += __shfl_xor(ss, 2); ss += __shfl_xor(ss, 4);
            const float rstd = rsqrtf(ss * (1.f / 128.f) + EPS);
            const float rr[16] = {bflo(ra.x), bfhi(ra.x), bflo(ra.y), bfhi(ra.y), bflo(ra.z), bfhi(ra.z), bflo(ra.w), bfhi(ra.w), bflo(rb.x), bfhi(rb.x), bflo(rb.y), bfhi(rb.y), bflo(rb.z), bfhi(rb.z), bflo(rb.w), bfhi(rb.w)};
            float out[16];
#pragma unroll
            for (int j = 0; j < 4; ++j) { const f32x4 gn = *(const f32x4*)(gnorm + v0 + 4 * j);
#pragma unroll
                for (int e2 = 0; e2 < 4; ++e2) { const float r = rr[4 * j + e2]; out[4 * j + e2] = o[j][e2] * rstd * gn[e2] * (r * sigmf(r)); } }
            *(v4u*)rp = (v4u){pk2(out[0], out[1]), pk2(out[2], out[3]), pk2(out[4], out[5]), pk2(out[6], out[7])};
            *(v4u*)(rp + 8) = (v4u){pk2(out[8], out[9]), pk2(out[10], out[11]), pk2(out[12], out[13]), pk2(out[14], out[15])};
        }
        }
    }
#undef GLA_LOAD
    if (PASS == 1) {
        float* sl = Sloc + ((size_t)(bh * 8 + grp) * 8 + w) * 1024 + lane;
#pragma unroll
        for (int r = 0; r < 16; ++r) sl[r * 64] = sacc[r];
        if (w == 0) Dtot[(size_t)(bh * 8 + grp) * 64 + lane] = __expf(gsum);
    }
    __syncthreads();
}
__device__ __forceinline__ void conv_unit(int cu, const bf16* ca, const bf16* cg, bf16* outp, const float* wdw, const float* bdw, const float* gln, const float* bln, LAS unsigned char* lds) {
    int tid_l = threadIdx.x; asm volatile("" : "+v"(tid_l));
    const int tid = tid_l, lane = tid & 63; const int w = __builtin_amdgcn_readfirstlane(tid >> 6);
    const size_t row0 = (size_t)cu * 32; const int s0 = (int)(row0 % SEQ);
    LAS unsigned* us = (LAS unsigned*)lds;
    LAS float* ys = (LAS float*)(lds + 62 * 1024);
    for (int idx = tid; idx < 62 * 64; idx += 512) { const int r = idx >> 6, ch = idx & 63; const int s = s0 - 30 + r;
        v4u o = (v4u){0u, 0u, 0u, 0u};
        if (s >= 0) { const size_t off = (row0 + r - 30) * 512 + ch * 8; const v4u a = *(const v4u*)(ca + off), g = *(const v4u*)(cg + off);
            o.x = pk2(bflo(a.x) * sigmf(bflo(g.x)), bfhi(a.x) * sigmf(bfhi(g.x))); o.y = pk2(bflo(a.y) * sigmf(bflo(g.y)), bfhi(a.y) * sigmf(bfhi(g.y)));
            o.z = pk2(bflo(a.z) * sigmf(bflo(g.z)), bfhi(a.z) * sigmf(bfhi(g.z))); o.w = pk2(bflo(a.w) * sigmf(bflo(g.w)), bfhi(a.w) * sigmf(bfhi(g.w))); }
        *(LAS v4u*)(us + r * 256 + ch * 4) = o; }
    const int cp = tid & 255, th = tid >> 8;
    float w0[31], w1[31];
#pragma unroll
    for (int k = 0; k < 31; ++k) { const f32x2 ww = *(const f32x2*)(wdw + k * 512 + 2 * cp); w0[k] = ww.x; w1[k] = ww.y; }
    const f32x2 bb = *(const f32x2*)(bdw + 2 * cp);
    __syncthreads();
#pragma unroll 1
    for (int tq = 0; tq < 4; ++tq) {
        const int t0 = th * 16 + tq * 4;
        unsigned uw[34];
#pragma unroll
        for (int r = 0; r < 34; ++r) uw[r] = us[(t0 + r) * 256 + cp];
#pragma unroll
        for (int tt = 0; tt < 4; ++tt) { float y0 = bb.x, y1 = bb.y;
#pragma unroll
            for (int k = 0; k < 31; ++k) { y0 += w0[k] * bflo(uw[tt + k]); y1 += w1[k] * bfhi(uw[tt + k]); }
            *(LAS f32x2*)(ys + (t0 + tt) * 512 + 2 * cp) = (f32x2){y0, y1}; }
    }
    __syncthreads();
#pragma unroll 1
    for (int tt = 0; tt < 4; ++tt) { const int t = 4 * w + tt;
        const f32x4 a = *(const LAS f32x4*)(ys + t * 512 + lane * 8), b = *(const LAS f32x4*)(ys + t * 512 + lane * 8 + 4);
        const float mean = wave_sum((a.x + a.y) + (a.z + a.w) + (b.x + b.y) + (b.z + b.w)) * (1.f / 512.f);
        const f32x4 da = a - mean, db = b - mean;
        const float var = wave_sum((da.x * da.x + da.y * da.y) + (da.z * da.z + da.w * da.w) + (db.x * db.x + db.y * db.y) + (db.z * db.z + db.w * db.w)) * (1.f / 512.f);
        const float rstd = rsqrtf(var + EPS);
        const f32x4 g0 = *(const f32x4*)(gln + lane * 8), g1 = *(const f32x4*)(gln + lane * 8 + 4), b0 = *(const f32x4*)(bln + lane * 8), b1 = *(const f32x4*)(bln + lane * 8 + 4);
        f32x4 y0 = da * rstd * g0 + b0, y1 = db * rstd * g1 + b1;
#pragma unroll
        for (int e = 0; e < 4; ++e) { y0[e] = y0[e] * sigmf(y0[e]); y1[e] = y1[e] * sigmf(y1[e]); }
        *(v4u*)(outp + (row0 + t) * 512 + lane * 8) = (v4u){pk2(y0.x, y0.y), pk2(y0.z, y0.w), pk2(y1.x, y1.y), pk2(y1.z, y1.w)}; }
    __syncthreads();
}

struct Params { const float* in[21]; float* out; unsigned char* ws; };
template <int l> __device__ __forceinline__ void layer_body(const Params& p, LAS unsigned char* lds, unsigned char* lds_raw, const XcdBarrier& xbar) {
    int tid_l = threadIdx.x; asm volatile("" : "+v"(tid_l));
    const int tid = tid_l, lane = tid & 63, wave = __builtin_amdgcn_readfirstlane(tid >> 6);
    const int G = gridDim.x, bx = blockIdx.x;
    const int vcu = (G % 8 == 0) ? (bx % 8) * (G / 8) + bx / 8 : bx;
    const int gw = vcu * 8 + wave, NGW = G * 8;
    unsigned char* ws = p.ws;
    unsigned* ctl = (unsigned*)(ws + WS_CTL);
    float* ropec = (float*)(ws + WS_ROPEC); float* ropes = (float*)(ws + WS_ROPES); float* kmean = (float*)(ws + WS_KMEAN);
    bf16* XN = (bf16*)(ws + WS_XN);
    const float* x = p.in[0];
    float* hbuf = p.out;
    {
        const float* hin = (l == 0) ? x : hbuf;
        {
            pg8::Gemm g{(const pg8::bf16_t*)XN, (const pg8::bf16_t*)(ws + WS_WIN), M, NMIX, DM}; pg8::StaticOrder S; S.init(M, NMIX + 0, G, bx);
            pg8::EpiInproj E{(bf16*)(ws + WS_Q), (bf16*)(ws + WS_K), (bf16*)(ws + WS_V), (bf16*)(ws + WS_LQ), (bf16*)(ws + WS_LK), (bf16*)(ws + WS_LV), (bf16*)(ws + WS_LR), (bf16*)(ws + WS_CA), (bf16*)(ws + WS_CG),
                             (float*)(ws + WS_G), kmean, ropec, ropes, p.in[6] + l * 256, 0.125f * 1.4426950408889634f};
#ifndef NO_G1
            pg8::gemm_phase<pg8::EpiInproj, pg8::StaticOrder, true, true>(lds, g, S, E);
#endif
        }
        xcd_barrier(xbar);
        {
            LAS unsigned* slot = (LAS unsigned*)(lds + LDS_RING);
            for (;;) {
                __syncthreads();
                if (tid == 0) *slot = atomicAdd(ctl + 64 * l, 1u);
                __syncthreads();
                const int u = (int)*slot;
                if (u >= 512 + 224 + 512) break;
#ifndef NO_GLA
                if (u >= 512 && u < 736) { const int a = u - 512; gla_unit<1>(a / 7, a % 7, (const bf16*)(ws + WS_LQ), (const bf16*)(ws + WS_LK), (const bf16*)(ws + WS_LV), (const float*)(ws + WS_G), (bf16*)(ws + WS_LR), p.in[7] + l * 128, (float*)(ws + WS_SLOC), (float*)(ws + WS_DTOT), lds); }
#endif
#ifndef NO_ATTN
                if (u < 512) { const int a = u, qb = 7 - (a >> 6), bh = a & 63;
                    attn_body::attn_unit<8>(bh >> 3, bh & 7, qb, (const attn_body::bf16*)(ws + WS_Q), (const attn_body::bf16*)(ws + WS_K), (const attn_body::bf16*)(ws + WS_V), (attn_body::bf16*)(ws + WS_Q), kmean, (char*)lds_raw); }
#endif
#ifndef NO_CONV
                if (u >= 736) conv_unit(u - 736, (const bf16*)(ws + WS_CA), (const bf16*)(ws + WS_CG), (bf16*)(ws + WS_CONV), p.in[8] + l * 31 * 512, p.in[9] + l * 512, p.in[10] + l * 512, p.in[11] + l * 512, lds);
#endif
            }
        }
        xcd_barrier(xbar);
#ifndef NO_GLA
        for (int u = bx; u < 256; u += G) gla_unit<3>(u >> 3, u & 7, (const bf16*)(ws + WS_LQ), (const bf16*)(ws + WS_LK), (const bf16*)(ws + WS_LV), (const float*)(ws + WS_G), (bf16*)(ws + WS_LR), p.in[7] + l * 128, (float*)(ws + WS_SLOC), (float*)(ws + WS_DTOT), lds);
#endif
        xcd_barrier(xbar);
        {
            pg8::Gemm g{(const pg8::bf16_t*)(ws + WS_Q), (const pg8::bf16_t*)(ws + WS_WBO), 3 * M, 3 * DM, 512}; pg8::SchedBranch S{G, bx};
            pg8::EpiStore<0> E{(bf16*)(ws + WS_YB), DM, 4, (size_t)M * DM};
#ifndef NO_G2
            pg8::gemm_phase<pg8::EpiStore<0>, pg8::SchedBranch, true, true>(lds, g, S, E);
#endif
        }
        xcd_barrier(xbar);
        {
            pg8::Gemm g{(const pg8::bf16_t*)XN, (const pg8::bf16_t*)(ws + WS_WIN) + (size_t)NMIX * DM, M, 3 * DM, DM}; pg8::SchedGates S{G, bx};
            pg8::EpiGate E{(const bf16*)(ws + WS_YB), (size_t)M * DM, (bf16*)(ws + WS_MB), p.in[4] + l * 3072};
#ifndef NO_G3
            pg8::gemm_phase<pg8::EpiGate, pg8::SchedGates, true, true>(lds, g, S, E);
#endif
        }
        xcd_barrier(xbar);
        {
            pg8::Gemm g{(const pg8::bf16_t*)(ws + WS_MB), (const pg8::bf16_t*)(ws + WS_WMIX), M, DM, DM}; pg8::StaticOrder S; S.init(M, DM, G, bx);
            pg8::EpiStore<0> E{(bf16*)(ws + WS_Y), DM, 1 << 20, 0};
#ifndef NO_G4
            pg8::gemm_phase<pg8::EpiStore<0>, pg8::StaticOrder, true, true>(lds, g, S, E);
#endif
        }
        xcd_barrier(xbar);
        row_phase(hin, (const bf16*)(ws + WS_Y), p.in[16] + l * DM, hbuf, p.in[17] + l * DM, XN, gw, NGW, lane);
        xcd_barrier(xbar);
        {
            pg8::Gemm g{(const pg8::bf16_t*)XN, (const pg8::bf16_t*)(ws + WS_WUP), M, DFF, DM}; pg8::StaticOrder S; S.init(M, DFF, G, bx);
            pg8::EpiStore<1> E{(bf16*)(ws + WS_H), DFF, 1 << 20, 0};
#ifndef NO_G5
            pg8::gemm_phase<pg8::EpiStore<1>, pg8::StaticOrder, true, true>(lds, g, S, E);
#endif
        }
        xcd_barrier(xbar);
        {
            pg8::Gemm g{(const pg8::bf16_t*)(ws + WS_H), (const pg8::bf16_t*)(ws + WS_WDN), M, DM, DFF}; pg8::StaticOrder S; S.init(M, DM, G, bx);
            pg8::EpiStore<0> E{(bf16*)(ws + WS_Y2), DM, 1 << 20, 0};
#ifndef NO_G6
            pg8::gemm_phase<pg8::EpiStore<0>, pg8::StaticOrder, true, true>(lds, g, S, E);
#endif
        }
        xcd_barrier(xbar);
        if (l == 0) {
            LayerW L{p.in[3] + (size_t)DM * 7184, p.in[5] + 16 * 256, p.in[12] + 512 * DM, p.in[13] + 512 * DM, p.in[14] + 512 * DM, p.in[15] + DM * DM, p.in[18] + (size_t)DM * DFF, p.in[19] + (size_t)DFF * DM};
    #ifndef NO_CVT
        convert_weights(L, ws, lds, gw, NGW, wave, lane);
#endif
            for (int i = bx * 512 + tid; i < 64 * 512; i += G * 512) kmean[i] = 0.f;
            row_phase(hbuf, (const bf16*)(ws + WS_Y2), p.in[20], hbuf, p.in[2] + DM, XN, gw, NGW, lane);
            xcd_barrier(xbar);
        } else {
            row_phase(hbuf, (const bf16*)(ws + WS_Y2), p.in[20] + DM, hbuf, nullptr, nullptr, gw, NGW, lane);
        }
        }
}
__global__ void __launch_bounds__(512, 2) mk_fwd(Params p) {
    extern __shared__ __attribute__((aligned(16))) unsigned char lds_raw[];
    cg::grid_group grid = cg::this_grid();
    LAS unsigned char* lds = (LAS unsigned char*)lds_raw;
    if (threadIdx.x < 64) ((LAS unsigned*)(lds + LDS_RING + 256))[threadIdx.x] = 0u;
    __syncthreads();
    const XcdBarrier xbar = xcd_barrier_post((unsigned*)(p.ws + WS_CTL) + 4096, (volatile LAS unsigned*)(lds + LDS_RING + 256));
    const int tid = threadIdx.x, lane = tid & 63, wave = __builtin_amdgcn_readfirstlane(tid >> 6);
    const int G = gridDim.x, bx = blockIdx.x;
    const int vcu = (G % 8 == 0) ? (bx % 8) * (G / 8) + bx / 8 : bx;
    const int gw = vcu * 8 + wave, NGW = G * 8;
    unsigned char* ws = p.ws;
    unsigned* ctl = (unsigned*)(ws + WS_CTL);
    float* ropec = (float*)(ws + WS_ROPEC); float* ropes = (float*)(ws + WS_ROPES); float* kmean = (float*)(ws + WS_KMEAN);
    bf16* XN = (bf16*)(ws + WS_XN);
    const float* x = p.in[0]; const int* positions = (const int*)p.in[1];
    float* hbuf = p.out;

    {
        LayerW L{p.in[3], p.in[5], p.in[12], p.in[13], p.in[14], p.in[15], p.in[18], p.in[19]};
#ifndef NO_CVT
        convert_weights(L, ws, lds, gw, NGW, wave, lane);
#endif
        for (int i = bx * 512 + tid; i < M * 32; i += G * 512) { const int m = i >> 5, f = i & 31; const float ang = (float)positions[m] * c_inv_freq[f];
            const double rev = (double)ang * 0.15915494309189535; const float fr = (float)(rev - __builtin_rint(rev));
            ropec[i] = __builtin_amdgcn_cosf(fr); ropes[i] = __builtin_amdgcn_sinf(fr); }
        for (int i = bx * 512 + tid; i < 64 * 512; i += G * 512) kmean[i] = 0.f;
        row_phase(x, nullptr, nullptr, nullptr, p.in[2], XN, gw, NGW, lane);
    }
    grid.sync();
    layer_body<0>(p, lds, lds_raw, xbar);
    layer_body<1>(p, lds, lds_raw, xbar);
}

extern "C" void kernel_launch(void* const* d_in, const int* in_sizes, int n_in, void* d_out, int out_size, void* d_ws, size_t ws_size, hipStream_t stream) {
    static int grid = 0;
    if (grid == 0) {
        if (n_in != 21 || out_size != M * DM || ws_size < WS_END) { fprintf(stderr, "kernel_launch: unexpected shapes (n_in %d out %d ws %zu)\n", n_in, out_size, ws_size); grid = -1; return; }
        int dev = 0, cus = 0, per_cu = 0;
        hipGetDevice(&dev);
        hipDeviceGetAttribute(&cus, hipDeviceAttributeMultiprocessorCount, dev);
        hipFuncSetAttribute((const void*)mk_fwd, hipFuncAttributeMaxDynamicSharedMemorySize, LDS_BYTES);
        hipOccupancyMaxActiveBlocksPerMultiprocessor(&per_cu, (const void*)mk_fwd, 512, LDS_BYTES);
        if (per_cu < 1) { fprintf(stderr, "kernel_launch: occupancy query says %d blocks per CU\n", per_cu); per_cu = 1; }
        if (per_cu > 1) per_cu = 1;
        grid = cus * per_cu;
        (void)hipGetLastError();
    }
    if (grid < 0) return;
    hipMemsetAsync((char*)d_ws + WS_CTL, 0, 65536, stream);
    Params p{};
    for (int i = 0; i < 21; ++i) p.in[i] = (const float*)d_in[i];
    p.out = (float*)d_out; p.ws = (unsigned char*)d_ws;
    void* args[] = {&p};
    hipError_t e = hipLaunchCooperativeKernel((const void*)mk_fwd, dim3(grid), dim3(512), args, LDS_BYTES, stream);
    if (e != hipSuccess) fprintf(stderr, "cooperative launch failed: %s (grid %d)\n", hipGetErrorString(e), grid);
}
```

```cpp
#include <hip/hip_runtime.h>
#include <hip/hip_cooperative_groups.h>
#include <cstdio>
#include <cstdint>
namespace cg = cooperative_groups;
namespace pg8 {
#define PG8_LAS __attribute__((address_space(3)))
typedef unsigned short bf16_t;
typedef short bf16x8 __attribute__((ext_vector_type(8)));
typedef float f32x4 __attribute__((ext_vector_type(4)));
typedef unsigned u32x4 __attribute__((ext_vector_type(4)));
constexpr int BM = 256, BK = 64, HALF = 128, HTB = HALF * BK * 2  , STAGE_BYTES = 8 * HTB, NXCD = 8, WGM = 8;

__host__ __device__ __forceinline__ int lds_byte(int r, int c) { const int st = (r >> 4) * 2 + (c >> 5), rr = r & 15, cc = c & 31, ob = rr * 64 + cc * 2; return st * 1024 + (ob ^ (((ob >> 9) & 1) << 5)); }
__host__ __device__ __forceinline__ void stage_rc(int b, int& R, int& C) { const int st = b / 1024, sb = b % 1024, swz = sb ^ (((sb >> 9) & 1) << 5); R = (st >> 1) * 16 + swz / 64; C = (st & 1) * 32 + (swz % 64) / 2; }
__host__ __device__ __forceinline__ int perm32(int rho) { const int n = rho >> 4, i = rho & 15; return 8 * (i >> 2) + 4 * n + (i & 3); }

struct Unit { int pm, pn; };
struct Gemm { const bf16_t* A; const bf16_t* Bt; int M, N, K; };

struct StaticOrder {
    int nM, nN, nwg, G, c;
    __host__ __device__ void init(int M, int N, int G_, int c_) { nM = M / BM; nN = N / BM; nwg = nM * nN; G = G_; c = c_; }
    __host__ __device__ bool next(int i, Unit& u) const {
        const long L = (long)i * G + c; if (L >= nwg) return false;
        int wgid = (int)L; { const int q = nwg / NXCD, r = nwg % NXCD, xcd = wgid % NXCD, off = wgid / NXCD; wgid = (xcd < r ? xcd * (q + 1) : r * (q + 1) + (xcd - r) * q) + off; }
        const int nig = WGM * nN, gid = wgid / nig, fm = gid * WGM, gsz = (nM - fm) < WGM ? (nM - fm) : WGM;
        u.pm = fm + ((wgid % nig) % gsz); u.pn = (wgid % nig) / gsz; return true;
    }
    __device__ __forceinline__ void a_ready(const Unit&) const {}
    __device__ __forceinline__ void done(const Unit&) const {}
};

__device__ __forceinline__ unsigned cvt_pk_bf16(float lo, float hi) { unsigned r; asm volatile("v_cvt_pk_bf16_f32 %0, %1, %2" : "=v"(r) : "v"(lo), "v"(hi)); return r; }
typedef float f32x2 __attribute__((ext_vector_type(2)));
typedef unsigned u32x2 __attribute__((ext_vector_type(2)));
__device__ __forceinline__ float bf_lo(unsigned w) { return __uint_as_float(w << 16); }
__device__ __forceinline__ float bf_hi(unsigned w) { return __uint_as_float(w & 0xffff0000u); }
__device__ __forceinline__ float sigm(float x) { return 1.0f / (1.0f + __expf(-x)); }
__device__ __forceinline__ u32x4 pack8(const f32x4 a, const f32x4 b) { u32x4 w; w.x = cvt_pk_bf16(a[0], a[1]); w.y = cvt_pk_bf16(a[2], a[3]); w.z = cvt_pk_bf16(b[0], b[1]); w.w = cvt_pk_bf16(b[2], b[3]); return w; }

__host__ __device__ __forceinline__ void tile_of(int wgid, int nM, int nN, int& pm, int& pn) {
    const int nwg = nM * nN;
    { const int q = nwg / NXCD, r = nwg % NXCD, xcd = wgid % NXCD, off = wgid / NXCD; wgid = (xcd < r ? xcd * (q + 1) : r * (q + 1) + (xcd - r) * q) + off; }
    const int nig = WGM * nN, gid = wgid / nig, fm = gid * WGM, gsz = (nM - fm) < WGM ? (nM - fm) : WGM;
    pm = fm + ((wgid % nig) % gsz); pn = (wgid % nig) / gsz;
}
struct SchedBranch {
    int G, c;
    __device__ bool next(int i, Unit& u) const { const long L = (long)i * G + c; if (L >= 768) return false; const int j = (int)(L / 256); int pm, pn; tile_of((int)(L % 256), 64, 4, pm, pn); u.pm = 64 * j + pm; u.pn = 4 * j + pn; return true; }
    __device__ __forceinline__ void a_ready(const Unit&) const {}
    __device__ __forceinline__ void done(const Unit&) const {}
};
struct SchedGates {
    int G, c;
    __device__ bool next(int i, Unit& u) const { const int j = i % 3, rnd = i / 3; const long L = (long)rnd * G + c; if (L >= 256) return false; int pm, pn; tile_of((int)L, 64, 4, pm, pn); u.pm = pm; u.pn = 4 * j + pn; return true; }
    __device__ __forceinline__ void a_ready(const Unit&) const {}
    __device__ __forceinline__ void done(const Unit&) const {}
};

struct SchedSkip12 {
    int G, c;
    __device__ bool next(int i, Unit& u) const { const long L = (long)i * G + c; if (L >= 1024) return false; int pm, pn; tile_of((int)L, 64, 16, pm, pn); u.pm = pm; u.pn = pn + (pn >= 12 ? 1 : 0); return true; }
    __device__ __forceinline__ void a_ready(const Unit&) const {}
    __device__ __forceinline__ void done(const Unit&) const {}
};
struct SchedOne {
    int pm, pn;
    __device__ bool next(int i, Unit& u) const { if (i > 0) return false; u.pm = pm; u.pn = pn; return true; }
    __device__ __forceinline__ void a_ready(const Unit&) const {}
    __device__ __forceinline__ void done(const Unit&) const {}
};
template <int ACT  > struct EpiStore {
    static constexpr bool PERM = true, AFTER_DRAIN = false;
    bf16_t* O; int ldc; int jdiv; size_t jstride;
    __device__ __forceinline__ void operator()(const f32x4 (&acc)[2][2][4][2], const Unit& u, int wr, int wc, int fr, int fq) const {
        const int j = u.pn / jdiv; const int pm = u.pm - 64 * j, pn = u.pn - jdiv * j;
        bf16_t* base = O + (size_t)j * jstride;
        const int row0 = pm * BM + wr * 64 + fr, col0 = pn * BM + wc * 32 + 8 * fq;
#pragma unroll
        for (int ai = 0; ai < 2; ++ai)
#pragma unroll
            for (int m = 0; m < 4; ++m) { bf16_t* rowp = base + (size_t)(row0 + ai * HALF + m * 16) * ldc + col0;
#pragma unroll
                for (int bj = 0; bj < 2; ++bj) { f32x4 v0 = acc[ai][bj][m][0], v1 = acc[ai][bj][m][1];
                    if (ACT == 1) {
#pragma unroll
                        for (int e = 0; e < 4; ++e) { const float a = fmaxf(v0[e], 0.f), b = fmaxf(v1[e], 0.f); v0[e] = a * a; v1[e] = b * b; } }
                    *(u32x4*)(rowp + bj * HALF) = pack8(v0, v1); } }
    }
};
struct EpiGate {
    static constexpr bool PERM = true, AFTER_DRAIN = false;
    const bf16_t* Y; size_t ystride; bf16_t* Mb; const float* bgate;
    __device__ __forceinline__ void operator()(const f32x4 (&acc)[2][2][4][2], const Unit& u, int wr, int wc, int fr, int fq) const {
        const int j = u.pn >> 2, pn = u.pn & 3;
        const bf16_t* Yj = Y + (size_t)j * ystride;
        const int row0 = u.pm * BM + wr * 64 + fr, col0 = pn * BM + wc * 32 + 8 * fq;
        f32x4 bv[2][2];
#pragma unroll
        for (int bj = 0; bj < 2; ++bj)
#pragma unroll
            for (int n = 0; n < 2; ++n) bv[bj][n] = *(const f32x4*)(bgate + j * 1024 + col0 + bj * HALF + 4 * n);
#pragma unroll
        for (int ai = 0; ai < 2; ++ai)
#pragma unroll
            for (int m = 0; m < 4; ++m) { const size_t off = (size_t)(row0 + ai * HALF + m * 16) * 1024 + col0;
#pragma unroll
                for (int bj = 0; bj < 2; ++bj) { const size_t o2 = off + bj * HALF;
                    const u32x4 yw = *(const u32x4*)(Yj + o2); u32x4 mw = (u32x4){0u, 0u, 0u, 0u}; if (j > 0) mw = *(const u32x4*)(Mb + o2);
                    const f32x4 x0 = acc[ai][bj][m][0] + bv[bj][0], x1 = acc[ai][bj][m][1] + bv[bj][1];
                    f32x4 r0, r1;
                    r0[0] = sigm(x0[0]) * bf_lo(yw.x) + bf_lo(mw.x); r0[1] = sigm(x0[1]) * bf_hi(yw.x) + bf_hi(mw.x);
                    r0[2] = sigm(x0[2]) * bf_lo(yw.y) + bf_lo(mw.y); r0[3] = sigm(x0[3]) * bf_hi(yw.y) + bf_hi(mw.y);
                    r1[0] = sigm(x1[0]) * bf_lo(yw.z) + bf_lo(mw.z); r1[1] = sigm(x1[1]) * bf_hi(yw.z) + bf_hi(mw.z);
                    r1[2] = sigm(x1[2]) * bf_lo(yw.w) + bf_lo(mw.w); r1[3] = sigm(x1[3]) * bf_hi(yw.w) + bf_hi(mw.w);
                    *(u32x4*)(Mb + o2) = pack8(r0, r1); } }
    }
};
struct EpiInproj {
    static constexpr bool PERM = true, AFTER_DRAIN = false;
    bf16_t *Q, *Kb, *V, *lq, *lk, *lv, *lr, *ca, *cg; float* gdec; float* kmean; const float* ropec; const float* ropes; const float* bgla; float qscale;
    __device__ __forceinline__ void operator()(const f32x4 (&acc)[2][2][4][2], const Unit& u, int wr, int wc, int fr, int fq) const {
        const int pn = u.pn;
        const int row0 = u.pm * BM + wr * 64 + fr, cl = wc * 32 + 8 * fq;
        if (pn < 4) {
            const bool isk = pn >= 2; bf16_t* dst = isk ? Kb : Q; const int ct = (pn & 1) * 256; const float sc = isk ? 1.0f : qscale;
#pragma unroll
            for (int bj = 0; bj < 2; ++bj) { const int c = ct + bj * HALF + cl, i0 = (c & 63) >> 1;
                float cs[8];
#pragma unroll
                for (int e = 0; e < 8; ++e) cs[e] = 0.f;
#pragma unroll
                for (int ai = 0; ai < 2; ++ai)
#pragma unroll
                    for (int m = 0; m < 4; ++m) { const int row = row0 + ai * HALF + m * 16;
                        const f32x4 co = *(const f32x4*)(ropec + (size_t)row * 32 + i0), si = *(const f32x4*)(ropes + (size_t)row * 32 + i0);
                        const f32x4 v0 = acc[ai][bj][m][0], v1 = acc[ai][bj][m][1]; f32x4 o0, o1;
                        o0[0] = (v0[0] * co[0] - v0[1] * si[0]) * sc; o0[1] = (v0[1] * co[0] + v0[0] * si[0]) * sc;
                        o0[2] = (v0[2] * co[1] - v0[3] * si[1]) * sc; o0[3] = (v0[3] * co[1] + v0[2] * si[1]) * sc;
                        o1[0] = (v1[0] * co[2] - v1[1] * si[2]) * sc; o1[1] = (v1[1] * co[2] + v1[0] * si[2]) * sc;
                        o1[2] = (v1[2] * co[3] - v1[3] * si[3]) * sc; o1[3] = (v1[3] * co[3] + v1[2] * si[3]) * sc;
#pragma unroll
                        for (int e = 0; e < 4; ++e) { cs[e] += o0[e]; cs[4 + e] += o1[e]; }
                        *(u32x4*)(dst + (size_t)row * 512 + c) = pack8(o0, o1); }
                if (isk) {
#pragma unroll
                    for (int e = 0; e < 8; ++e) { float s = cs[e]; s += __shfl_xor(s, 1); s += __shfl_xor(s, 2); s += __shfl_xor(s, 4); s += __shfl_xor(s, 8); cs[e] = s; }
                    if (fr == 0) {
#pragma unroll
                        for (int e = 0; e < 8; ++e) atomicAdd(kmean + (size_t)u.pm * 512 + c + e, cs[e]); } } }
        } else if (pn == 10) {
#pragma unroll
            for (int bj = 0; bj < 2; ++bj) { const int c = bj * HALF + cl; const f32x4 b0 = *(const f32x4*)(bgla + c), b1 = *(const f32x4*)(bgla + c + 4);
#pragma unroll
                for (int ai = 0; ai < 2; ++ai)
#pragma unroll
                    for (int m = 0; m < 4; ++m) { const int row = row0 + ai * HALF + m * 16; const f32x4 x0 = acc[ai][bj][m][0] + b0, x1 = acc[ai][bj][m][1] + b1; f32x4 g0, g1;
#pragma unroll
                        for (int e = 0; e < 4; ++e) { g0[e] = (fminf(x0[e], 0.f) - __logf(1.0f + __expf(-fabsf(x0[e])))) * 0.0625f; g1[e] = (fminf(x1[e], 0.f) - __logf(1.0f + __expf(-fabsf(x1[e])))) * 0.0625f; }
                        *(f32x4*)(gdec + (size_t)row * 256 + c) = g0; *(f32x4*)(gdec + (size_t)row * 256 + c + 4) = g1; } }
        } else {
            bf16_t* dst; int ld = 512, ct; float sc = 1.0f;
            if (pn < 6) { dst = V; ct = (pn - 4) * 256; }
            else if (pn == 6) { dst = lq; ld = 256; ct = 0; sc = 0.125f; }
            else if (pn == 7) { dst = lk; ld = 256; ct = 0; }
            else if (pn < 10) { dst = lv; ct = (pn - 8) * 256; }
            else if (pn < 13) { dst = lr; ct = (pn - 11) * 256; }
            else if (pn < 15) { dst = ca; ct = (pn - 13) * 256; }
            else { dst = cg; ct = (pn - 15) * 256; }
#pragma unroll
            for (int ai = 0; ai < 2; ++ai)
#pragma unroll
                for (int m = 0; m < 4; ++m) { bf16_t* rowp = dst + (size_t)(row0 + ai * HALF + m * 16) * ld + ct + cl;
#pragma unroll
                    for (int bj = 0; bj < 2; ++bj) *(u32x4*)(rowp + bj * HALF) = pack8(acc[ai][bj][m][0] * sc, acc[ai][bj][m][1] * sc); }
        }
    }
};
template <class Epi, class Sched, bool ALIGN_EPI = false, bool SP2 = false>
__device__ __forceinline__ void gemm_phase(PG8_LAS unsigned char* lds, const Gemm g, const Sched& S, const Epi& E) {
    int tid_l = threadIdx.x; asm volatile("" : "+v"(tid_l));
    const int tid = tid_l, wid = __builtin_amdgcn_readfirstlane(tid >> 6), lane = tid & 63, wr = wid >> 2, wc = wid & 3, fr = lane & 15, fq = lane >> 4;
    const int K = g.K, nt = K / BK;
    unsigned voffA[2], voffB[2];
#pragma unroll
    for (int i = 0; i < 2; ++i) { int R, C; stage_rc(tid * 16 + i * 8192, R, C); const int Rb = Epi::PERM ? ((R & ~31) + perm32(R & 31)) : R;
        voffA[i] = (unsigned)(R * K + C) * 2u; voffB[i] = (unsigned)(Rb * K + C) * 2u; }
    const size_t kstep = (size_t)(BK * 2);
    const size_t hstep = (size_t)HALF * K * 2;
    const size_t tstep = 2 * hstep;
    const unsigned ldsw = (unsigned)wid * 1024u;
    const int aoff = lds_byte(wr * 64 + fr, fq * 8), boff = lds_byte(wc * 32 + fr, fq * 8);
#define PG8_SA(b, h) (((b) * 2 + (h)) * HTB)
#define PG8_SB(b, h) ((4 + (b) * 2 + (h)) * HTB)
#define PG8_STAGE(bufoff, gbase, voff) do { _Pragma("unroll") for (int _i = 0; _i < 2; ++_i) \
        __builtin_amdgcn_global_load_lds((const unsigned*)((const char*)(gbase) + (voff)[_i]), (PG8_LAS unsigned*)(lds + (bufoff) + ldsw + _i * 8192), 16, 0, 0); } while (0)
#define PG8_LDA(dst, b, h) do { _Pragma("unroll") for (int m = 0; m < 4; ++m) _Pragma("unroll") for (int k = 0; k < 2; ++k) dst[m][k] = *(const PG8_LAS bf16x8*)(lds + PG8_SA(b, h) + aoff + m * 2048 + k * 1024); } while (0)
#define PG8_LDB(dst, b, h) do { _Pragma("unroll") for (int n = 0; n < 2; ++n) _Pragma("unroll") for (int k = 0; k < 2; ++k) dst[n][k] = *(const PG8_LAS bf16x8*)(lds + PG8_SB(b, h) + boff + n * 2048 + k * 1024); } while (0)
#define PG8_MMA(ai, bj, At, Bt) do { __builtin_amdgcn_s_setprio(1); _Pragma("unroll") for (int m = 0; m < 4; ++m) _Pragma("unroll") for (int n = 0; n < 2; ++n) _Pragma("unroll") for (int k = 0; k < 2; ++k) \
        acc[ai][bj][m][n] = __builtin_amdgcn_mfma_f32_16x16x32_bf16(Bt[n][k], At[m][k], acc[ai][bj][m][n], 0, 0, 0); __builtin_amdgcn_s_setprio(0); } while (0)
#define PG8_WAIT_V(n) asm volatile("s_waitcnt vmcnt(" #n ")" ::: "memory")
#define PG8_WAIT_L(n) asm volatile("s_waitcnt lgkmcnt(" #n ")" ::: "memory")
#define PG8_BAR __builtin_amdgcn_s_barrier()
#define PG8_SCHED __builtin_amdgcn_sched_barrier(0)
    Unit cur, nxt; int ui = 0;
    if (!S.next(0, cur)) return;
    f32x4 acc[2][2][4][2];
#pragma unroll
    for (int a = 0; a < 2; ++a)
#pragma unroll
        for (int b = 0; b < 2; ++b)
#pragma unroll
            for (int m = 0; m < 4; ++m)
#pragma unroll
                for (int n = 0; n < 2; ++n) acc[a][b][m][n] = (f32x4){0.f, 0.f, 0.f, 0.f};
    bf16x8 At[4][2], B0[2][2], B1[2][2];
    const char* cA = (const char*)g.A + (size_t)cur.pm * tstep; const char* cB = (const char*)g.Bt + (size_t)cur.pn * tstep;
    S.a_ready(cur);
    if constexpr (SP2) {
        PG8_STAGE(PG8_SB(0, 0), cB, voffB); PG8_STAGE(PG8_SB(0, 1), cB + hstep, voffB); PG8_STAGE(PG8_SA(0, 0), cA, voffA); PG8_STAGE(PG8_SA(0, 1), cA + hstep, voffA);
        if (wr == 1) PG8_BAR;
        PG8_WAIT_V(2); PG8_BAR;
        PG8_STAGE(PG8_SB(1, 0), cB + kstep, voffB); PG8_STAGE(PG8_SA(1, 0), cA + kstep, voffA); PG8_STAGE(PG8_SB(1, 1), cB + hstep + kstep, voffB);
        PG8_WAIT_V(6); PG8_BAR;
    } else {
        PG8_STAGE(PG8_SB(0, 0), cB, voffB); PG8_STAGE(PG8_SA(0, 0), cA, voffA); PG8_STAGE(PG8_SB(0, 1), cB + hstep, voffB); PG8_STAGE(PG8_SA(0, 1), cA + hstep, voffA);
        if (wr == 1) PG8_BAR;
        PG8_WAIT_V(4); PG8_BAR;
        PG8_STAGE(PG8_SB(1, 0), cB + kstep, voffB); PG8_STAGE(PG8_SA(1, 0), cA + kstep, voffA); PG8_STAGE(PG8_SB(1, 1), cB + hstep + kstep, voffB);
        PG8_WAIT_V(6); PG8_BAR;
    }
    for (;;) {
        const bool has_next = S.next(ui + 1, nxt);
        const char* nA = has_next ? (const char*)g.A + (size_t)nxt.pm * tstep : cA; const char* nB = has_next ? (const char*)g.Bt + (size_t)nxt.pn * tstep : cB;
        for (int t = 0; t < nt; t += 2) {
            const bool last = (t == nt - 2);
            const char* a1 = cA + (size_t)(t + 1) * kstep;
            const char* a2 = last ? nA : cA + (size_t)(t + 2) * kstep; const char* b2 = last ? nB : cB + (size_t)(t + 2) * kstep;
            const char* a3 = a2 + kstep; const char* b3 = b2 + kstep;
            if (last && has_next) S.a_ready(nxt);
            if constexpr (SP2) {
            PG8_LDB(B0, 0, 0); PG8_LDB(B1, 0, 1); PG8_SCHED; PG8_LDA(At, 0, 0); PG8_STAGE(PG8_SA(1, 1), a1 + hstep, voffA);
            PG8_WAIT_V(8); PG8_WAIT_L(0); PG8_BAR; PG8_MMA(0, 0, At, B0); PG8_MMA(0, 1, At, B1); PG8_BAR; PG8_SCHED;
            PG8_LDA(At, 0, 1); PG8_STAGE(PG8_SB(0, 0), b2, voffB); PG8_STAGE(PG8_SB(0, 1), b2 + hstep, voffB); PG8_STAGE(PG8_SA(0, 0), a2, voffA);
            PG8_WAIT_V(8); PG8_WAIT_L(0); PG8_BAR; PG8_MMA(1, 0, At, B0); PG8_MMA(1, 1, At, B1); PG8_BAR; PG8_SCHED;
            PG8_LDB(B0, 1, 0); PG8_LDB(B1, 1, 1); PG8_SCHED; PG8_LDA(At, 1, 0); PG8_STAGE(PG8_SA(0, 1), a2 + hstep, voffA);
            PG8_WAIT_V(8); PG8_WAIT_L(0); PG8_BAR; PG8_MMA(0, 0, At, B0); PG8_MMA(0, 1, At, B1); PG8_BAR; PG8_SCHED;
            PG8_LDA(At, 1, 1); PG8_STAGE(PG8_SB(1, 0), b3, voffB); PG8_STAGE(PG8_SB(1, 1), b3 + hstep, voffB); PG8_STAGE(PG8_SA(1, 0), a3, voffA);
            PG8_WAIT_V(8); PG8_WAIT_L(0); PG8_BAR; PG8_MMA(1, 0, At, B0); PG8_MMA(1, 1, At, B1); PG8_BAR; PG8_SCHED;
            } else {
            PG8_LDB(B0, 0, 0); PG8_SCHED; PG8_LDA(At, 0, 0); PG8_STAGE(PG8_SA(1, 1), a1 + hstep, voffA);
            PG8_WAIT_L(8); PG8_BAR; PG8_WAIT_L(0); PG8_MMA(0, 0, At, B0); PG8_BAR; PG8_SCHED;
            PG8_LDB(B1, 0, 1); PG8_STAGE(PG8_SB(0, 0), b2, voffB);
            PG8_BAR; PG8_WAIT_L(0); PG8_MMA(0, 1, At, B1); PG8_BAR;
            PG8_LDA(At, 0, 1); PG8_STAGE(PG8_SA(0, 0), a2, voffA);
            PG8_BAR; PG8_WAIT_L(0); PG8_MMA(1, 0, At, B0); PG8_BAR; PG8_SCHED;
            PG8_STAGE(PG8_SB(0, 1), b2 + hstep, voffB);
            PG8_WAIT_V(6); PG8_BAR; PG8_MMA(1, 1, At, B1); PG8_BAR;
            PG8_LDB(B0, 1, 0); PG8_SCHED; PG8_LDA(At, 1, 0); PG8_STAGE(PG8_SA(0, 1), a2 + hstep, voffA);
            PG8_WAIT_L(8); PG8_BAR; PG8_WAIT_L(0); PG8_MMA(0, 0, At, B0); PG8_BAR; PG8_SCHED;
            PG8_LDB(B1, 1, 1); PG8_STAGE(PG8_SB(1, 0), b3, voffB);
            PG8_BAR; PG8_WAIT_L(0); PG8_MMA(0, 1, At, B1); PG8_BAR;
            PG8_LDA(At, 1, 1); PG8_STAGE(PG8_SA(1, 0), a3, voffA);
            PG8_BAR; PG8_WAIT_L(0); PG8_MMA(1, 0, At, B0); PG8_BAR; PG8_SCHED;
            PG8_STAGE(PG8_SB(1, 1), b3 + hstep, voffB);
            PG8_WAIT_V(6); PG8_BAR; PG8_MMA(1, 1, At, B1); PG8_BAR;
            }
        }
        if constexpr (ALIGN_EPI) { if (wr == 0) PG8_BAR; }
        if constexpr (!Epi::AFTER_DRAIN) { E(acc, cur, wr, wc, fr, fq); S.done(cur); }
        if (!has_next) break;
#pragma unroll
        for (int a = 0; a < 2; ++a)
#pragma unroll
            for (int b = 0; b < 2; ++b)
#pragma unroll
                for (int m = 0; m < 4; ++m)
#pragma unroll
                    for (int n = 0; n < 2; ++n) acc[a][b][m][n] = (f32x4){0.f, 0.f, 0.f, 0.f};
        cur = nxt; cA = nA; cB = nB; ++ui;
        if constexpr (ALIGN_EPI) { if (wr == 1) PG8_BAR; }
    }
    PG8_WAIT_V(0);
    if constexpr (!ALIGN_EPI) { if (wr == 0) PG8_BAR; }
    PG8_BAR;
    if constexpr (Epi::AFTER_DRAIN) { E.fused(acc, cur, wr, wc, fr, fq, lds, wid, lane); S.done(cur); }
#undef PG8_SA
#undef PG8_SB
#undef PG8_STAGE
#undef PG8_LDA
#undef PG8_LDB
#undef PG8_MMA
#undef PG8_WAIT_V
#undef PG8_WAIT_L
#undef PG8_BAR
#undef PG8_SCHED
}
}
#include <hip/hip_bf16.h>
#include <cmath>
namespace attn_body {
using bf16=__hip_bfloat16;
using bf16x8=__attribute__((ext_vector_type(8)))short;
using s16x4=__attribute__((ext_vector_type(4)))short;
using f32x16=__attribute__((ext_vector_type(16)))float;
using u32x4=__attribute__((ext_vector_type(4)))unsigned;
constexpr int BATCH=8,NHEAD=8,SEQ=2048,D=64,DM=NHEAD*D;
constexpr int NW=8,QBLK=32,QB=QBLK*NW,KVBLK=64,NQB=SEQ/QB;
constexpr int ATTN_PITCH=DM, ATTN_UNIT_ROWS=QB;
__device__ __forceinline__ int crow(int r,int hi){return (r&3)+8*(r>>2)+4*hi;}
#define SBAR() __builtin_amdgcn_sched_barrier(0)
__device__ __forceinline__ void cmask(f32x16&p0,f32x16&p1,int jb,int qrel,int hi){
  const float NEG=-INFINITY; int kb=64*jb+4*hi;
  #pragma unroll
  for(int r=0;r<16;++r){int kv=kb+(r&3)+8*(r>>2); if(kv>qrel)p0[r]=NEG; if(kv+32>qrel)p1[r]=NEG;}
}

constexpr int NSLOT=3, SLOTB=8192;
constexpr int LDS_K=0, LDS_V=NSLOT*SLOTB, LDS_WS=2*NSLOT*SLOTB, LDS_OST=LDS_WS+NW*64*4, LDS_BYTES=LDS_OST+NW*4096;
constexpr float C2=0.125f*1.4426950408889634f;
__device__ __forceinline__ void glds16(const void*gsrc,unsigned lds_dst){unsigned keep;
  asm volatile("s_mov_b32 %0, m0\n\ts_mov_b32 m0, %2\n\ts_nop 0\n\tglobal_load_lds_dwordx4 %1, off\n\ts_mov_b32 m0, %0":"=&s"(keep):"v"(gsrc),"s"(lds_dst):"memory");}
__device__ __forceinline__ float max3f(float a,float b,float c){float r;asm("v_max3_f32 %0, %1, %2, %3":"=v"(r):"v"(a),"v"(b),"v"(c));return r;}
__device__ __forceinline__ float max2f(float a,float b){float r;asm("v_max_f32_e32 %0, %1, %2":"=v"(r):"v"(a),"v"(b));return r;}
__device__ __forceinline__ float fadd_s(float a,float b){float r;asm("v_add_f32_e32 %0, %1, %2":"=v"(r):"v"(a),"v"(b));return r;}
__device__ __forceinline__ float fsub_s(float a,float b){float r;asm("v_sub_f32_e32 %0, %1, %2":"=v"(r):"v"(a),"v"(b));return r;}
typedef float f32x2_t __attribute__((ext_vector_type(2))); typedef float f32x4_t __attribute__((ext_vector_type(4))); typedef __bf16 bf16x2_t __attribute__((ext_vector_type(2)));
__device__ __forceinline__ unsigned cvtpk_s(float lo,float hi){f32x2_t v={lo,hi};bf16x2_t b=__builtin_convertvector(v,bf16x2_t);return __builtin_bit_cast(unsigned,b);}
#define WAIT_BAR(N) asm volatile("s_waitcnt vmcnt(" #N ") lgkmcnt(0)\n\ts_barrier":::"memory")

__device__ __forceinline__ void qkt(f32x16&p0,f32x16&p1,const char*Kslot,const bf16x8*qr,const f32x16&negm,int r32,int hi){
  const char*kb=Kslot+hi*1024+r32*16;
  #pragma unroll
  for(int d0=0;d0<4;++d0){
    const bf16x8 b0=*reinterpret_cast<const bf16x8*>(kb+d0*2048);
    const bf16x8 b1=*reinterpret_cast<const bf16x8*>(kb+d0*2048+512);
    if(d0==0){p0=__builtin_amdgcn_mfma_f32_32x32x16_bf16(b0,qr[0],negm,0,0,0);p1=__builtin_amdgcn_mfma_f32_32x32x16_bf16(b1,qr[0],negm,0,0,0);}
    else{p0=__builtin_amdgcn_mfma_f32_32x32x16_bf16(b0,qr[d0],p0,0,0,0);p1=__builtin_amdgcn_mfma_f32_32x32x16_bf16(b1,qr[d0],p1,0,0,0);}}
}
typedef __attribute__((address_space(3))) const char* lds_cptr;
typedef short v4i16_t __attribute__((ext_vector_type(4)));
__device__ __forceinline__ void kload8(bf16x8*kf,lds_cptr kp){
  kf[0]=*(const __attribute__((address_space(3))) bf16x8*)(kp);      kf[1]=*(const __attribute__((address_space(3))) bf16x8*)(kp+512);
  kf[2]=*(const __attribute__((address_space(3))) bf16x8*)(kp+2048); kf[3]=*(const __attribute__((address_space(3))) bf16x8*)(kp+2560);
  kf[4]=*(const __attribute__((address_space(3))) bf16x8*)(kp+4096); kf[5]=*(const __attribute__((address_space(3))) bf16x8*)(kp+4608);
  kf[6]=*(const __attribute__((address_space(3))) bf16x8*)(kp+6144); kf[7]=*(const __attribute__((address_space(3))) bf16x8*)(kp+6656);
}
__device__ __forceinline__ void kload2(bf16x8*kf,lds_cptr kp,int j){ kf[2*j]=*(const __attribute__((address_space(3))) bf16x8*)(kp+j*2048); kf[2*j+1]=*(const __attribute__((address_space(3))) bf16x8*)(kp+j*2048+512); }
__device__ __forceinline__ s16x4 vtr(lds_cptr p){ return __builtin_bit_cast(s16x4,__builtin_amdgcn_ds_read_tr16_b64_v4i16((__attribute__((address_space(3))) v4i16_t*)p)); }
__device__ __forceinline__ float rowmax(const f32x16&p0,const f32x16&p1){
  float a=max3f(p0[0],p0[1],p1[0]),b=max3f(p0[2],p0[3],p1[1]);a=max3f(a,p1[2],p1[3]);
  #pragma unroll
  for(int r=4;r<16;r+=4){a=max3f(a,p0[r],p0[r+1]);b=max3f(b,p0[r+2],p0[r+3]);a=max3f(a,p1[r],p1[r+1]);b=max3f(b,p1[r+2],p1[r+3]);}
  const float m=max2f(a,b);
  auto rr=__builtin_amdgcn_permlane32_swap(__float_as_uint(m),__float_as_uint(m),false,false);
  return max2f(__uint_as_float(rr[0]),__uint_as_float(rr[1]));
}
__device__ __forceinline__ void pv(f32x16*o,int vb,bf16x8 pa0,bf16x8 pa1,bf16x8 pa2,bf16x8 pa3){
  #pragma unroll
  for(int d0=0;d0<2;++d0){s16x4 lo[4],hi[4];
    #pragma unroll
    for(int ks=0;ks<4;++ks){
      asm volatile("ds_read_b64_tr_b16 %0,%1 offset:%c2":"=&v"(lo[ks]):"v"(vb),"i"(d0*4096+ks*1024):"memory");
      asm volatile("ds_read_b64_tr_b16 %0,%1 offset:%c2":"=&v"(hi[ks]):"v"(vb),"i"(d0*4096+ks*1024+512):"memory");}
    asm volatile("s_waitcnt lgkmcnt(0)":::"memory");SBAR();
    #define PK(k) (bf16x8){lo[k][0],lo[k][1],lo[k][2],lo[k][3],hi[k][0],hi[k][1],hi[k][2],hi[k][3]}
    o[d0]=__builtin_amdgcn_mfma_f32_32x32x16_bf16(pa0,PK(0),o[d0],0,0,0);
    o[d0]=__builtin_amdgcn_mfma_f32_32x32x16_bf16(pa1,PK(1),o[d0],0,0,0);
    o[d0]=__builtin_amdgcn_mfma_f32_32x32x16_bf16(pa2,PK(2),o[d0],0,0,0);
    o[d0]=__builtin_amdgcn_mfma_f32_32x32x16_bf16(pa3,PK(3),o[d0],0,0,0);
    #undef PK
  }
}

#ifndef ATTN_STORE16
#define ATTN_STORE16(p,v) (*(u32x4*)(p)=(v))
#endif
template<int THRL> __device__ __forceinline__ void attn_unit(int b,int h,int qb,const bf16*Q,const bf16*__restrict__ K,const bf16*__restrict__ V,bf16*O,const float*ksum,char*shm){
  int tid_l=threadIdx.x; asm volatile("":"+v"(tid_l)); const int tid=tid_l,lane=tid&63,r32=lane&31,hi=lane>>5; const int wid=__builtin_amdgcn_readfirstlane(tid>>6);
  const long rowbase=(long)b*SEQ; const int q0=qb*QB;
  const bf16*Qw=Q+(rowbase+q0+wid*QBLK)*DM+h*D;
  const bf16*Kh=K+rowbase*DM+h*D,*Vh=V+rowbase*DM+h*D;
  const unsigned lds0=(unsigned)(uintptr_t)shm;
  float*wsf=(float*)(shm+LDS_WS)+wid*64;
  const bf16*ksrc=Kh+(long)lane*DM+wid*8;
  const bf16*vsrc=Vh+(long)(16*(wid&3)+(lane>>2))*DM+(wid>>2)*32+(lane&3)*8;
  const unsigned kdst=lds0+LDS_K+wid*1024, vdst=lds0+LDS_V+wid*1024;
  #define DMA_K(t,slot) glds16(ksrc+(long)(t)*KVBLK*DM,(unsigned)__builtin_amdgcn_readfirstlane(kdst+(slot)))
  #define DMA_V(t,slot) glds16(vsrc+(long)(t)*KVBLK*DM,(unsigned)__builtin_amdgcn_readfirstlane(vdst+(slot)))
  const int vb0=(int)(lds0+LDS_V)+((lane>>4)&1)*32+(lane&3)*8+(4*hi+((lane&15)>>2))*64;
  const char*Kbase=shm+LDS_K; bf16x8 kf[8];
  const lds_cptr shm3=(lds_cptr)shm; const lds_cptr kp0=shm3+LDS_K+hi*1024+r32*16; const lds_cptr vp0=shm3+LDS_V+((lane>>4)&1)*32+(lane&3)*8+(4*hi+((lane&15)>>2))*64;
  const int NT=(q0+QB)/KVBLK;
  DMA_K(0,0);DMA_V(0,0);DMA_K(1,SLOTB);
  bf16x8 qr[4];
  #pragma unroll
  for(int d0=0;d0<4;++d0)qr[d0]=*reinterpret_cast<const bf16x8*>(&Qw[(long)r32*DM+d0*16+hi*8]);

  unsigned selmask=1u<<qb;
  if(qb>0){
    float gt[7];
    #pragma unroll
    for(int n=0;n<7;++n){ float s=-INFINITY;
      if(n<qb){ const float*km=ksum+((size_t)(b*8+n))*512+h*64; s=0.f;
        #pragma unroll
        for(int d0=0;d0<4;++d0){ const f32x4_t k0=*reinterpret_cast<const f32x4_t*>(km+d0*16+hi*8),k1=*reinterpret_cast<const f32x4_t*>(km+d0*16+hi*8+4);
          #pragma unroll
          for(int e=0;e<4;++e){ s+=__uint_as_float(((unsigned)(unsigned short)qr[d0][e])<<16)*k0[e]; s+=__uint_as_float(((unsigned)(unsigned short)qr[d0][4+e])<<16)*k1[e]; } }
        s+=__shfl_xor(s,32); }
      gt[n]=s; }
    #pragma unroll
    for(int n=0;n<7;++n){ int rank=0;
      #pragma unroll
      for(int m2=0;m2<7;++m2){ if(m2!=n) rank+=((gt[m2]>gt[n])||((gt[m2]==gt[n])&&(m2<n)))?1:0; }
      if(n<qb&&rank<3)selmask|=(1u<<n); }
  }
  #define MMASK(P0,P1,t) do{ if(!((selmask>>((t)>>2))&1u)){ _Pragma("unroll") for(int r=0;r<16;++r){P0[r]=-INFINITY;P1[r]=-INFINITY;} } }while(0)
  float mhat=0.f,l_reg=0.f;f32x16 o[2];o[0]=f32x16{};o[1]=f32x16{};f32x16 negm=f32x16{};asm volatile("":"+v"(negm));
  const int qrel=wid*QBLK+r32;
  #define CMASK(P0,P1,t) do{int jb_=(t)-(NT-4); if(jb_>=0)cmask(P0,P1,jb_,qrel,hi);}while(0)
  bool resc=false;
  #define START(P0,P1) do{ const float rm=rowmax(P0,P1); resc=false; \
    { const float dl=rm; mhat=fadd_s(mhat,dl); \
      _Pragma("unroll") for(int r=0;r<16;++r){P0[r]=fsub_s(P0[r],dl);P1[r]=fsub_s(P1[r],dl);} \
      _Pragma("unroll") for(int r=0;r<16;++r)negm[r]=-mhat; asm volatile("":"+v"(negm)); } \
    _Pragma("unroll") for(int r=0;r<16;++r)P0[r]=__builtin_amdgcn_exp2f(P0[r]); }while(0)
  #define RESC() do{ if(resc){ asm volatile("s_waitcnt lgkmcnt(0)":::"memory"); \
      _Pragma("unroll") for(int d_=0;d_<2;++d_) _Pragma("unroll") for(int r=0;r<16;++r)o[d_][r]*=wsf[crow(r,hi)]; } }while(0)
  f32x16 pA0,pA1,pB0,pB1;
  int sl_prev=0,sl_cur=0,sl_next=SLOTB;
  #define ROT() do{sl_prev=sl_cur;sl_cur=sl_next;sl_next=(sl_next==(NSLOT-1)*SLOTB)?0:sl_next+SLOTB;}while(0)
  DMA_K(2,2*SLOTB);
  WAIT_BAR(3);
  qkt(pA0,pA1,Kbase,qr,negm,r32,hi);asm volatile("s_nop 15\n\ts_nop 7":"+v"(pA0),"+v"(pA1));CMASK(pA0,pA1,0);
  START(pA0,pA1);
  _Pragma("unroll") for(int r=0;r<16;++r)pA1[r]=__builtin_amdgcn_exp2f(pA1[r]);
  if(!(selmask&1u)){ _Pragma("unroll") for(int r=0;r<16;++r){pA0[r]=0.f;pA1[r]=0.f;} }
  WAIT_BAR(0);
  DMA_K(3,0);DMA_V(1,SLOTB);
  ROT();
  kload8(kf,kp0+sl_cur);
  WAIT_BAR(2);
  s16x4 vlo[8],vhi[8]; u32x4 pw0,pw1,pw2,pw3;
  #define PKW(P,B) cvtpk_s(P[B],P[B+1])
  #define PAF(k) __builtin_bit_cast(bf16x8,pw##k)
  #define VFR(i) (bf16x8){vlo[i][0],vlo[i][1],vlo[i][2],vlo[i][3],vhi[i][0],vhi[i][1],vhi[i][2],vhi[i][3]}
  #define PIN(x) asm volatile("":"+v"(x))
  #define MX3(a,b,c) __builtin_fmaxf(__builtin_fmaxf((a),(b)),(c))
  #define GAPA(MF,A0,A1,A2,A3,W0,W1,PW) do{ MF; sacc+=A0; sacc+=A1; sacc+=A2; sacc+=A3; PIN(sacc); W0; W1; PIN(PW); SBAR(); }while(0)
  #define EX(v) __builtin_amdgcn_exp2f(v)
  #define GAPB(MF,X,B) do{ MF; X[B]=EX(X[B]); X[B+1]=EX(X[B+1]); X[B+2]=EX(X[B+2]); X[B+3]=EX(X[B+3]); PIN(X); SBAR(); }while(0)
  #define VRD(i) do{ vlo[i]=vtr(vp_+(((i)>>2)*4096+((i)&3)*1024)); vhi[i]=vtr(vp_+(((i)>>2)*4096+((i)&3)*1024+512)); }while(0)
  #define KRD(G,j) do{ if(G){ kload2(kf,kp0+sl_next,j); SBAR(); } }while(0)
  #define STEP(C0,C1,P0,P1,t,GK,GV,GL) do{ SBAR(); \
    const lds_cptr vp_=vp0+sl_prev; \
    VRD(0); SBAR(); float sacc=(P0[0]+P0[1]); \
    GAPA(C0=__builtin_amdgcn_mfma_f32_32x32x16_bf16(kf[0],qr[0],negm,0,0,0), P0[2],P0[3],P0[4],P0[5],     pw0[0]=PKW(P0,0), pw0[1]=PKW(P0,2), pw0); \
    VRD(4); SBAR(); GAPA(C1=__builtin_amdgcn_mfma_f32_32x32x16_bf16(kf[1],qr[0],negm,0,0,0), P0[6],P0[7],P0[8],P0[9],     pw0[2]=PKW(P0,4), pw0[3]=PKW(P0,6), pw0); \
    VRD(1); SBAR(); GAPA(C0=__builtin_amdgcn_mfma_f32_32x32x16_bf16(kf[2],qr[1],C0,0,0,0),   P0[10],P0[11],P0[12],P0[13], pw1[0]=PKW(P0,8), pw1[1]=PKW(P0,10), pw1); \
    VRD(5); SBAR(); GAPA(C1=__builtin_amdgcn_mfma_f32_32x32x16_bf16(kf[3],qr[1],C1,0,0,0),   P0[14],P0[15],P1[0],P1[1],   pw1[2]=PKW(P0,12),pw1[3]=PKW(P0,14), pw1); \
    VRD(2); SBAR(); GAPA(C0=__builtin_amdgcn_mfma_f32_32x32x16_bf16(kf[4],qr[2],C0,0,0,0),   P1[2],P1[3],P1[4],P1[5],     pw2[0]=PKW(P1,0), pw2[1]=PKW(P1,2), pw2); \
    VRD(6); SBAR(); GAPA(C1=__builtin_amdgcn_mfma_f32_32x32x16_bf16(kf[5],qr[2],C1,0,0,0),   P1[6],P1[7],P1[8],P1[9],     pw2[2]=PKW(P1,4), pw2[3]=PKW(P1,6), pw2); \
    VRD(3); SBAR(); GAPA(C0=__builtin_amdgcn_mfma_f32_32x32x16_bf16(kf[6],qr[3],C0,0,0,0),   P1[10],P1[11],P1[12],P1[13], pw3[0]=PKW(P1,8), pw3[1]=PKW(P1,10), pw3); \
    VRD(7); SBAR(); GAPA(C1=__builtin_amdgcn_mfma_f32_32x32x16_bf16(kf[7],qr[3],C1,0,0,0),   P1[14],P1[15],0.f,0.f,       pw3[2]=PKW(P1,12),pw3[3]=PKW(P1,14), pw3); \
    l_reg+=sacc; \
    if(GK){DMA_K((t)+3,sl_cur);} if(GV){DMA_V((t)+1,sl_next);} \
    CMASK(C0,C1,t); \
    { float a=MX3(C0[0],C0[1],C1[0]),b=MX3(C0[2],C0[3],C1[1]); a=MX3(a,C1[2],C1[3]); \
      _Pragma("unroll") for(int r=4;r<16;r+=4){a=MX3(a,C0[r],C0[r+1]);b=MX3(b,C0[r+2],C0[r+3]);a=MX3(a,C1[r],C1[r+1]);b=MX3(b,C1[r+2],C1[r+3]);} \
      float rm=__builtin_fmaxf(a,b); { auto rr=__builtin_amdgcn_permlane32_swap(__float_as_uint(rm),__float_as_uint(rm),false,false); rm=__builtin_fmaxf(__uint_as_float(rr[0]),__uint_as_float(rr[1])); } \
      resc=false; \
      if(__builtin_expect(__any(rm>(float)THRL),0)){ const float dl=__builtin_fmaxf(rm,0.f); mhat+=dl; \
        _Pragma("unroll") for(int r=0;r<16;++r){C0[r]-=dl;C1[r]-=dl;} \
        _Pragma("unroll") for(int r=0;r<16;++r)negm[r]=-mhat; asm volatile("":"+v"(negm)); \
        const float f=__builtin_amdgcn_exp2f(-dl); l_reg*=f; if(hi==0)wsf[r32]=f; resc=true; } } \
    MMASK(C0,C1,t); \
    SBAR(); \
    GAPB(o[0]=__builtin_amdgcn_mfma_f32_32x32x16_bf16(PAF(0),VFR(0),o[0],0,0,0), C0,0); \
    GAPB(o[1]=__builtin_amdgcn_mfma_f32_32x32x16_bf16(PAF(0),VFR(4),o[1],0,0,0), C0,4); \
    KRD(GL,0); GAPB(o[0]=__builtin_amdgcn_mfma_f32_32x32x16_bf16(PAF(1),VFR(1),o[0],0,0,0), C0,8); \
    KRD(GL,1); GAPB(o[1]=__builtin_amdgcn_mfma_f32_32x32x16_bf16(PAF(1),VFR(5),o[1],0,0,0), C0,12); \
    KRD(GL,2); GAPB(o[0]=__builtin_amdgcn_mfma_f32_32x32x16_bf16(PAF(2),VFR(2),o[0],0,0,0), C1,0); \
    KRD(GL,3); GAPB(o[1]=__builtin_amdgcn_mfma_f32_32x32x16_bf16(PAF(2),VFR(6),o[1],0,0,0), C1,4); \
    GAPB(o[0]=__builtin_amdgcn_mfma_f32_32x32x16_bf16(PAF(3),VFR(3),o[0],0,0,0), C1,8); \
    GAPB(o[1]=__builtin_amdgcn_mfma_f32_32x32x16_bf16(PAF(3),VFR(7),o[1],0,0,0), C1,12); \
    }while(0)
  int t=1;
  #undef CMASK
  #define CMASK(P0,P1,t) do{}while(0)
  for(;t+5<NT;t+=2){
    STEP(pB0,pB1,pA0,pA1,t,true,true,true);     WAIT_BAR(2); RESC(); ROT();
    STEP(pA0,pA1,pB0,pB1,t+1,true,true,true);   WAIT_BAR(2); RESC(); ROT();
  }
  #undef CMASK
  #define CMASK(P0,P1,t) do{int jb_=(t)-(NT-4); if(jb_>=0)cmask(P0,P1,jb_,qrel,hi);}while(0)
  #define ENDW(tt) do{ if((tt)+3<NT){WAIT_BAR(2);} else if((tt)+2<NT){WAIT_BAR(1);} else {WAIT_BAR(0);} }while(0)
  for(;t+1<NT;t+=2){
    STEP(pB0,pB1,pA0,pA1,t,(t+3<NT),(t+1<NT),(t+1<NT));       ENDW(t);   RESC(); ROT();
    STEP(pA0,pA1,pB0,pB1,t+1,(t+4<NT),(t+2<NT),(t+2<NT));     ENDW(t+1); RESC(); ROT();
  }
  STEP(pB0,pB1,pA0,pA1,NT-1,false,false,false); RESC();
  { float sacc=pB0[0]+pB0[1]; _Pragma("unroll") for(int r=2;r<16;++r)sacc+=pB0[r]; _Pragma("unroll") for(int r=0;r<16;++r)sacc+=pB1[r]; l_reg+=sacc;
    pw0=(u32x4){PKW(pB0,0),PKW(pB0,2),PKW(pB0,4),PKW(pB0,6)};pw1=(u32x4){PKW(pB0,8),PKW(pB0,10),PKW(pB0,12),PKW(pB0,14)};pw2=(u32x4){PKW(pB1,0),PKW(pB1,2),PKW(pB1,4),PKW(pB1,6)};pw3=(u32x4){PKW(pB1,8),PKW(pB1,10),PKW(pB1,12),PKW(pB1,14)};
    SBAR(); pv(o,vb0+sl_cur,PAF(0),PAF(1),PAF(2),PAF(3)); }
  #undef PKW
  #undef PAF
  #undef VFR
  #undef PIN
  #undef MX3
  #undef GAPA
  #undef GAPB
  #undef EX
  #undef VRD
  #undef KRD
  #undef STEP
  #undef ENDW
  {auto rr=__builtin_amdgcn_permlane32_swap(__float_as_uint(l_reg),__float_as_uint(l_reg),false,false);l_reg=__uint_as_float(rr[0])+__uint_as_float(rr[1]);}
  if(hi==0)wsf[32+r32]=l_reg;asm volatile("s_waitcnt lgkmcnt(0)":::"memory");
  float rli[16];
  #pragma unroll
  for(int r=0;r<16;++r)rli[r]=__builtin_amdgcn_rcpf(wsf[32+crow(r,hi)]);
  bf16*Ow=O+(rowbase+q0+wid*QBLK)*DM+h*D;
  { bf16*stg=(bf16*)(shm+LDS_OST)+wid*2048;
    #pragma unroll
    for(int r=0;r<16;++r){const int orow=crow(r,hi);
      #pragma unroll
      for(int d0=0;d0<2;++d0)stg[orow*64+d0*32+r32]=__float2bfloat16(o[d0][r]*rli[r]);}
    asm volatile("s_waitcnt lgkmcnt(0)":::"memory");
    #pragma unroll
    for(int i=0;i<4;++i){const int row=i*8+(lane>>3),ch=lane&7; const u32x4 v=*(const u32x4*)(stg+row*64+ch*8); ATTN_STORE16(Ow+(long)row*DM+ch*8,v);} }
  asm volatile("s_waitcnt lgkmcnt(0)\n\ts_barrier":::"memory");
  #undef MMASK
  #undef DMA_K
  #undef DMA_V
  #undef CMASK
  #undef START
  #undef RESC
  #undef ROT
}
constexpr int ATTN_LDS_BYTES=LDS_BYTES;
struct AttnTensors { const bf16* Q; const bf16* K; const bf16* V; bf16* O; };
struct AttnUnit { int bh; int qb; };
struct StaticOrder {
  int vcu;
  __device__ __forceinline__ explicit StaticOrder(int grid,int block):vcu((block%8)*(grid/8)+block/8){}
  __device__ __forceinline__ bool next(int i,AttnUnit&u)const{ if(i>=4)return false; const int s=vcu&7; u.bh=vcu>>3; u.qb=(i==0)?s:(i==1)?15-s:(i==2)?16+s:31-s; return true; }
  __device__ __forceinline__ void a_ready(const AttnUnit&)const{}
  __device__ __forceinline__ void done(const AttnUnit&)const{}
};
template<class Sched,int THRL=8> __device__ __forceinline__ void attn_phase(char*lds,const AttnTensors&T,const Sched&S){
  AttnUnit u;
  for(int i=0;S.next(i,u);++i){ S.a_ready(u); attn_unit<THRL>(u.bh/NHEAD,u.bh%NHEAD,u.qb,T.Q,T.K,T.V,T.O,lds); S.done(u); }
}
#undef SBAR
#undef WAIT_BAR
}
#define GAS __attribute__((address_space(1)))
#define LAS __attribute__((address_space(3)))
#define XB_TMO      128
#define XB_XCNT(j)  (256  + 64 * (j))
#define XB_XSUB(j)  (1280 + 64 * (j))
#define XB_XGEN(j)  (2304 + 64 * (j))
#define XB_TOP      3328
#define XB_TOPGEN   3392
#define XCD_BAR_WORDS 3456
#define XB_SPIN_CAP (1u << 18)

__device__ __forceinline__ unsigned xb_ld(unsigned* p)              { return __hip_atomic_load(p, __ATOMIC_RELAXED, __HIP_MEMORY_SCOPE_AGENT); }
__device__ __forceinline__ unsigned xb_add(unsigned* p, unsigned v) { return __hip_atomic_fetch_add(p, v, __ATOMIC_RELAXED, __HIP_MEMORY_SCOPE_AGENT); }
__device__ __forceinline__ unsigned xb_xcc_id() { return (unsigned)__builtin_amdgcn_s_getreg((3 << 11) | 20) & 0xFu; }
#define XB_SPIN(cond, bar) do { unsigned _sp = 0; while (cond) { __builtin_amdgcn_s_sleep(1); \
    if ((++_sp & 255u) == 0u) { if (xb_ld(&(bar)[XB_TMO])) break; if (_sp > XB_SPIN_CAP) { atomicAdd(&(bar)[XB_TMO], 1u); break; } } } } while (0)

struct XcdBarrier {
    unsigned* bar; unsigned x;
    volatile LAS unsigned* st;
};

__device__ __forceinline__ XcdBarrier xcd_barrier_post(unsigned* bar, volatile LAS unsigned* st) {
    XcdBarrier b; b.bar = bar; b.x = xb_xcc_id(); b.st = st;
    if (threadIdx.x == 0) (void)xb_add(&bar[XB_XCNT(b.x)], 1u);
    return b;
}
__device__ __forceinline__ void xcd_barrier_complete(unsigned* bar, unsigned x, unsigned& nloc, unsigned& nx) {
    const unsigned G = gridDim.x * gridDim.y * gridDim.z;
    unsigned sum, cnt, mine, sp = 0u;
    for (;;) {
        sum = 0u; cnt = 0u; mine = 0u;
#pragma unroll
        for (unsigned j = 0; j < 16; ++j) { const unsigned c = xb_ld(&bar[XB_XCNT(j)]); sum += c; cnt += (c > 0u) ? 1u : 0u; mine = (j == x) ? c : mine; }
        if (sum == G) break;
        __builtin_amdgcn_s_sleep(1);
        if ((++sp & 255u) == 0u) { if (xb_ld(&bar[XB_TMO])) break; if (sp > XB_SPIN_CAP) { atomicAdd(&bar[XB_TMO], 1u); break; } }
    }
    nloc = mine > 0u ? mine : 1u; nx = cnt > 0u ? cnt : 1u;
}

__device__ __forceinline__ void xcd_barrier(const XcdBarrier& b) {
    asm volatile("s_waitcnt vmcnt(0)" ::: "memory");
    __syncthreads();
    if (threadIdx.x == 0) {
        unsigned* bar = b.bar;
        __builtin_amdgcn_s_waitcnt(0);
        unsigned nloc = b.st[0], nx = b.st[1];
        if (nloc == 0u) { xcd_barrier_complete(bar, b.x, nloc, nx); b.st[0] = nloc; b.st[1] = nx; }
        const unsigned old = xb_add(&bar[XB_XSUB(b.x)], 1u);
        const unsigned gen = old / nloc;
        if (old + 1u == (gen + 1u) * nloc) {
            __builtin_amdgcn_fence(__ATOMIC_RELEASE, "agent");
            asm volatile("s_waitcnt vmcnt(0)" ::: "memory");
            const unsigned og = xb_add(&bar[XB_TOP], 1u);
            const unsigned tg = og / nx;
            if (og + 1u == (tg + 1u) * nx) xb_add(&bar[XB_TOPGEN], 1u);
            else XB_SPIN(xb_ld(&bar[XB_TOPGEN]) == tg, bar);
            __builtin_amdgcn_fence(__ATOMIC_ACQUIRE, "agent");
            xb_add(&bar[XB_XGEN(b.x)], 1u);
            asm volatile("s_waitcnt vmcnt(0)" ::: "memory");
        } else {
            XB_SPIN(xb_ld(&bar[XB_XGEN(b.x)]) == gen, bar);
            __builtin_amdgcn_fence(__ATOMIC_ACQUIRE, "agent");
            asm volatile("s_waitcnt vmcnt(0)" ::: "memory");
        }
    }
    __syncthreads();
}
typedef unsigned short bf16;
typedef unsigned v4u __attribute__((ext_vector_type(4)));
typedef unsigned v2u __attribute__((ext_vector_type(2)));
typedef float f32x4 __attribute__((ext_vector_type(4)));
typedef float f32x2 __attribute__((ext_vector_type(2)));
typedef float f32x16 __attribute__((ext_vector_type(16)));
typedef short bf16x8 __attribute__((ext_vector_type(8)));
constexpr int NB = 8, SEQ = 2048, DM = 1024, M = NB * SEQ, DFF = 4096;
constexpr int NIN = 7424;
constexpr int NMIX = 4352;
constexpr float EPS = 1e-6f;
constexpr size_t MiB = 1u << 20;
constexpr size_t WS_CTL = 0, WS_ROPEC = 1 * MiB, WS_ROPES = 3 * MiB, WS_KMEAN = 5 * MiB;
constexpr size_t WS_WIN = 6 * MiB, WS_WBO = WS_WIN + (size_t)NIN * DM * 2, WS_WMIX = WS_WBO + 3 * MiB, WS_WUP = WS_WMIX + 2 * MiB, WS_WDN = WS_WUP + 8 * MiB;
static_assert(WS_WDN + 8 * MiB <= 42 * MiB, "weights");
constexpr size_t WS_XN = 42 * MiB;
constexpr size_t WS_Q = 74 * MiB, WS_LR = 90 * MiB, WS_CONV = 106 * MiB, WS_K = 122 * MiB, WS_V = 138 * MiB, WS_LQ = 154 * MiB, WS_LK = 162 * MiB, WS_LV = 170 * MiB,
                 WS_CA = 186 * MiB, WS_CG = 202 * MiB, WS_G = 218 * MiB;
constexpr size_t WS_YB = 122 * MiB, WS_MB = 218 * MiB, WS_Y = 106 * MiB, WS_H = 74 * MiB, WS_Y2 = 202 * MiB, WS_END = 256 * MiB;
constexpr size_t WS_SLOC = 234 * MiB, WS_DTOT = 242 * MiB;
constexpr int LDS_RING = 131072, LDS_BYTES = LDS_RING + 1024;

__device__ __forceinline__ unsigned f2bf(float f) { unsigned u = __builtin_bit_cast(unsigned, f); return (u + 0x7fffu + ((u >> 16) & 1u)) >> 16; }
__device__ __forceinline__ unsigned pk2(float lo, float hi) { return pg8::cvt_pk_bf16(lo, hi); }
__device__ __forceinline__ float bflo(unsigned w) { return __uint_as_float(w << 16); }
__device__ __forceinline__ float bfhi(unsigned w) { return __uint_as_float(w & 0xffff0000u); }
__device__ __forceinline__ float bf1(unsigned short h) { return __uint_as_float(((unsigned)h) << 16); }
__device__ __forceinline__ float sigmf(float x) { return 1.0f / (1.0f + __expf(-x)); }
__device__ __forceinline__ float wave_sum(float v) {
#pragma unroll
    for (int o = 1; o < 64; o <<= 1) v += __shfl_xor(v, o);
    return v;
}
__constant__ float c_inv_freq[32] = {1.0f, 0.7498942613601685f, 0.5623413324356079f, 0.4216965138912201f, 0.3162277638912201f, 0.23713737726211548f, 0.17782793939113617f, 0.133352130651474f, 0.10000000149011612f, 0.07498941570520401f, 0.05623413249850273f, 0.04216965287923813f, 0.03162277489900589f, 0.023713737726211548f, 0.017782794311642647f, 0.01333521492779255f, 0.009999999776482582f, 0.007498941849917173f, 0.005623413249850273f, 0.0042169648222625256f, 0.003162277629598975f, 0.00237137358635664f, 0.0017782794311642647f, 0.0013335214462131262f, 0.0010000000474974513f, 0.0007498942431993783f, 0.000562341301701963f, 0.0004216965171508491f, 0.0003162277571391314f, 0.00023713737027719617f, 0.00017782794020604342f, 0.0001333521504420787f};

__device__ __forceinline__ int src_inproj(int n) {
    if (n < 1024) { const int sec = n >> 9, w = n & 511, hd = w >> 6, j = w & 63; return sec * 512 + hd * 64 + (j >> 1) + 32 * (j & 1); }
    if (n < 2560) return n;
    if (n < 2816) return -(n - 2560) - 1;
    return n - 240;
}
template <bool INPROJ> __device__ __forceinline__ void wt_item(const float* W, int K, int ldw, int nblk, bf16* WT, const float* A2, LAS float* scr, int item, int lane) {
    const int kb = item / nblk, nb = item % nblk, k0 = 64 * kb, n0 = 32 * nb;
    const int nd = n0 + (lane & 31); const int src = INPROJ ? src_inproj(nd) : nd;
    if (INPROJ && src < 0) {
        const int nn = -(src + 1);
        float a2[16];
#pragma unroll
        for (int r = 0; r < 16; ++r) a2[r] = A2[r * 256 + nn];
#pragma unroll 2
        for (int i = 0; i < 32; ++i) { const int kk = 2 * i + (lane >> 5); const float* wr = W + (size_t)(k0 + kk) * ldw + 2560; float s = 0.f;
#pragma unroll
            for (int r = 0; r < 16; r += 4) { const f32x4 w4 = *(const f32x4*)(wr + r); s += w4[0] * a2[r] + w4[1] * a2[r + 1] + w4[2] * a2[r + 2] + w4[3] * a2[r + 3]; }
            scr[kk * 33 + (lane & 31)] = s; }
    } else {
        float wv[32];
#pragma unroll
        for (int i = 0; i < 32; ++i) { const int kk = 2 * i + (lane >> 5); wv[i] = W[(size_t)(k0 + kk) * ldw + src]; }
#pragma unroll
        for (int i = 0; i < 32; ++i) { const int kk = 2 * i + (lane >> 5); scr[kk * 33 + (lane & 31)] = wv[i]; }
    }
    asm volatile("s_waitcnt lgkmcnt(0)" ::: "memory");
    const int c = lane & 7;
#pragma unroll
    for (int j = 0; j < 4; ++j) { const int n = (lane >> 3) + 8 * j; const LAS float* s = scr + (8 * c) * 33 + n;
        v4u o; o.x = pk2(s[0 * 33], s[1 * 33]); o.y = pk2(s[2 * 33], s[3 * 33]); o.z = pk2(s[4 * 33], s[5 * 33]); o.w = pk2(s[6 * 33], s[7 * 33]);
        *(v4u*)(WT + (size_t)(n0 + n) * K + k0 + 8 * c) = o; }
    asm volatile("s_waitcnt lgkmcnt(0)" ::: "memory");
}
struct LayerW { const float *w_in, *a2, *w_mo, *w_go, *w_co, *w_mix, *w_up, *w_dn; };
__device__ __forceinline__ void convert_weights(const LayerW& L, unsigned char* ws, LAS unsigned char* lds, int gw, int NGW, int wave, int lane) {
    LAS float* scr = (LAS float*)(lds + wave * 16384);
    bf16* Win = (bf16*)(ws + WS_WIN); bf16* Wbo = (bf16*)(ws + WS_WBO); bf16* Wmix = (bf16*)(ws + WS_WMIX); bf16* Wup = (bf16*)(ws + WS_WUP); bf16* Wdn = (bf16*)(ws + WS_WDN);
    constexpr int I_IN = (DM / 64) * (NIN / 32), I_BO = (512 / 64) * (DM / 32), I_MIX = (DM / 64) * (DM / 32), I_UP = (DM / 64) * (DFF / 32), I_DN = (DFF / 64) * (DM / 32);
    constexpr int NITEMS = I_IN + 3 * I_BO + I_MIX + I_UP + I_DN;
    for (int it = gw; it < NITEMS; it += NGW) {
        int r = it;
        if (r < I_IN) { wt_item<true>(L.w_in, DM, 7184, NIN / 32, Win, L.a2, scr, r, lane); continue; } r -= I_IN;
        if (r < I_BO) { wt_item<false>(L.w_mo, 512, DM, DM / 32, Wbo, nullptr, scr, r, lane); continue; } r -= I_BO;
        if (r < I_BO) { wt_item<false>(L.w_go, 512, DM, DM / 32, Wbo + 512 * 1024, nullptr, scr, r, lane); continue; } r -= I_BO;
        if (r < I_BO) { wt_item<false>(L.w_co, 512, DM, DM / 32, Wbo + 2 * 512 * 1024, nullptr, scr, r, lane); continue; } r -= I_BO;
        if (r < I_MIX) { wt_item<false>(L.w_mix, DM, DM, DM / 32, Wmix, nullptr, scr, r, lane); continue; } r -= I_MIX;
        if (r < I_UP) { wt_item<false>(L.w_up, DM, DFF, DFF / 32, Wup, nullptr, scr, r, lane); continue; } r -= I_UP;
        wt_item<false>(L.w_dn, DFF, DM, DM / 32, Wdn, nullptr, scr, r, lane);
    }
}
__device__ __forceinline__ void row_phase(const float* hin, const bf16* Y, const float* gY, float* hout, const float* gN, bf16* XN, int gw, int NGW, int lane) {
    constexpr int NR = 4;
    for (int m0 = gw; m0 < M; m0 += NR * NGW) {
        f32x4 v[NR][4]; v2u yw[NR][4];
#pragma unroll
        for (int r = 0; r < NR; ++r) { const int m = m0 + r * NGW; if (m < M) { const f32x4* xr = (const f32x4*)(hin + (size_t)m * DM) + lane;
#pragma unroll
            for (int j = 0; j < 4; ++j) v[r][j] = xr[64 * j];
            if (Y) { const v2u* yr = (const v2u*)(Y + (size_t)m * DM) + lane;
#pragma unroll
                for (int j = 0; j < 4; ++j) yw[r][j] = yr[64 * j]; } } }
        if (Y) {
            float s[NR];
#pragma unroll
            for (int r = 0; r < NR; ++r) { s[r] = 0.f;
#pragma unroll
                for (int j = 0; j < 4; ++j) { const float a = bflo(yw[r][j].x), b = bfhi(yw[r][j].x), c = bflo(yw[r][j].y), d = bfhi(yw[r][j].y); s[r] += (a * a + b * b) + (c * c + d * d); } }
#pragma unroll
            for (int o = 1; o < 64; o <<= 1) {
#pragma unroll
                for (int r = 0; r < NR; ++r) s[r] += __shfl_xor(s[r], o); }
#pragma unroll
            for (int r = 0; r < NR; ++r) { const int m = m0 + r * NGW; if (m < M) { const float rstd = rsqrtf(s[r] * (1.f / DM) + EPS); f32x4* ho = (f32x4*)(hout + (size_t)m * DM) + lane;
#pragma unroll
                for (int j = 0; j < 4; ++j) { const f32x4 g = ((const f32x4*)gY)[lane + 64 * j]; const f32x4 y = (f32x4){bflo(yw[r][j].x), bfhi(yw[r][j].x), bflo(yw[r][j].y), bfhi(yw[r][j].y)};
                    v[r][j] = v[r][j] + y * rstd * g; ho[64 * j] = v[r][j]; } } }
        }
        if (XN) {
            float s[NR];
#pragma unroll
            for (int r = 0; r < NR; ++r) { s[r] = 0.f;
#pragma unroll
                for (int j = 0; j < 4; ++j) s[r] += (v[r][j].x * v[r][j].x + v[r][j].y * v[r][j].y) + (v[r][j].z * v[r][j].z + v[r][j].w * v[r][j].w); }
#pragma unroll
            for (int o = 1; o < 64; o <<= 1) {
#pragma unroll
                for (int r = 0; r < NR; ++r) s[r] += __shfl_xor(s[r], o); }
#pragma unroll
            for (int r = 0; r < NR; ++r) { const int m = m0 + r * NGW; if (m < M) { const float rstd = rsqrtf(s[r] * (1.f / DM) + EPS); v2u* o8 = (v2u*)(XN + (size_t)m * DM) + lane;
#pragma unroll
                for (int j = 0; j < 4; ++j) { const f32x4 g = ((const f32x4*)gN)[lane + 64 * j]; const f32x4 t = v[r][j] * rstd * g; v2u w; w.x = pk2(t.x, t.y); w.y = pk2(t.z, t.w); o8[64 * j] = w; } } }
        }
    }
}
constexpr int GL_QS = 0, GL_KS = 9216, GL_KT = 18432, GL_VT = 27648, GL_AS = 46080, GL_ST = 55296, GL_OS = 92160, GL_TOT = 125952, GL_DEC = 128000;
__device__ __forceinline__ int crow16(int r, int hi) { return (r & 3) + 8 * (r >> 2) + 4 * hi; }
template <int PASS> __device__ __forceinline__ void gla_unit(int bh, int grp, const bf16* lq, const bf16* lk, const bf16* lv, const float* gdec, bf16* lr, const float* gnorm, float* Sloc, float* Dtot, LAS unsigned char* lds) {
    int tid_l = threadIdx.x; asm volatile("" : "+v"(tid_l));
    const int tid = tid_l, lane = tid & 63, l31 = lane & 31, hi = lane >> 5; const int w = __builtin_amdgcn_readfirstlane(tid >> 6);
    const int b = bh >> 2, hh = bh & 3; const size_t rowbase = (size_t)b * SEQ + (size_t)grp * 256;
    LAS bf16* Qs = (LAS bf16*)(lds + GL_QS); LAS bf16* Ks = (LAS bf16*)(lds + GL_KS); LAS bf16* KT = (LAS bf16*)(lds + GL_KT); LAS bf16* VT = (LAS bf16*)(lds + GL_VT);
    LAS bf16* As = (LAS bf16*)(lds + GL_AS); LAS bf16* ST = (LAS bf16*)(lds + GL_ST); LAS float* Os = (LAS float*)(lds + GL_OS); LAS float* tot = (LAS float*)(lds + GL_TOT); LAS float* dec = (LAS float*)(lds + GL_DEC);
    const int dt = w >> 2, vt = w & 3;
    f32x16 sacc;
#pragma unroll
    for (int r = 0; r < 16; ++r) sacc[r] = 0.f;
    float gl_n[8]; unsigned short qv_n[8], kv_n[8], vv0_n[8], vv1_n[8];
#define GLA_LOAD(ci) do { const size_t r0_ = rowbase + (size_t)(ci) * 64 + 8 * w; _Pragma("unroll") for (int t = 0; t < 8; ++t) { const size_t row = r0_ + t; gl_n[t] = gdec[row * 256 + hh * 64 + lane]; \
        if (PASS == 3) qv_n[t] = lq[row * 256 + hh * 64 + lane]; kv_n[t] = lk[row * 256 + hh * 64 + lane]; vv0_n[t] = lv[row * 512 + hh * 128 + lane]; vv1_n[t] = lv[row * 512 + hh * 128 + 64 + lane]; } } while (0)
    GLA_LOAD(0);
    if (PASS == 3) {
        for (int g2 = 0; g2 < grp; ++g2) { const float* sl = Sloc + ((size_t)(bh * 8 + g2) * 8 + w) * 1024 + lane; const float* dp = Dtot + (size_t)(bh * 8 + g2) * 64 + 32 * dt + 4 * hi;
#pragma unroll
            for (int g = 0; g < 4; ++g) { const f32x4 dv = *(const f32x4*)(dp + 8 * g);
#pragma unroll
                for (int e2 = 0; e2 < 4; ++e2) sacc[4 * g + e2] = sacc[4 * g + e2] * dv[e2] + sl[(4 * g + e2) * 64]; } }
#pragma unroll
        for (int g = 0; g < 4; ++g) { const int d0 = 32 * dt + 8 * g + 4 * hi;
            *(LAS v2u*)(ST + (32 * vt + l31) * 72 + d0) = (v2u){pk2(sacc[4 * g], sacc[4 * g + 1]), pk2(sacc[4 * g + 2], sacc[4 * g + 3])}; }
    }
    float gsum = 0.f;
#pragma unroll 1
    for (int c = 0; c < 4; ++c) {
        float gl[8]; unsigned short qv[8], kv[8], vv0[8], vv1[8];
#pragma unroll
        for (int t = 0; t < 8; ++t) { gl[t] = gl_n[t]; qv[t] = qv_n[t]; kv[t] = kv_n[t]; vv0[t] = vv0_n[t]; vv1[t] = vv1_n[t]; }
        v4u ra, rb; bf16* rp = lr + (rowbase + (size_t)c * 64 + (tid >> 3)) * 512 + hh * 128 + (tid & 7) * 16;
        if (PASS == 3) { ra = *(const v4u*)rp; rb = *(const v4u*)(rp + 8); }
#pragma unroll
        for (int t = 1; t < 8; ++t) gl[t] += gl[t - 1];
        tot[w * 64 + lane] = gl[7];
        __syncthreads();
        if (c < 3) GLA_LOAD(c + 1);
        float off = 0.f, glast = 0.f;
#pragma unroll
        for (int j = 0; j < 8; ++j) { const float tj = tot[j * 64 + lane]; glast += tj; if (j < w) off += tj; }
        gsum += glast;
        unsigned kt[4];
#pragma unroll
        for (int t = 0; t < 8; t += 2) {
            const float G0 = off + gl[t], G1 = off + gl[t + 1];
            const float k0 = bf1(kv[t]) * __expf(-G0), k1 = bf1(kv[t + 1]) * __expf(-G1);
            const unsigned kp = pk2(k0, k1);
            if (PASS == 3) { const float q0 = bf1(qv[t]) * __expf(G0), q1 = bf1(qv[t + 1]) * __expf(G1); const unsigned qp = pk2(q0, q1);
                Qs[(8 * w + t) * 72 + lane] = (bf16)(qp & 0xffffu); Qs[(8 * w + t + 1) * 72 + lane] = (bf16)(qp >> 16);
                Ks[(8 * w + t) * 72 + lane] = (bf16)(kp & 0xffffu); Ks[(8 * w + t + 1) * 72 + lane] = (bf16)(kp >> 16); }
            kt[t >> 1] = kp; }
        *(LAS v4u*)(KT + lane * 72 + 8 * w) = (v4u){kt[0], kt[1], kt[2], kt[3]};
        *(LAS v4u*)(VT + lane * 72 + 8 * w) = (v4u){(unsigned)vv0[0] | ((unsigned)vv0[1] << 16), (unsigned)vv0[2] | ((unsigned)vv0[3] << 16), (unsigned)vv0[4] | ((unsigned)vv0[5] << 16), (unsigned)vv0[6] | ((unsigned)vv0[7] << 16)};
        *(LAS v4u*)(VT + (64 + lane) * 72 + 8 * w) = (v4u){(unsigned)vv1[0] | ((unsigned)vv1[1] << 16), (unsigned)vv1[2] | ((unsigned)vv1[3] << 16), (unsigned)vv1[4] | ((unsigned)vv1[5] << 16), (unsigned)vv1[6] | ((unsigned)vv1[7] << 16)};
        if (w == 0) dec[lane] = __expf(glast);
        __syncthreads();
        {
#pragma unroll
            for (int kk = 0; kk < 4; ++kk) { const bf16x8 a = *(const LAS bf16x8*)(KT + (32 * dt + l31) * 72 + kk * 16 + hi * 8), bb = *(const LAS bf16x8*)(VT + (32 * vt + l31) * 72 + kk * 16 + hi * 8);
                sacc = __builtin_amdgcn_mfma_f32_32x32x16_bf16(a, bb, sacc, 0, 0, 0); }
            LAS bf16* Sn = ST + ((c + 1) & 1) * (128 * 72);
#pragma unroll
            for (int g = 0; g < 4; ++g) { const int d0 = 32 * dt + 8 * g + 4 * hi; const f32x4 dv = *(const LAS f32x4*)(dec + d0);
                sacc[4 * g] *= dv[0]; sacc[4 * g + 1] *= dv[1]; sacc[4 * g + 2] *= dv[2]; sacc[4 * g + 3] *= dv[3];
                if (PASS == 3) *(LAS v2u*)(Sn + (32 * vt + l31) * 72 + d0) = (v2u){pk2(sacc[4 * g], sacc[4 * g + 1]), pk2(sacc[4 * g + 2], sacc[4 * g + 3])}; }
        }
        if (PASS == 3) {
        if (w < 3) {
            const int it = (w == 0) ? 0 : 1, jt = (w == 2) ? 1 : 0;
            f32x16 a16;
#pragma unroll
            for (int r = 0; r < 16; ++r) a16[r] = 0.f;
#pragma unroll
            for (int kk = 0; kk < 4; ++kk) { const bf16x8 a = *(const LAS bf16x8*)(Ks + (32 * jt + l31) * 72 + kk * 16 + hi * 8), bb = *(const LAS bf16x8*)(Qs + (32 * it + l31) * 72 + kk * 16 + hi * 8);
                a16 = __builtin_amdgcn_mfma_f32_32x32x16_bf16(a, bb, a16, 0, 0, 0); }
            const int i = 32 * it + l31;
#pragma unroll
            for (int g = 0; g < 4; ++g) { const int j0 = 32 * jt + 8 * g + 4 * hi;
                const float x0 = (j0 <= i) ? a16[4 * g] : 0.f, x1 = (j0 + 1 <= i) ? a16[4 * g + 1] : 0.f, x2 = (j0 + 2 <= i) ? a16[4 * g + 2] : 0.f, x3 = (j0 + 3 <= i) ? a16[4 * g + 3] : 0.f;
                *(LAS v2u*)(As + i * 72 + j0) = (v2u){pk2(x0, x1), pk2(x2, x3)}; }
        }
        __syncthreads();
        {
            f32x16 o16;
#pragma unroll
            for (int r = 0; r < 16; ++r) o16[r] = 0.f;
            const LAS bf16* Sc = ST + (c & 1) * (128 * 72);
#pragma unroll
            for (int kk = 0; kk < 4; ++kk) { const bf16x8 a = *(const LAS bf16x8*)(Qs + (32 * dt + l31) * 72 + kk * 16 + hi * 8), bb = *(const LAS bf16x8*)(Sc + (32 * vt + l31) * 72 + kk * 16 + hi * 8);
                o16 = __builtin_amdgcn_mfma_f32_32x32x16_bf16(a, bb, o16, 0, 0, 0); }
#pragma unroll
            for (int kk = 0; kk < 4; ++kk) if (kk < 2 || dt == 1) { const bf16x8 a = *(const LAS bf16x8*)(As + (32 * dt + l31) * 72 + kk * 16 + hi * 8), bb = *(const LAS bf16x8*)(VT + (32 * vt + l31) * 72 + kk * 16 + hi * 8);
                o16 = __builtin_amdgcn_mfma_f32_32x32x16_bf16(a, bb, o16, 0, 0, 0); }
#pragma unroll
            for (int r = 0; r < 16; ++r) Os[(32 * dt + crow16(r, hi)) * 132 + 32 * vt + l31] = o16[r];
        }
        __syncthreads();
        {
            const int i = tid >> 3, v0 = (tid & 7) * 16;
            f32x4 o[4]; float ss = 0.f;
#pragma unroll
            for (int j = 0; j < 4; ++j) { o[j] = *(const LAS f32x4*)(Os + i * 132 + v0 + 4 * j); ss += (o[j].x * o[j].x + o[j].y * o[j].y) + (o[j].z * o[j].z + o[j].w * o[j].w); }
            ss += __shfl_xor(ss, 1); ss += __shfl_xor(ss, 2); ss += __shfl_xor(ss, 4);
            const float rstd = rsqrtf(ss * (1.f / 128.f) + EPS);
            const float rr[16] = {bflo(ra.x), bfhi(ra.x), bflo(ra.y), bfhi(ra.y), bflo(ra.z), bfhi(ra.z), bflo(ra.w), bfhi(ra.w), bflo(rb.x), bfhi(rb.x), bflo(rb.y), bfhi(rb.y), bflo(rb.z), bfhi(rb.z), bflo(rb.w), bfhi(rb.w)};
            float out[16];
#pragma unroll
            for (int j = 0; j < 4; ++j) { const f32x4 gn = *(const f32x4*)(gnorm + v0 + 4 * j);
#pragma unroll
                for (int e2 = 0; e2 < 4; ++e2) { const float r = rr[4 * j + e2]; out[4 * j + e2] = o[j][e2] * rstd * gn[e2] * (r * sigmf(r)); } }
            *(v4u*)rp = (v4u){pk2(out[0], out[1]), pk2(out[2], out[3]), pk2(out[4], out[5]), pk2(out[6], out[7])};
            *(v4u*)(rp + 8) = (v4u){pk2(out[8], out[9]), pk2(out[10], out[11]), pk2(out[12], out[13]), pk2(out[14], out[15])};
        }
        }
    }
#undef GLA_LOAD
    if (PASS == 1) {
        float* sl = Sloc + ((size_t)(bh * 8 + grp) * 8 + w) * 1024 + lane;
#pragma unroll
        for (int r = 0; r < 16; ++r) sl[r * 64] = sacc[r];
        if (w == 0) Dtot[(size_t)(bh * 8 + grp) * 64 + lane] = __expf(gsum);
    }
    __syncthreads();
}
__device__ __forceinline__ void conv_unit(int cu, const bf16* ca, const bf16* cg, bf16* outp, const float* wdw, const float* bdw, const float* gln, const float* bln, LAS unsigned char* lds) {
    int tid_l = threadIdx.x; asm volatile("" : "+v"(tid_l));
    const int tid = tid_l, lane = tid & 63; const int w = __builtin_amdgcn_readfirstlane(tid >> 6);
    const size_t row0 = (size_t)cu * 32; const int s0 = (int)(row0 % SEQ);
    LAS unsigned* us = (LAS unsigned*)lds;
    LAS float* ys = (LAS float*)(lds + 62 * 1024);
    for (int idx = tid; idx < 62 * 64; idx += 512) { const int r = idx >> 6, ch = idx & 63; const int s = s0 - 30 + r;
        v4u o = (v4u){0u, 0u, 0u, 0u};
        if (s >= 0) { const size_t off = (row0 + r - 30) * 512 + ch * 8; const v4u a = *(const v4u*)(ca + off), g = *(const v4u*)(cg + off);
            o.x = pk2(bflo(a.x) * sigmf(bflo(g.x)), bfhi(a.x) * sigmf(bfhi(g.x))); o.y = pk2(bflo(a.y) * sigmf(bflo(g.y)), bfhi(a.y) * sigmf(bfhi(g.y)));
            o.z = pk2(bflo(a.z) * sigmf(bflo(g.z)), bfhi(a.z) * sigmf(bfhi(g.z))); o.w = pk2(bflo(a.w) * sigmf(bflo(g.w)), bfhi(a.w) * sigmf(bfhi(g.w))); }
        *(LAS v4u*)(us + r * 256 + ch * 4) = o; }
    const int cp = tid & 255, th = tid >> 8;
    float w0[31], w1[31];
#pragma unroll
    for (int k = 0; k < 31; ++k) { const f32x2 ww = *(const f32x2*)(wdw + k * 512 + 2 * cp); w0[k] = ww.x; w1[k] = ww.y; }
    const f32x2 bb = *(const f32x2*)(bdw + 2 * cp);
    __syncthreads();
#pragma unroll 1
    for (int tq = 0; tq < 4; ++tq) {
        const int t0 = th * 16 + tq * 4;
        unsigned uw[34];
#pragma unroll
        for (int r = 0; r < 34; ++r) uw[r] = us[(t0 + r) * 256 + cp];
#pragma unroll
        for (int tt = 0; tt < 4; ++tt) { float y0 = bb.x, y1 = bb.y;
#pragma unroll
            for (int k = 0; k < 31; ++k) { y0 += w0[k] * bflo(uw[tt + k]); y1 += w1[k] * bfhi(uw[tt + k]); }
            *(LAS f32x2*)(ys + (t0 + tt) * 512 + 2 * cp) = (f32x2){y0, y1}; }
    }
    __syncthreads();
#pragma unroll 1
    for (int tt = 0; tt < 4; ++tt) { const int t = 4 * w + tt;
        const f32x4 a = *(const LAS f32x4*)(ys + t * 512 + lane * 8), b = *(const LAS f32x4*)(ys + t * 512 + lane * 8 + 4);
        const float mean = wave_sum((a.x + a.y) + (a.z + a.w) + (b.x + b.y) + (b.z + b.w)) * (1.f / 512.f);
        const f32x4 da = a - mean, db = b - mean;
        const float var = wave_sum((da.x * da.x + da.y * da.y) + (da.z * da.z + da.w * da.w) + (db.x * db.x + db.y * db.y) + (db.z * db.z + db.w * db.w)) * (1.f / 512.f);
        const float rstd = rsqrtf(var + EPS);
        const f32x4 g0 = *(const f32x4*)(gln + lane * 8), g1 = *(const f32x4*)(gln + lane * 8 + 4), b0 = *(const f32x4*)(bln + lane * 8), b1 = *(const f32x4*)(bln + lane * 8 + 4);
        f32x4 y0 = da * rstd * g0 + b0, y1 = db * rstd * g1 + b1;
#pragma unroll
        for (int e = 0; e < 4; ++e) { y0[e] = y0[e] * sigmf(y0[e]); y1[e] = y1[e] * sigmf(y1[e]); }
        *(v4u*)(outp + (row0 + t) * 512 + lane * 8) = (v4u){pk2(y0.x, y0.y), pk2(y0.z, y0.w), pk2(y1.x, y1.y), pk2(y1.z, y1.w)}; }
    __syncthreads();
}

struct Params { const float* in[21]; float* out; unsigned char* ws; };
template <int l> __device__ __forceinline__ void layer_body(const Params& p, LAS unsigned char* lds, unsigned char* lds_raw, const XcdBarrier& xbar) {
    int tid_l = threadIdx.x; asm volatile("" : "+v"(tid_l));
    const int tid = tid_l, lane = tid & 63, wave = __builtin_amdgcn_readfirstlane(tid >> 6);
    const int G = gridDim.x, bx = blockIdx.x;
    const int vcu = (G % 8 == 0) ? (bx % 8) * (G / 8) + bx / 8 : bx;
    const int gw = vcu * 8 + wave, NGW = G * 8;
    unsigned char* ws = p.ws;
    unsigned* ctl = (unsigned*)(ws + WS_CTL);
    float* ropec = (float*)(ws + WS_ROPEC); float* ropes = (float*)(ws + WS_ROPES); float* kmean = (float*)(ws + WS_KMEAN);
    bf16* XN = (bf16*)(ws + WS_XN);
    const float* x = p.in[0];
    float* hbuf = p.out;
    {
        const float* hin = (l == 0) ? x : hbuf;
        {
            pg8::Gemm g{(const pg8::bf16_t*)XN, (const pg8::bf16_t*)(ws + WS_WIN), M, NMIX, DM}; pg8::SchedSkip12 S{G, bx};
            pg8::EpiInproj E{(bf16*)(ws + WS_Q), (bf16*)(ws + WS_K), (bf16*)(ws + WS_V), (bf16*)(ws + WS_LQ), (bf16*)(ws + WS_LK), (bf16*)(ws + WS_LV), (bf16*)(ws + WS_LR), (bf16*)(ws + WS_CA), (bf16*)(ws + WS_CG),
                             (float*)(ws + WS_G), kmean, ropec, ropes, p.in[6] + l * 256, 0.125f * 1.4426950408889634f};
#ifndef NO_G1
            pg8::gemm_phase<pg8::EpiInproj, pg8::SchedSkip12, true, true>(lds, g, S, E);
#endif
        }
        xcd_barrier(xbar);
        {
            LAS unsigned* slot = (LAS unsigned*)(lds + LDS_RING);
            for (;;) {
                __syncthreads();
                if (tid == 0) *slot = atomicAdd(ctl + 64 * l, 1u);
                __syncthreads();
                int u = (int)*slot;
                if (u >= 64 + 512 + 224 + 512) break;
                if (u < 64) {
                    pg8::Gemm g{(const pg8::bf16_t*)XN, (const pg8::bf16_t*)(ws + WS_WIN), M, NMIX, DM}; pg8::SchedOne S1{u, 12};
                    pg8::EpiInproj E{(bf16*)(ws + WS_Q), (bf16*)(ws + WS_K), (bf16*)(ws + WS_V), (bf16*)(ws + WS_LQ), (bf16*)(ws + WS_LK), (bf16*)(ws + WS_LV), (bf16*)(ws + WS_LR), (bf16*)(ws + WS_CA), (bf16*)(ws + WS_CG),
                                     (float*)(ws + WS_G), kmean, ropec, ropes, p.in[6] + l * 256, 0.125f * 1.4426950408889634f};
                    pg8::gemm_phase<pg8::EpiInproj, pg8::SchedOne, true, true>(lds, g, S1, E);
                    continue; }
                u -= 64;
#ifndef NO_GLA
                if (u >= 512 && u < 736) { const int a = u - 512; gla_unit<1>(a / 7, a % 7, (const bf16*)(ws + WS_LQ), (const bf16*)(ws + WS_LK), (const bf16*)(ws + WS_LV), (const float*)(ws + WS_G), (bf16*)(ws + WS_LR), p.in[7] + l * 128, (float*)(ws + WS_SLOC), (float*)(ws + WS_DTOT), lds); }
#endif
#ifndef NO_ATTN
                if (u < 512) { const int a = u, qb = 7 - (a >> 6), bh = a & 63;
                    attn_body::attn_unit<8>(bh >> 3, bh & 7, qb, (const attn_body::bf16*)(ws + WS_Q), (const attn_body::bf16*)(ws + WS_K), (const attn_body::bf16*)(ws + WS_V), (attn_body::bf16*)(ws + WS_Q), kmean, (char*)lds_raw); }
#endif
#ifndef NO_CONV
                if (u >= 736) conv_unit(u - 736, (const bf16*)(ws + WS_CA), (const bf16*)(ws + WS_CG), (bf16*)(ws + WS_CONV), p.in[8] + l * 31 * 512, p.in[9] + l * 512, p.in[10] + l * 512, p.in[11] + l * 512, lds);
#endif
            }
        }
        xcd_barrier(xbar);
#ifndef NO_GLA
        for (int u = bx; u < 256; u += G) gla_unit<3>(u >> 3, u & 7, (const bf16*)(ws + WS_LQ), (const bf16*)(ws + WS_LK), (const bf16*)(ws + WS_LV), (const float*)(ws + WS_G), (bf16*)(ws + WS_LR), p.in[7] + l * 128, (float*)(ws + WS_SLOC), (float*)(ws + WS_DTOT), lds);
#endif
        xcd_barrier(xbar);
        {
            pg8::Gemm g{(const pg8::bf16_t*)(ws + WS_Q), (const pg8::bf16_t*)(ws + WS_WBO), 3 * M, 3 * DM, 512}; pg8::SchedBranch S{G, bx};
            pg8::EpiStore<0> E{(bf16*)(ws + WS_YB), DM, 4, (size_t)M * DM};
#ifndef NO_G2
            pg8::gemm_phase<pg8::EpiStore<0>, pg8::SchedBranch, true, true>(lds, g, S, E);
#endif
        }
        if (G != 256) xcd_barrier(xbar);
        {
            pg8::Gemm g{(const pg8::bf16_t*)XN, (const pg8::bf16_t*)(ws + WS_WIN) + (size_t)NMIX * DM, M, 3 * DM, DM}; pg8::SchedGates S{G, bx};
            pg8::EpiGate E{(const bf16*)(ws + WS_YB), (size_t)M * DM, (bf16*)(ws + WS_MB), p.in[4] + l * 3072};
#ifndef NO_G3
            pg8::gemm_phase<pg8::EpiGate, pg8::SchedGates, true, true>(lds, g, S, E);
#endif
        }
        xcd_barrier(xbar);
        {
            pg8::Gemm g{(const pg8::bf16_t*)(ws + WS_MB), (const pg8::bf16_t*)(ws + WS_WMIX), M, DM, DM}; pg8::StaticOrder S; S.init(M, DM, G, bx);
            pg8::EpiStore<0> E{(bf16*)(ws + WS_Y), DM, 1 << 20, 0};
#ifndef NO_G4
            pg8::gemm_phase<pg8::EpiStore<0>, pg8::StaticOrder, true, true>(lds, g, S, E);
#endif
        }
        xcd_barrier(xbar);
        row_phase(hin, (const bf16*)(ws + WS_Y), p.in[16] + l * DM, hbuf, p.in[17] + l * DM, XN, gw, NGW, lane);
        xcd_barrier(xbar);
        {
            pg8::Gemm g{(const pg8::bf16_t*)XN, (const pg8::bf16_t*)(ws + WS_WUP), M, DFF, DM}; pg8::StaticOrder S; S.init(M, DFF, G, bx);
            pg8::EpiStore<1> E{(bf16*)(ws + WS_H), DFF, 1 << 20, 0};
#ifndef NO_G5
            pg8::gemm_phase<pg8::EpiStore<1>, pg8::StaticOrder, true, true>(lds, g, S, E);
#endif
        }
        xcd_barrier(xbar);
        {
            pg8::Gemm g{(const pg8::bf16_t*)(ws + WS_H), (const pg8::bf16_t*)(ws + WS_WDN), M, DM, DFF}; pg8::StaticOrder S; S.init(M, DM, G, bx);
            pg8::EpiStore<0> E{(bf16*)(ws + WS_Y2), DM, 1 << 20, 0};
#ifndef NO_G6
            pg8::gemm_phase<pg8::EpiStore<0>, pg8::StaticOrder, true, true>(lds, g, S, E);
#endif
        }
        xcd_barrier(xbar);
        if (l == 0) {
            LayerW L{p.in[3] + (size_t)DM * 7184, p.in[5] + 16 * 256, p.in[12] + 512 * DM, p.in[13] + 512 * DM, p.in[14] + 512 * DM, p.in[15] + DM * DM, p.in[18] + (size_t)DM * DFF, p.in[19] + (size_t)DFF * DM};
    #ifndef NO_CVT
        convert_weights(L, ws, lds, gw, NGW, wave, lane);
#endif
            for (int i = bx * 512 + tid; i < 64 * 512; i += G * 512) kmean[i] = 0.f;
            row_phase(hbuf, (const bf16*)(ws + WS_Y2), p.in[20], hbuf, p.in[2] + DM, XN, gw, NGW, lane);
            xcd_barrier(xbar);
        } else {
            row_phase(hbuf, (const bf16*)(ws + WS_Y2), p.in[20] + DM, hbuf, nullptr, nullptr, gw, NGW, lane);
        }
        }
}
__global__ void __launch_bounds__(512, 2) mk_fwd(Params p) {
    extern __shared__ __attribute__((aligned(16))) unsigned char lds_raw[];
    cg::grid_group grid = cg::this_grid();
    LAS unsigned char* lds = (LAS unsigned char*)lds_raw;
    if (threadIdx.x < 64) ((LAS unsigned*)(lds + LDS_RING + 256))[threadIdx.x] = 0u;
    __syncthreads();
    const XcdBarrier xbar = xcd_barrier_post((unsigned*)(p.ws + WS_CTL) + 4096, (volatile LAS unsigned*)(lds + LDS_RING + 256));
    const int tid = threadIdx.x, lane = tid & 63, wave = __builtin_amdgcn_readfirstlane(tid >> 6);
    const int G = gridDim.x, bx = blockIdx.x;
    const int vcu = (G % 8 == 0) ? (bx % 8) * (G / 8) + bx / 8 : bx;
    const int gw = vcu * 8 + wave, NGW = G * 8;
    unsigned char* ws = p.ws;
    unsigned* ctl = (unsigned*)(ws + WS_CTL);
    float* ropec = (float*)(ws + WS_ROPEC); float* ropes = (float*)(ws + WS_ROPES); float* kmean = (float*)(ws + WS_KMEAN);
    bf16* XN = (bf16*)(ws + WS_XN);
    const float* x = p.in[0]; const int* positions = (const int*)p.in[1];
    float* hbuf = p.out;

    {
        LayerW L{p.in[3], p.in[5], p.in[12], p.in[13], p.in[14], p.in[15], p.in[18], p.in[19]};
#ifndef NO_CVT
        convert_weights(L, ws, lds, gw, NGW, wave, lane);
#endif
        for (int i = bx * 512 + tid; i < M * 32; i += G * 512) { const int m = i >> 5, f = i & 31; const float ang = (float)positions[m] * c_inv_freq[f];
            const double rev = (double)ang * 0.15915494309189535; const float fr = (float)(rev - __builtin_rint(rev));
            ropec[i] = __builtin_amdgcn_cosf(fr); ropes[i] = __builtin_amdgcn_sinf(fr); }
        for (int i = bx * 512 + tid; i < 64 * 512; i += G * 512) kmean[i] = 0.f;
        row_phase(x, nullptr, nullptr, nullptr, p.in[2], XN, gw, NGW, lane);
    }
    grid.sync();
    layer_body<0>(p, lds, lds_raw, xbar);
    layer_body<1>(p, lds, lds_raw, xbar);
}

extern "C" void kernel_launch(void* const* d_in, const int* in_sizes, int n_in, void* d_out, int out_size, void* d_ws, size_t ws_size, hipStream_t stream) {
    static int grid = 0;
    if (grid == 0) {
        if (n_in != 21 || out_size != M * DM || ws_size < WS_END) { fprintf(stderr, "kernel_launch: unexpected shapes (n_in %d out %d ws %zu)\n", n_in, out_size, ws_size); grid = -1; return; }
        int dev = 0, cus = 0, per_cu = 0;
        hipGetDevice(&dev);
        hipDeviceGetAttribute(&cus, hipDeviceAttributeMultiprocessorCount, dev);
        hipFuncSetAttribute((const void*)mk_fwd, hipFuncAttributeMaxDynamicSharedMemorySize, LDS_BYTES);
        hipOccupancyMaxActiveBlocksPerMultiprocessor(&per_cu, (const void*)mk_fwd, 512, LDS_BYTES);
        if (per_cu < 1) { fprintf(stderr, "kernel_launch: occupancy query says %d blocks per CU\n", per_cu); per_cu = 1; }
        if (per_cu > 1) per_cu = 1;
        grid = cus * per_cu;
        (void)hipGetLastError();
    }
    if (grid < 0) return;
    hipMemsetAsync((char*)d_ws + WS_CTL, 0, 65536, stream);
    Params p{};
    for (int i = 0; i < 21; ++i) p.in[i] = (const float*)d_in[i];
    p.out = (float*)d_out; p.ws = (unsigned char*)d_ws;
    void* args[] = {&p};
    hipError_t e = hipLaunchCooperativeKernel((const void*)mk_fwd, dim3(grid), dim3(512), args, LDS_BYTES, stream);
    if (e != hipSuccess) fprintf(stderr, "cooperative launch failed: %s (grid %d)\n", hipGetErrorString(e), grid);
}
```
